# Optimizing an MI355X kernel written in HIP

```python
import jax, jax.numpy as jnp
from jax import lax
import numpy as np

D_MODEL = 2048
BATCH = 8
SEQ = 2048
DEPTH = 1

RET_HEADS = 4
RET_DK = 256
RET_DV = 256
RET_CHUNK = 128
RET_WIDTH = RET_HEADS * RET_DV
NSA_HEADS = 8
NSA_KV_GROUPS = 2
NSA_HPG = NSA_HEADS // NSA_KV_GROUPS
NSA_DK = 128
NSA_DV = 128
NSA_WIDTH = NSA_HEADS * NSA_DV
MIX_WIDTH = RET_WIDTH + NSA_WIDTH
CMP_BLOCK = 32
CMP_STRIDE = 16
CMP_HIDDEN = 256
SEL_BLOCK = 64
SEL_COUNT = 16
WIN = 512
WIN_QBLOCK = 128
SEL_QCHUNK = 64
N_GROUPS = 8
EXP_PER_GROUP = 8
N_EXPERTS = N_GROUPS * EXP_PER_GROUP
TOP_K_IN_GROUP = 2
D_EXPERT = 512
MOE_BLOCK = 128
ROPE_BASE = 10000.0
EPS = 1e-6
NEG = -1e30
FORCE_BONUS = 1e4
PROJ_SIZES = (
    RET_HEADS * RET_DK, RET_HEADS * RET_DK, RET_WIDTH, RET_WIDTH,
    NSA_HEADS * NSA_DK,
    NSA_KV_GROUPS * NSA_DK, NSA_KV_GROUPS * NSA_DV,
    NSA_KV_GROUPS * NSA_DK, NSA_KV_GROUPS * NSA_DV,
    NSA_KV_GROUPS * NSA_DK, NSA_KV_GROUPS * NSA_DV,
    NSA_HEADS * 3,
)
PROJ_TOTAL = sum(PROJ_SIZES)

kernel_name = 'hybrid_retention_nsa_hmoe_block'


def split_cols(a):
    outs, off = [], 0
    for s in PROJ_SIZES:
        outs.append(a[..., off:off + s])
        off += s
    return outs


def rms_norm(x, g):
    xf = x.astype(jnp.float32)
    y = xf * lax.rsqrt(jnp.mean(xf * xf, axis=-1, keepdims=True) + EPS)
    return (y * g).astype(x.dtype)


def masked_softmax(s, mask):
    s = jnp.where(mask, s.astype(jnp.float32), NEG)
    p = jax.nn.softmax(s, axis=-1)
    return jnp.where(mask, p, 0.0)


def rotary(x, pos):
    half = x.shape[-1] // 2
    inv = ROPE_BASE ** (-jnp.arange(half, dtype=jnp.float32) / half)
    ang = pos.astype(jnp.float32)[:, None] * inv[None, :]
    cos = jnp.cos(ang)[None, :, None, :]
    sin = jnp.sin(ang)[None, :, None, :]
    x1, x2 = x[..., :half], x[..., half:]
    return jnp.concatenate([x1 * cos - x2 * sin, x1 * sin + x2 * cos], axis=-1).astype(x.dtype)


def retention(q, k, v, g, gn_g):
    B, T, H, dk = q.shape
    dv = v.shape[-1]
    C = RET_CHUNK
    NC = T // C
    pos = jnp.arange(T)
    q = rotary(q, pos)
    k = rotary(k, pos) * (dk ** -0.5)
    log_gamma = jnp.log1p(-jnp.exp2(-5.0 - jnp.arange(H, dtype=jnp.float32)))
    idx = jnp.arange(C, dtype=jnp.float32)
    rel = idx[:, None] - idx[None, :]
    decay_in = jnp.where(rel >= 0, jnp.exp(log_gamma[:, None, None] * jnp.maximum(rel, 0.0)), 0.0)
    zeta = jnp.exp(log_gamma[:, None] * (C - 1 - idx)[None, :])
    q_decay = jnp.exp(log_gamma[:, None] * (idx + 1)[None, :])
    chunk_decay = jnp.exp(log_gamma * C)

    def to_chunks(a):
        return a.reshape(B, NC, C, H, a.shape[-1]).transpose(0, 3, 1, 2, 4)

    qc, kc, vc = to_chunks(q), to_chunks(k), to_chunks(v)
    s = jnp.einsum('bhncd,bhnmd->bhncm', qc, kc) * decay_in[None, :, None]
    inner = jnp.einsum('bhncm,bhnme->bhnce', s, vc)
    kv = jnp.einsum('bhnmd,bhnme->nbhde', kc * zeta[None, :, None, :, None], vc).astype(jnp.float32)

    def step(S, kv_n):
        return chunk_decay[None, :, None, None] * S + kv_n, S

    _, S_prev = lax.scan(step, jnp.zeros((B, H, dk, dv), jnp.float32), kv)
    cross = jnp.einsum('bhncd,nbhde->bhnce', qc.astype(jnp.float32), S_prev) * q_decay[None, :, None, :, None]
    o = (inner + cross).astype(jnp.float32).transpose(0, 2, 3, 1, 4).reshape(B, T, H, dv)
    mu = jnp.mean(o, axis=-1, keepdims=True)
    var = jnp.mean(jnp.square(o - mu), axis=-1, keepdims=True)
    o = ((o - mu) * lax.rsqrt(var + EPS)).reshape(B, T, H * dv) * gn_g
    return o * jax.nn.silu(g.astype(jnp.float32))


def nsa(q, k_cmp, v_cmp, k_slc, v_slc, k_win, v_win, gate_logits,
        pos_k, w1_k, w2_k, pos_v, w1_v, w2_v):
    B, T = q.shape[:2]
    G, Hg, d = NSA_KV_GROUPS, NSA_HPG, NSA_DK
    qg = (q * (d ** -0.5)).reshape(B, T, G, Hg, d).transpose(0, 2, 3, 1, 4)
    t_pos = jnp.arange(T)

    def kv_heads(a):
        return a.reshape(B, T, G, -1).transpose(0, 2, 1, 3)

    Nc = (T - CMP_BLOCK) // CMP_STRIDE + 1
    blk_idx = jnp.arange(Nc)[:, None] * CMP_STRIDE + jnp.arange(CMP_BLOCK)[None, :]

    def compress(a, pe, w1, w2):
        blocks = kv_heads(a)[:, :, blk_idx] + pe
        flat = blocks.reshape(B, G, Nc, -1)
        return jax.nn.silu(flat @ w1) @ w2

    kc = compress(k_cmp, pos_k, w1_k, w2_k)
    vc = compress(v_cmp, pos_v, w1_v, w2_v)
    cmp_end = jnp.arange(Nc) * CMP_STRIDE + CMP_BLOCK - 1
    cmask = cmp_end[None, :] <= t_pos[:, None]
    p_cmp = masked_softmax(jnp.einsum('bghtd,bgcd->bghtc', qg, kc), cmask)
    o_cmp = jnp.einsum('bghtc,bgcd->bghtd', p_cmp.astype(vc.dtype), vc)

    Ns = T // SEL_BLOCK
    n_sel = min(SEL_COUNT, Ns)
    cmp_start = jnp.arange(Nc) * CMP_STRIDE
    sel_start = jnp.arange(Ns) * SEL_BLOCK
    overlap = ((cmp_start[:, None] < sel_start[None, :] + SEL_BLOCK)
               & (cmp_start[:, None] + CMP_BLOCK > sel_start[None, :])).astype(jnp.float32)
    imp = jnp.einsum('bghtc,cs->bgts', p_cmp, overlap)
    cur = t_pos // SEL_BLOCK
    sblk = jnp.arange(Ns)
    valid = sblk[None, :] <= cur[:, None]
    forced = (sblk[None, :] == 0) | (sblk[None, :] == cur[:, None]) | (sblk[None, :] == cur[:, None] - 1)
    score = jnp.where(valid, imp + jnp.where(forced, FORCE_BONUS, 0.0), -1.0)
    _, sel_idx = lax.top_k(score, n_sel)

    ks_blocks = kv_heads(k_slc).reshape(B, G, Ns, SEL_BLOCK, -1)
    vs_blocks = kv_heads(v_slc).reshape(B, G, Ns, SEL_BLOCK, -1)
    QC = min(SEL_QCHUNK, T)
    NQ = T // QC
    q_ch = qg.reshape(B, G, Hg, NQ, QC, d).transpose(3, 0, 1, 2, 4, 5)
    idx_ch = sel_idx.reshape(B, G, NQ, QC, n_sel).transpose(2, 0, 1, 3, 4)
    t_ch = t_pos.reshape(NQ, QC)
    b_ix = jnp.arange(B)[:, None, None, None]
    g_ix = jnp.arange(G)[None, :, None, None]

    def sel_chunk(args):
        qq, ii, tt = args
        kk = ks_blocks[b_ix, g_ix, ii]
        vv = vs_blocks[b_ix, g_ix, ii]
        kpos = ii[..., None] * SEL_BLOCK + jnp.arange(SEL_BLOCK)
        mask = (kpos <= tt[None, None, :, None, None]).reshape(B, G, 1, QC, -1)
        s = jnp.einsum('bghqd,bgqnld->bghqnl', qq, kk).reshape(B, G, Hg, QC, -1)
        p = masked_softmax(s, mask).reshape(B, G, Hg, QC, n_sel, SEL_BLOCK)
        return jnp.einsum('bghqnl,bgqnld->bghqd', p.astype(vv.dtype), vv)

    o_slc = lax.map(sel_chunk, (q_ch, idx_ch, t_ch))
    o_slc = o_slc.transpose(1, 2, 3, 0, 4, 5).reshape(B, G, Hg, T, -1)

    WB = WIN_QBLOCK
    NB = T // WB
    nprev = WIN // WB

    def windows(a):
        ap = jnp.pad(kv_heads(a), ((0, 0), (0, 0), (WIN, 0), (0, 0))).reshape(B, G, NB + nprev, WB, -1)
        return jnp.stack([ap[:, :, i:i + NB] for i in range(nprev + 1)], axis=3).reshape(B, G, NB, (nprev + 1) * WB, -1)

    kw, vw = windows(k_win), windows(v_win)
    qpos = t_pos.reshape(NB, WB)
    kpos = (jnp.arange(NB) * WB - WIN)[:, None] + jnp.arange((nprev + 1) * WB)[None, :]
    delta = qpos[:, :, None] - kpos[:, None, :]
    wmask = (delta >= 0) & (delta < WIN) & (kpos[:, None, :] >= 0)
    qb = qg.reshape(B, G, Hg, NB, WB, d)
    p_win = masked_softmax(jnp.einsum('bghnqd,bgnkd->bghnqk', qb, kw), wmask)
    o_win = jnp.einsum('bghnqk,bgnkd->bghnqd', p_win.astype(vw.dtype), vw).reshape(B, G, Hg, T, -1)

    gt = jax.nn.sigmoid(gate_logits.astype(jnp.float32)).reshape(B, T, G, Hg, 3).transpose(0, 2, 3, 1, 4)
    o = gt[..., 0:1] * o_cmp + gt[..., 1:2] * o_slc + gt[..., 2:3] * o_win
    return o.transpose(0, 3, 1, 2, 4).reshape(B, T, NSA_HEADS * NSA_DV)


def hier_moe(h, w_grp, b_grp, w_exp, b_exp, w_gate, w_up, w_down):
    B, T, D = h.shape
    N = B * T
    K = TOP_K_IN_GROUP
    hf = h.reshape(N, D)
    pg = jax.nn.softmax((hf @ w_grp).astype(jnp.float32) + b_grp, axis=-1)
    pg_top, grp = lax.top_k(pg, 1)
    le = ((hf @ w_exp).astype(jnp.float32) + b_exp).reshape(N, N_GROUPS, EXP_PER_GROUP)
    le_g = le[jnp.arange(N), grp[:, 0]]
    pe_top, loc = lax.top_k(jax.nn.softmax(le_g, axis=-1), K)
    wts = pg_top * pe_top / jnp.sum(pe_top, axis=-1, keepdims=True)
    eid = grp * EXP_PER_GROUP + loc

    A = N * K
    e_flat = eid.reshape(A)
    tok = jnp.repeat(jnp.arange(N, dtype=jnp.int32), K)
    w_flat = wts.reshape(A)
    order = jnp.argsort(e_flat)
    e_sorted = e_flat[order]
    counts = jnp.bincount(e_flat, length=N_EXPERTS)
    padded = (counts + MOE_BLOCK - 1) // MOE_BLOCK * MOE_BLOCK
    pad_end = jnp.cumsum(padded)
    pad_start = pad_end - padded
    start = jnp.cumsum(counts) - counts
    dest = pad_start[e_sorted] + (jnp.arange(A) - start[e_sorted])
    n_blocks = -(-A // MOE_BLOCK) + N_EXPERTS
    P = n_blocks * MOE_BLOCK
    row_tok = jnp.zeros((P,), jnp.int32).at[dest].set(tok[order])
    row_w = jnp.zeros((P,), jnp.float32).at[dest].set(w_flat[order])
    blk_exp = jnp.minimum(jnp.searchsorted(pad_end, jnp.arange(n_blocks) * MOE_BLOCK, side='right'), N_EXPERTS - 1)
    xs = hf[row_tok].reshape(n_blocks, MOE_BLOCK, D)

    def expert_block(args):
        xb, e = args
        a = jax.nn.silu(xb @ w_gate[e]) * (xb @ w_up[e])
        return a @ w_down[e]

    ys = lax.map(expert_block, (xs, blk_exp)).reshape(P, D)
    out = jnp.zeros((N, D), jnp.float32).at[row_tok].add(ys.astype(jnp.float32) * row_w[:, None])
    return out.reshape(B, T, D).astype(h.dtype)


def setup_inputs(seed: int = 0) -> dict:
    key = jax.random.key(seed)
    ks = jax.random.split(key, 24)
    L, D = DEPTH, D_MODEL

    def nrm(k, shape, scale):
        return jax.random.normal(k, shape, jnp.float32) * scale

    return {
        'x': nrm(ks[0], (BATCH, SEQ, D), 1.0),
        'c': nrm(ks[1], (BATCH, D), 1.0),
        'w_ada': nrm(ks[2], (L, D, 6 * D), 0.5 * D ** -0.5),
        'b_ada': nrm(ks[3], (L, 6 * D), 0.02),
        'norm1_g': 1.0 + nrm(ks[4], (L, D), 0.02),
        'norm2_g': 1.0 + nrm(ks[5], (L, D), 0.02),
        'final_g': 1.0 + nrm(ks[6], (D,), 0.02),
        'w_in': nrm(ks[7], (L, D, PROJ_TOTAL), D ** -0.5),
        'ret_gn_g': 1.0 + nrm(ks[8], (L, RET_WIDTH), 0.02),
        'cmp_pos_k': nrm(ks[9], (L, CMP_BLOCK, NSA_DK), 0.1),
        'cmp_w1_k': nrm(ks[10], (L, CMP_BLOCK * NSA_DK, CMP_HIDDEN), (CMP_BLOCK * NSA_DK) ** -0.5),
        'cmp_w2_k': nrm(ks[11], (L, CMP_HIDDEN, NSA_DK), CMP_HIDDEN ** -0.5),
        'cmp_pos_v': nrm(ks[12], (L, CMP_BLOCK, NSA_DV), 0.1),
        'cmp_w1_v': nrm(ks[13], (L, CMP_BLOCK * NSA_DV, CMP_HIDDEN), (CMP_BLOCK * NSA_DV) ** -0.5),
        'cmp_w2_v': nrm(ks[14], (L, CMP_HIDDEN, NSA_DV), CMP_HIDDEN ** -0.5),
        'w_out': nrm(ks[15], (L, MIX_WIDTH, D), MIX_WIDTH ** -0.5),
        'w_grp': nrm(ks[16], (L, D, N_GROUPS), D ** -0.5),
        'b_grp': nrm(ks[17], (L, N_GROUPS), 0.01),
        'w_exp': nrm(ks[18], (L, D, N_EXPERTS), D ** -0.5),
        'b_exp': nrm(ks[19], (L, N_EXPERTS), 0.01),
        'w_gate': nrm(ks[20], (L, N_EXPERTS, D, D_EXPERT), D ** -0.5),
        'w_up': nrm(ks[21], (L, N_EXPERTS, D, D_EXPERT), D ** -0.5),
        'w_down': nrm(ks[22], (L, N_EXPERTS, D_EXPERT, D), D_EXPERT ** -0.5),
    }


def reference(x, c, w_ada, b_ada, norm1_g, norm2_g, final_g, w_in, ret_gn_g,
              cmp_pos_k, cmp_w1_k, cmp_w2_k, cmp_pos_v, cmp_w1_v, cmp_w2_v,
              w_out, w_grp, b_grp, w_exp, b_exp, w_gate, w_up, w_down):
    B, T, D = x.shape
    c_act = jax.nn.silu(c)
    for l in range(DEPTH):
        mod = c_act @ w_ada[l] + b_ada[l]
        sh1, sc1, g1, sh2, sc2, g2 = jnp.split(mod[:, None, :], 6, axis=-1)
        h = rms_norm(x, norm1_g[l]) * (1.0 + sc1) + sh1
        rq, rk, rv, rg, nq, kc, vc, ks_, vs_, kw, vw, ng = split_cols(h @ w_in[l])
        o_ret = retention(rq.reshape(B, T, RET_HEADS, RET_DK), rk.reshape(B, T, RET_HEADS, RET_DK),
                          rv.reshape(B, T, RET_HEADS, RET_DV), rg, ret_gn_g[l])
        o_nsa = nsa(nq, kc, vc, ks_, vs_, kw, vw, ng,
                    cmp_pos_k[l], cmp_w1_k[l], cmp_w2_k[l], cmp_pos_v[l], cmp_w1_v[l], cmp_w2_v[l])
        mix = jnp.concatenate([o_ret.astype(x.dtype), o_nsa.astype(x.dtype)], axis=-1) @ w_out[l]
        x = x + g1 * mix
        h2 = rms_norm(x, norm2_g[l]) * (1.0 + sc2) + sh2
        x = x + g2 * hier_moe(h2, w_grp[l], b_grp[l], w_exp[l], b_exp[l], w_gate[l], w_up[l], w_down[l])
    return rms_norm(x, final_g)
```

```cpp
#include <hip/hip_runtime.h>
#include <cstdio>
#include <cstdint>
namespace pg8 {
#define PG8_LAS __attribute__((address_space(3)))
typedef unsigned short bf16_t;
typedef short bf16x8 __attribute__((ext_vector_type(8)));
typedef float f32x4 __attribute__((ext_vector_type(4)));
typedef unsigned u32x4 __attribute__((ext_vector_type(4)));
constexpr int BM = 256, BK = 64, HALF = 128, HTB = HALF * BK * 2  , STAGE_BYTES = 8 * HTB, NXCD = 8, WGM = 8;

__host__ __device__ __forceinline__ int lds_byte(int r, int c) { const int st = (r >> 4) * 2 + (c >> 5), rr = r & 15, cc = c & 31, ob = rr * 64 + cc * 2; return st * 1024 + (ob ^ (((ob >> 9) & 1) << 5)); }
__host__ __device__ __forceinline__ void stage_rc(int b, int& R, int& C) { const int st = b / 1024, sb = b % 1024, swz = sb ^ (((sb >> 9) & 1) << 5); R = (st >> 1) * 16 + swz / 64; C = (st & 1) * 32 + (swz % 64) / 2; }
__host__ __device__ __forceinline__ int perm32(int rho) { const int n = rho >> 4, i = rho & 15; return 8 * (i >> 2) + 4 * n + (i & 3); }

struct Unit { int pm, pn; };
struct Gemm { const bf16_t* A; const bf16_t* Bt; int M, N, K; };

struct StaticOrder {
    int nM, nN, nwg, G, c;
    __host__ __device__ void init(int M, int N, int G_, int c_) { nM = M / BM; nN = N / BM; nwg = nM * nN; G = G_; c = c_; }
    __host__ __device__ bool next(int i, Unit& u) const {
        const long L = (long)i * G + c; if (L >= nwg) return false;
        int wgid = (int)L; { const int q = nwg / NXCD, r = nwg % NXCD, xcd = wgid % NXCD, off = wgid / NXCD; wgid = (xcd < r ? xcd * (q + 1) : r * (q + 1) + (xcd - r) * q) + off; }
        const int nig = WGM * nN, gid = wgid / nig, fm = gid * WGM, gsz = (nM - fm) < WGM ? (nM - fm) : WGM;
        u.pm = fm + ((wgid % nig) % gsz); u.pn = (wgid % nig) / gsz; return true;
    }
    __device__ __forceinline__ void a_ready(const Unit&) const {}
    __device__ __forceinline__ void done(const Unit&) const {}
};


typedef float f32x2 __attribute__((ext_vector_type(2)));
typedef __bf16 bf16x2_t __attribute__((ext_vector_type(2)));
__device__ __forceinline__ unsigned cvt_pk_bf16(float lo, float hi) { f32x2 v = {lo, hi}; bf16x2_t r = __builtin_convertvector(v, bf16x2_t); return __builtin_bit_cast(unsigned, r); }

struct EpiBf16 {
    static constexpr bool PERM = true, AFTER_DRAIN = false;
    bf16_t* O; int ldc;
    __device__ __forceinline__ void operator()(const f32x4 (&acc)[2][2][4][2], const Unit& u, int wr, int wc, int fr, int fq) const {
        const int row0 = u.pm * BM + wr * 64 + fr; const int col0 = u.pn * BM + wc * 32 + 8 * fq;
#pragma unroll
        for (int ai = 0; ai < 2; ++ai)
#pragma unroll
            for (int m = 0; m < 4; ++m) { bf16_t* rowp = O + (size_t)(row0 + ai * HALF + m * 16) * ldc + col0;
#pragma unroll
                for (int bj = 0; bj < 2; ++bj) { const f32x4 v0 = acc[ai][bj][m][0], v1 = acc[ai][bj][m][1];
                    u32x4 w; w.x = cvt_pk_bf16(v0[0], v0[1]); w.y = cvt_pk_bf16(v0[2], v0[3]); w.z = cvt_pk_bf16(v1[0], v1[1]); w.w = cvt_pk_bf16(v1[2], v1[3]);
                    *(u32x4*)(rowp + bj * HALF) = w; } }
    }
};
struct EpiResGate {
    static constexpr bool PERM = false, AFTER_DRAIN = false;
    const float* base; float* out; int ldc; const float* gate; int gstride; int rows_per_batch;
    __device__ __forceinline__ void operator()(const f32x4 (&acc)[2][2][4][2], const Unit& u, int wr, int wc, int fr, int fq) const {
        const int row0 = u.pm * BM + wr * 64 + fr, col0 = u.pn * BM + wc * 32 + 4 * fq;
        const float* gp = gate + (size_t)((u.pm * BM) / rows_per_batch) * gstride + col0;
        f32x4 gv[2][2];
#pragma unroll
        for (int bj = 0; bj < 2; ++bj)
#pragma unroll
            for (int n = 0; n < 2; ++n) gv[bj][n] = *(const f32x4*)(gp + bj * HALF + n * 16);
#pragma unroll
        for (int ai = 0; ai < 2; ++ai)
#pragma unroll
            for (int m = 0; m < 4; ++m) { const size_t off = (size_t)(row0 + ai * HALF + m * 16) * ldc + col0;
#pragma unroll
                for (int bj = 0; bj < 2; ++bj)
#pragma unroll
                    for (int n = 0; n < 2; ++n) { const f32x4 bs = *(const f32x4*)(base + off + bj * HALF + n * 16);
                        *(f32x4*)(out + off + bj * HALF + n * 16) = bs + gv[bj][n] * acc[ai][bj][m][n]; } }
    }
};

template <class Epi, class Sched, bool ALIGN_EPI = false, bool SP2 = false>
__device__ __forceinline__ void gemm_phase(PG8_LAS unsigned char* lds, const Gemm g, const Sched& S, const Epi& E) {
    const int tid = threadIdx.x, wid = __builtin_amdgcn_readfirstlane(tid >> 6), lane = tid & 63, wr = wid >> 2, wc = wid & 3, fr = lane & 15, fq = lane >> 4;
    const int K = g.K, nt = K / BK;
    unsigned voffA[2], voffB[2];
#pragma unroll
    for (int i = 0; i < 2; ++i) { int R, C; stage_rc(tid * 16 + i * 8192, R, C); const int Rb = Epi::PERM ? ((R & ~31) + perm32(R & 31)) : R;
        voffA[i] = (unsigned)(R * K + C) * 2u; voffB[i] = (unsigned)(Rb * K + C) * 2u; }
    const size_t kstep = (size_t)(BK * 2);
    const size_t hstep = (size_t)HALF * K * 2;
    const size_t tstep = 2 * hstep;
    const unsigned ldsw = (unsigned)wid * 1024u;
    const int aoff = lds_byte(wr * 64 + fr, fq * 8), boff = lds_byte(wc * 32 + fr, fq * 8);
#define PG8_SA(b, h) (((b) * 2 + (h)) * HTB)
#define PG8_SB(b, h) ((4 + (b) * 2 + (h)) * HTB)
#define PG8_STAGE(bufoff, gbase, voff) do { _Pragma("unroll") for (int _i = 0; _i < 2; ++_i) \
        __builtin_amdgcn_global_load_lds((const unsigned*)((const char*)(gbase) + (voff)[_i]), (PG8_LAS unsigned*)(lds + (bufoff) + ldsw + _i * 8192), 16, 0, 0); } while (0)
#define PG8_LDA(dst, b, h) do { _Pragma("unroll") for (int m = 0; m < 4; ++m) _Pragma("unroll") for (int k = 0; k < 2; ++k) dst[m][k] = *(const PG8_LAS bf16x8*)(lds + PG8_SA(b, h) + aoff + m * 2048 + k * 1024); } while (0)
#define PG8_LDB(dst, b, h) do { _Pragma("unroll") for (int n = 0; n < 2; ++n) _Pragma("unroll") for (int k = 0; k < 2; ++k) dst[n][k] = *(const PG8_LAS bf16x8*)(lds + PG8_SB(b, h) + boff + n * 2048 + k * 1024); } while (0)
#define PG8_MMA(ai, bj, At, Bt) do { __builtin_amdgcn_s_setprio(1); _Pragma("unroll") for (int m = 0; m < 4; ++m) _Pragma("unroll") for (int n = 0; n < 2; ++n) _Pragma("unroll") for (int k = 0; k < 2; ++k) \
        acc[ai][bj][m][n] = __builtin_amdgcn_mfma_f32_16x16x32_bf16(Bt[n][k], At[m][k], acc[ai][bj][m][n], 0, 0, 0); __builtin_amdgcn_s_setprio(0); } while (0)
#define PG8_WAIT_V(n) asm volatile("s_waitcnt vmcnt(" #n ")" ::: "memory")
#define PG8_WAIT_L(n) asm volatile("s_waitcnt lgkmcnt(" #n ")" ::: "memory")
#define PG8_BAR __builtin_amdgcn_s_barrier()
#define PG8_SCHED __builtin_amdgcn_sched_barrier(0)
    Unit cur, nxt; int ui = 0;
    if (!S.next(0, cur)) return;
    f32x4 acc[2][2][4][2];
#pragma unroll
    for (int a = 0; a < 2; ++a)
#pragma unroll
        for (int b = 0; b < 2; ++b)
#pragma unroll
            for (int m = 0; m < 4; ++m)
#pragma unroll
                for (int n = 0; n < 2; ++n) acc[a][b][m][n] = (f32x4){0.f, 0.f, 0.f, 0.f};
    bf16x8 At[4][2], B0[2][2], B1[2][2];
    const char* cA = (const char*)g.A + (size_t)cur.pm * tstep; const char* cB = (const char*)g.Bt + (size_t)cur.pn * tstep;
    S.a_ready(cur);
    if constexpr (SP2) {
        PG8_STAGE(PG8_SB(0, 0), cB, voffB); PG8_STAGE(PG8_SB(0, 1), cB + hstep, voffB); PG8_STAGE(PG8_SA(0, 0), cA, voffA); PG8_STAGE(PG8_SA(0, 1), cA + hstep, voffA);
        if (wr == 1) PG8_BAR;
        PG8_WAIT_V(2); PG8_BAR;
        PG8_STAGE(PG8_SB(1, 0), cB + kstep, voffB); PG8_STAGE(PG8_SA(1, 0), cA + kstep, voffA); PG8_STAGE(PG8_SB(1, 1), cB + hstep + kstep, voffB);
        PG8_WAIT_V(6); PG8_BAR;
    } else {
        PG8_STAGE(PG8_SB(0, 0), cB, voffB); PG8_STAGE(PG8_SA(0, 0), cA, voffA); PG8_STAGE(PG8_SB(0, 1), cB + hstep, voffB); PG8_STAGE(PG8_SA(0, 1), cA + hstep, voffA);
        if (wr == 1) PG8_BAR;
        PG8_WAIT_V(4); PG8_BAR;
        PG8_STAGE(PG8_SB(1, 0), cB + kstep, voffB); PG8_STAGE(PG8_SA(1, 0), cA + kstep, voffA); PG8_STAGE(PG8_SB(1, 1), cB + hstep + kstep, voffB);
        PG8_WAIT_V(6); PG8_BAR;
    }
    for (;;) {
        const bool has_next = S.next(ui + 1, nxt);
        const char* nA = has_next ? (const char*)g.A + (size_t)nxt.pm * tstep : cA; const char* nB = has_next ? (const char*)g.Bt + (size_t)nxt.pn * tstep : cB;
        for (int t = 0; t < nt; t += 2) {
            const bool last = (t == nt - 2);
            const char* a1 = cA + (size_t)(t + 1) * kstep;
            const char* a2 = last ? nA : cA + (size_t)(t + 2) * kstep; const char* b2 = last ? nB : cB + (size_t)(t + 2) * kstep;
            const char* a3 = a2 + kstep; const char* b3 = b2 + kstep;
            if (last && has_next) S.a_ready(nxt);
            if constexpr (SP2) {
            PG8_LDB(B0, 0, 0); PG8_LDB(B1, 0, 1); PG8_SCHED; PG8_LDA(At, 0, 0); PG8_STAGE(PG8_SA(1, 1), a1 + hstep, voffA);
            PG8_WAIT_V(8); PG8_WAIT_L(0); PG8_BAR; PG8_MMA(0, 0, At, B0); PG8_MMA(0, 1, At, B1); PG8_BAR; PG8_SCHED;
            PG8_LDA(At, 0, 1); PG8_STAGE(PG8_SB(0, 0), b2, voffB); PG8_STAGE(PG8_SB(0, 1), b2 + hstep, voffB); PG8_STAGE(PG8_SA(0, 0), a2, voffA);
            PG8_WAIT_V(8); PG8_WAIT_L(0); PG8_BAR; PG8_MMA(1, 0, At, B0); PG8_MMA(1, 1, At, B1); PG8_BAR; PG8_SCHED;
            PG8_LDB(B0, 1, 0); PG8_LDB(B1, 1, 1); PG8_SCHED; PG8_LDA(At, 1, 0); PG8_STAGE(PG8_SA(0, 1), a2 + hstep, voffA);
            PG8_WAIT_V(8); PG8_WAIT_L(0); PG8_BAR; PG8_MMA(0, 0, At, B0); PG8_MMA(0, 1, At, B1); PG8_BAR; PG8_SCHED;
            PG8_LDA(At, 1, 1); PG8_STAGE(PG8_SB(1, 0), b3, voffB); PG8_STAGE(PG8_SB(1, 1), b3 + hstep, voffB); PG8_STAGE(PG8_SA(1, 0), a3, voffA);
            PG8_WAIT_V(8); PG8_WAIT_L(0); PG8_BAR; PG8_MMA(1, 0, At, B0); PG8_MMA(1, 1, At, B1); PG8_BAR; PG8_SCHED;
            } else {
            PG8_LDB(B0, 0, 0); PG8_SCHED; PG8_LDA(At, 0, 0); PG8_STAGE(PG8_SA(1, 1), a1 + hstep, voffA);
            PG8_WAIT_L(8); PG8_BAR; PG8_WAIT_L(0); PG8_MMA(0, 0, At, B0); PG8_BAR; PG8_SCHED;
            PG8_LDB(B1, 0, 1); PG8_STAGE(PG8_SB(0, 0), b2, voffB);
            PG8_BAR; PG8_WAIT_L(0); PG8_MMA(0, 1, At, B1); PG8_BAR;
            PG8_LDA(At, 0, 1); PG8_STAGE(PG8_SA(0, 0), a2, voffA);
            PG8_BAR; PG8_WAIT_L(0); PG8_MMA(1, 0, At, B0); PG8_BAR; PG8_SCHED;
            PG8_STAGE(PG8_SB(0, 1), b2 + hstep, voffB);
            PG8_WAIT_V(6); PG8_BAR; PG8_MMA(1, 1, At, B1); PG8_BAR;
            PG8_LDB(B0, 1, 0); PG8_SCHED; PG8_LDA(At, 1, 0); PG8_STAGE(PG8_SA(0, 1), a2 + hstep, voffA);
            PG8_WAIT_L(8); PG8_BAR; PG8_WAIT_L(0); PG8_MMA(0, 0, At, B0); PG8_BAR; PG8_SCHED;
            PG8_LDB(B1, 1, 1); PG8_STAGE(PG8_SB(1, 0), b3, voffB);
            PG8_BAR; PG8_WAIT_L(0); PG8_MMA(0, 1, At, B1); PG8_BAR;
            PG8_LDA(At, 1, 1); PG8_STAGE(PG8_SA(1, 0), a3, voffA);
            PG8_BAR; PG8_WAIT_L(0); PG8_MMA(1, 0, At, B0); PG8_BAR; PG8_SCHED;
            PG8_STAGE(PG8_SB(1, 1), b3 + hstep, voffB);
            PG8_WAIT_V(6); PG8_BAR; PG8_MMA(1, 1, At, B1); PG8_BAR;
            }
        }
        if constexpr (ALIGN_EPI) { if (wr == 0) PG8_BAR; }
        if constexpr (!Epi::AFTER_DRAIN) { E(acc, cur, wr, wc, fr, fq); S.done(cur); }
        if (!has_next) break;
#pragma unroll
        for (int a = 0; a < 2; ++a)
#pragma unroll
            for (int b = 0; b < 2; ++b)
#pragma unroll
                for (int m = 0; m < 4; ++m)
#pragma unroll
                    for (int n = 0; n < 2; ++n) acc[a][b][m][n] = (f32x4){0.f, 0.f, 0.f, 0.f};
        cur = nxt; cA = nA; cB = nB; ++ui;
        if constexpr (ALIGN_EPI) { if (wr == 1) PG8_BAR; }
    }
    PG8_WAIT_V(0);
    if constexpr (!ALIGN_EPI) { if (wr == 0) PG8_BAR; }
    PG8_BAR;
    if constexpr (Epi::AFTER_DRAIN) { E.fused(acc, cur, wr, wc, fr, fq, lds, wid, lane); S.done(cur); }
#undef PG8_SA
#undef PG8_SB
#undef PG8_STAGE
#undef PG8_LDA
#undef PG8_LDB
#undef PG8_MMA
#undef PG8_WAIT_V
#undef PG8_WAIT_L
#undef PG8_BAR
#undef PG8_SCHED
}
}

constexpr int NB = 8, T = 2048, D = 2048, M = NB * T;
constexpr int NP = 6912, PROJ = 6680;
constexpr int C_RQ = 0, C_RK = 1024, C_RV = 2048, C_RG = 3072, C_NQ = 4096, C_KC = 5120, C_VC = 5376, C_KS = 5632, C_VS = 5888, C_KW = 6144, C_VW = 6400, C_NG = 6656;
constexpr int NEXP = 64, DE = 512, CAP = 32768;
constexpr float EPS = 1e-6f;
constexpr int NWAVES = 8;

constexpr size_t MiB = 1u << 20;
constexpr size_t WS_CTL = 0, CTL_ZERO_BYTES = 1 * MiB;
constexpr size_t WS_SMALL = 1 * MiB;
constexpr size_t WS_BIAS1K = WS_SMALL, WS_BIAS1V = WS_SMALL + 1024, WS_W2KT = WS_SMALL + 4096, WS_W2VT = WS_W2KT + 65536, WS_WRT = WS_W2VT + 65536;
constexpr size_t WS_MODP = 2 * MiB;
constexpr size_t WS_MOD = WS_MODP + 4 * 8 * 12288 * 4;
constexpr size_t WS_COS = 4 * MiB, WS_SIN = 5 * MiB;
constexpr size_t WS_W1K = 6 * MiB, WS_W1V = 8 * MiB;
constexpr size_t WS_YK = 10 * MiB, WS_YV = 14 * MiB;
constexpr size_t WS_KC = 18 * MiB, WS_VCT = 19 * MiB;
constexpr size_t WS_ASG = 26 * MiB, WS_RW = 34 * MiB;
constexpr size_t WS_WIN = 42 * MiB;
constexpr size_t WS_WOUT = 70 * MiB;
constexpr size_t WS_WGU = 78 * MiB;
constexpr size_t WS_WD = 334 * MiB;
constexpr size_t WS_H = 462 * MiB;
constexpr size_t WS_PROJ = 526 * MiB;
constexpr size_t WS_Y = 526 * MiB;
constexpr size_t WS_A = 654 * MiB;
constexpr size_t WS_QR = 742 * MiB, WS_KR = 774 * MiB, WS_KZT = 806 * MiB, WS_VT = 838 * MiB;
constexpr size_t WS_SP = 870 * MiB;
constexpr size_t WS_KCMP = 934 * MiB, WS_VCMP = 942 * MiB, WS_VST = 950 * MiB, WS_VWT = 958 * MiB;
constexpr size_t WS_CAT = 966 * MiB;
constexpr size_t WS_END = 1030 * MiB;
constexpr int CW_BAR = 4096;
constexpr int CW_CNT = 8192;

constexpr int LDS_BYTES = 147456;
constexpr int MISC_OFF = LDS_BYTES - 256;

#define GAS __attribute__((address_space(1)))
#define LAS __attribute__((address_space(3)))
typedef unsigned short bf16;
typedef short bf16x8 __attribute__((ext_vector_type(8)));
typedef short bf16x4 __attribute__((ext_vector_type(4)));
typedef float f32x4 __attribute__((ext_vector_type(4)));
typedef float f32x16 __attribute__((ext_vector_type(16)));
typedef unsigned u32x4 __attribute__((ext_vector_type(4)));
typedef unsigned u32x2 __attribute__((ext_vector_type(2)));
#define LDS_WAIT() asm volatile("s_waitcnt lgkmcnt(0)" ::: "memory")
#define VM_WAIT() asm volatile("s_waitcnt vmcnt(0)" ::: "memory")
#define MFMA16(a, b, c) __builtin_amdgcn_mfma_f32_16x16x32_bf16((a), (b), (c), 0, 0, 0)
#define MFMA32(a, b, c) __builtin_amdgcn_mfma_f32_32x32x16_bf16((a), (b), (c), 0, 0, 0)
using pg8::cvt_pk_bf16;
__device__ __forceinline__ float bf2f(unsigned short b) { return __uint_as_float(((unsigned)b) << 16); }
__device__ __forceinline__ float bflo(unsigned w) { return __uint_as_float(w << 16); }
__device__ __forceinline__ float bfhi(unsigned w) { return __uint_as_float(w & 0xffff0000u); }
__device__ __forceinline__ float wave_sum(float v) {
#pragma unroll
    for (int o = 1; o < 64; o <<= 1) v += __shfl_xor(v, o);
    return v;
}
__device__ __forceinline__ float silu_f(float x) { return x / (1.f + __expf(-x)); }
__device__ __forceinline__ float sigmoid_f(float x) { return 1.f / (1.f + __expf(-x)); }
__device__ __forceinline__ bf16x8 cat4(bf16x4 lo, bf16x4 hi) { return __builtin_shufflevector(lo, hi, 0, 1, 2, 3, 4, 5, 6, 7); }
__device__ __forceinline__ bf16x8 pack8(const f32x4 a, const f32x4 b) { u32x4 p; p.x = cvt_pk_bf16(a[0], a[1]); p.y = cvt_pk_bf16(a[2], a[3]); p.z = cvt_pk_bf16(b[0], b[1]); p.w = cvt_pk_bf16(b[2], b[3]); return __builtin_bit_cast(bf16x8, p); }

#define XB_TMO      128
#define XB_XCNT(j)  (256  + 64 * (j))
#define XB_XSUB(j)  (1280 + 64 * (j))
#define XB_XGEN(j)  (2304 + 64 * (j))
#define XB_TOP      3328
#define XB_TOPGEN   3392
#define XCD_BAR_WORDS 3456
#define XB_SPIN_CAP (1u << 18)

__device__ __forceinline__ unsigned xb_ld(unsigned* p)              { return __hip_atomic_load(p, __ATOMIC_RELAXED, __HIP_MEMORY_SCOPE_AGENT); }
__device__ __forceinline__ unsigned xb_add(unsigned* p, unsigned v) { return __hip_atomic_fetch_add(p, v, __ATOMIC_RELAXED, __HIP_MEMORY_SCOPE_AGENT); }
__device__ __forceinline__ unsigned xb_xcc_id() { return (unsigned)__builtin_amdgcn_s_getreg((3 << 11) | 20) & 0xFu; }
#define XB_SPIN(cond, bar) do { unsigned _sp = 0; while (cond) { __builtin_amdgcn_s_sleep(1); \
    if ((++_sp & 255u) == 0u) { if (xb_ld(&(bar)[XB_TMO])) break; if (_sp > XB_SPIN_CAP) { atomicAdd(&(bar)[XB_TMO], 1u); break; } } } } while (0)

struct XcdBarrier {
    unsigned* bar; unsigned x;
    volatile LAS unsigned* st;
};

__device__ __forceinline__ XcdBarrier xcd_barrier_post(unsigned* bar, volatile LAS unsigned* st) {
    XcdBarrier b; b.bar = bar; b.x = xb_xcc_id(); b.st = st;
    if (threadIdx.x == 0) (void)xb_add(&bar[XB_XCNT(b.x)], 1u);
    return b;
}
__device__ __forceinline__ void xcd_barrier_complete(unsigned* bar, unsigned x, unsigned& nloc, unsigned& nx) {
    const unsigned G = gridDim.x * gridDim.y * gridDim.z;
    unsigned sum, cnt, mine, sp = 0u;
    for (;;) {
        sum = 0u; cnt = 0u; mine = 0u;
#pragma unroll
        for (unsigned j = 0; j < 16; ++j) { const unsigned c = xb_ld(&bar[XB_XCNT(j)]); sum += c; cnt += (c > 0u) ? 1u : 0u; mine = (j == x) ? c : mine; }
        if (sum == G) break;
        __builtin_amdgcn_s_sleep(1);
        if ((++sp & 255u) == 0u) { if (xb_ld(&bar[XB_TMO])) break; if (sp > XB_SPIN_CAP) { atomicAdd(&bar[XB_TMO], 1u); break; } }
    }
    nloc = mine > 0u ? mine : 1u; nx = cnt > 0u ? cnt : 1u;
}

__device__ __forceinline__ void xcd_barrier(const XcdBarrier& b) {
    asm volatile("s_waitcnt vmcnt(0)" ::: "memory");
    __syncthreads();
    if (threadIdx.x == 0) {
        unsigned* bar = b.bar;
        __builtin_amdgcn_s_waitcnt(0);
        unsigned nloc = b.st[0], nx = b.st[1];
        if (nloc == 0u) { xcd_barrier_complete(bar, b.x, nloc, nx); b.st[0] = nloc; b.st[1] = nx; }
        const unsigned old = xb_add(&bar[XB_XSUB(b.x)], 1u);
        const unsigned gen = old / nloc;
        if (old + 1u == (gen + 1u) * nloc) {
            __builtin_amdgcn_fence(__ATOMIC_RELEASE, "agent");
            asm volatile("s_waitcnt vmcnt(0)" ::: "memory");
            const unsigned og = xb_add(&bar[XB_TOP], 1u);
            const unsigned tg = og / nx;
            if (og + 1u == (tg + 1u) * nx) xb_add(&bar[XB_TOPGEN], 1u);
            else XB_SPIN(xb_ld(&bar[XB_TOPGEN]) == tg, bar);
            __builtin_amdgcn_fence(__ATOMIC_ACQUIRE, "agent");
            xb_add(&bar[XB_XGEN(b.x)], 1u);
            asm volatile("s_waitcnt vmcnt(0)" ::: "memory");
        } else {
            XB_SPIN(xb_ld(&bar[XB_XGEN(b.x)]) == gen, bar);
            __builtin_amdgcn_fence(__ATOMIC_ACQUIRE, "agent");
            asm volatile("s_waitcnt vmcnt(0)" ::: "memory");
        }
    }
    __syncthreads();
}

struct Args { const float* in[23]; float* out; unsigned char* ws; int ph_lo, ph_hi; };
enum { I_X = 0, I_C, I_WADA, I_BADA, I_N1G, I_N2G, I_FG, I_WIN, I_GNG, I_PK, I_W1K, I_W2K, I_PV, I_W1V, I_W2V, I_WOUT, I_WGRP, I_BGRP, I_WEXP, I_BEXP, I_WGATE, I_WUP, I_WDOWN };

__device__ __forceinline__ float ret_lg(int h) { return h == 0 ? -0.0317486983145803f : (h == 1 ? -0.015748356968139168f : (h == 2 ? -0.007843177461025893f : -0.003913899321136329f)); }

__device__ __forceinline__ void transpose_tile(const float* __restrict__ W, int ldw, int k0, int n0, int nmax, bf16* __restrict__ WT, int ldt, int drow0, int dcol0, LAS float* scr, int lane) {
#pragma unroll 8
    for (int i = 0; i < 32; ++i) { const int kk = 2 * i + (lane >> 5); const int n = n0 + (lane & 31);
        const float v = (n < nmax) ? W[(size_t)(k0 + kk) * ldw + n] : 0.f; scr[kk * 33 + (lane & 31)] = v; }
    LDS_WAIT();
    const int c = lane & 7;
#pragma unroll
    for (int j = 0; j < 4; ++j) { const int nn = (lane >> 3) + 8 * j; const LAS float* s = scr + (8 * c) * 33 + nn;
        u32x4 o; o.x = cvt_pk_bf16(s[0 * 33], s[1 * 33]); o.y = cvt_pk_bf16(s[2 * 33], s[3 * 33]); o.z = cvt_pk_bf16(s[4 * 33], s[5 * 33]); o.w = cvt_pk_bf16(s[6 * 33], s[7 * 33]);
        *(u32x4*)(WT + (size_t)(drow0 + nn) * ldt + dcol0 + 8 * c) = o; }
    LDS_WAIT();
}

__device__ __forceinline__ void phase0(const Args& a, LAS unsigned char* lds) {
    const int tid = threadIdx.x, lane = tid & 63, wave = __builtin_amdgcn_readfirstlane(tid >> 6);
    unsigned char* ws = a.ws;
    {
        LAS float* cact = (LAS float*)lds;
        LAS float* red = (LAS float*)(lds + 16384);
        const float* c = a.in[I_C]; const float* wada = a.in[I_WADA];
        float* modp = (float*)(ws + WS_MODP);
        for (int it = blockIdx.x; it < 768; it += gridDim.x) {
            const int kq = it / 192, cc = it % 192;
            __syncthreads();
            for (int i = tid; i < 8 * 512; i += 512) { const int b = i >> 9, k = i & 511; cact[i] = silu_f(c[b * 2048 + kq * 512 + k]); }
            __syncthreads();
            float acc[8];
#pragma unroll
            for (int b = 0; b < 8; ++b) acc[b] = 0.f;
            const float* wp = wada + (size_t)(kq * 512 + wave * 64) * 12288 + cc * 64 + lane;
#pragma unroll 8
            for (int kk = 0; kk < 64; ++kk) { const float wv = wp[(size_t)kk * 12288];
#pragma unroll
                for (int b = 0; b < 8; ++b) acc[b] += cact[b * 512 + wave * 64 + kk] * wv; }
#pragma unroll
            for (int b = 0; b < 8; ++b) red[(wave * 8 + b) * 64 + lane] = acc[b];
            __syncthreads();
            { const int b = tid >> 6, l = tid & 63; float s = 0.f;
#pragma unroll
              for (int w = 0; w < 8; ++w) s += red[(w * 8 + b) * 64 + l];
              modp[((size_t)kq * 8 + b) * 12288 + cc * 64 + l] = s; }
        }
    }
    for (int ten = blockIdx.x; ten < 2; ten += gridDim.x) {
        const float* pe = a.in[ten ? I_PV : I_PK]; const float* w1 = a.in[ten ? I_W1V : I_W1K]; float* bias = (float*)(ws + (ten ? WS_BIAS1V : WS_BIAS1K));
        const int n = tid & 255, half = tid >> 8; float s = 0.f;
        for (int k = half * 2048; k < half * 2048 + 2048; ++k) s += pe[k] * w1[(size_t)k * 256 + n];
        __syncthreads(); LAS float* red = (LAS float*)lds; red[tid] = s; __syncthreads();
        if (tid < 256) bias[tid] = red[tid] + red[tid + 256];
    }
    __syncthreads();
    {
        LAS float* scr = (LAS float*)(lds + wave * 16384);
        const int gw = blockIdx.x * NWAVES + wave, NGW = gridDim.x * NWAVES;
        constexpr int I_IN = 216 * 32, I_OUT = 64 * 32, I_G = 64 * 512, I_W1 = 512, I_W2 = 16;
        constexpr int NITEMS = I_IN + I_OUT + 3 * I_G + 2 * I_W1 + 2 * I_W2;
        for (int it = gw; it < NITEMS; it += NGW) {
            int r = it;
            if (r < I_IN) { const int kb = r / 216, nb = r % 216; transpose_tile(a.in[I_WIN], PROJ, 64 * kb, 32 * nb, PROJ, (bf16*)(ws + WS_WIN), 2048, 32 * nb, 64 * kb, scr, lane); continue; } r -= I_IN;
            if (r < I_OUT) { const int kb = r / 64, nb = r % 64; transpose_tile(a.in[I_WOUT], 2048, 64 * kb, 32 * nb, 2048, (bf16*)(ws + WS_WOUT), 2048, 32 * nb, 64 * kb, scr, lane); continue; } r -= I_OUT;
            if (r < 2 * I_G) { const int up = r >= I_G ? 1 : 0; r -= up * I_G; const int e = r >> 9, rr = r & 511, kb = rr >> 4, nb = rr & 15, n0 = 32 * nb;
                const float* W = a.in[up ? I_WUP : I_WGATE] + (size_t)e * 2048 * 512;
                transpose_tile(W, 512, 64 * kb, n0, 512, (bf16*)(ws + WS_WGU), 2048, e * 1024 + (n0 >> 7) * 256 + up * 128 + (n0 & 127), 64 * kb, scr, lane); continue; } r -= 2 * I_G;
            if (r < I_G) { const int e = r >> 9, rr = r & 511, kb = rr >> 6, nb = rr & 63;
                transpose_tile(a.in[I_WDOWN] + (size_t)e * 512 * 2048, 2048, 64 * kb, 32 * nb, 2048, (bf16*)(ws + WS_WD), 512, e * 2048 + 32 * nb, 64 * kb, scr, lane); continue; } r -= I_G;
            if (r < 2 * I_W1) { const int ten = r >= I_W1 ? 1 : 0; r -= ten * I_W1; const int kb = r >> 3, nb = r & 7, k0 = 64 * kb;
                transpose_tile(a.in[ten ? I_W1V : I_W1K], 256, k0, 32 * nb, 256, (bf16*)(ws + (ten ? WS_W1V : WS_W1K)), 2048, (k0 >= 2048 ? 256 : 0) + 32 * nb, k0 & 2047, scr, lane); continue; } r -= 2 * I_W1;
            { const int ten = r >= I_W2 ? 1 : 0; r -= ten * I_W2; const int kb = r >> 2, nb = r & 3;
                transpose_tile(a.in[ten ? I_W2V : I_W2K], 128, 64 * kb, 32 * nb, 128, (bf16*)(ws + (ten ? WS_W2VT : WS_W2KT)), 256, 32 * nb, 64 * kb, scr, lane); }
        }
    }
    {
        const int gt = blockIdx.x * 512 + tid, NT = gridDim.x * 512;
        bf16* wrt = (bf16*)(ws + WS_WRT); const float* wg = a.in[I_WGRP]; const float* we = a.in[I_WEXP];
        for (int idx = gt; idx < 80 * 2048; idx += NT) { const int n = idx >> 11, k = idx & 2047;
            const float v = n < 8 ? wg[k * 8 + n] : (n < 72 ? we[k * 64 + (n - 8)] : 0.f); wrt[idx] = (bf16)(cvt_pk_bf16(v, 0.f) & 0xffffu); }
        float* cosT = (float*)(ws + WS_COS); float* sinT = (float*)(ws + WS_SIN);
        for (int idx = gt; idx < 2048 * 128; idx += NT) { const int pos = idx >> 7, j = idx & 127;
            const float inv = exp2f(-(float)j * 0.10381025296523007f);
            const double rev = (double)pos * (double)inv * 0.15915494309189535;
            const float fr = (float)(rev - __builtin_floor(rev));
            cosT[idx] = __builtin_amdgcn_cosf(fr); sinT[idx] = __builtin_amdgcn_sinf(fr); }
    }
}

template <bool FROM_PART>
__device__ __forceinline__ void norm_mod_phase(const Args& a, LAS unsigned char* lds, const float* xin, const float* gvec, int sh_chunk, int sc_chunk, bf16* outp) {
    const int tid = threadIdx.x, lane = tid & 63, wave = __builtin_amdgcn_readfirstlane(tid >> 6);
    LAS float* Av = (LAS float*)lds; LAS float* Bv = Av + 2048;
    const float* modp = (const float*)(a.ws + WS_MODP); const float* mod = (const float*)(a.ws + WS_MOD); const float* bada = a.in[I_BADA];
    int prev_b = -1;
    for (int rb = blockIdx.x; rb < M / 64; rb += gridDim.x) {
        const int b = rb >> 5;
        if (b != prev_b) {
            __syncthreads();
            for (int j = tid; j < 2048; j += 512) { float sh, sc;
                if (FROM_PART) { sh = bada[sh_chunk * 2048 + j]; sc = bada[sc_chunk * 2048 + j];
#pragma unroll
                    for (int kq = 0; kq < 4; ++kq) { sh += modp[((size_t)kq * 8 + b) * 12288 + sh_chunk * 2048 + j]; sc += modp[((size_t)kq * 8 + b) * 12288 + sc_chunk * 2048 + j]; } }
                else { sh = mod[b * 12288 + sh_chunk * 2048 + j]; sc = mod[b * 12288 + sc_chunk * 2048 + j]; }
                Av[j] = gvec[j] * (1.f + sc); Bv[j] = sh; }
            __syncthreads(); prev_b = b;
        }
        for (int rr = wave; rr < 64; rr += NWAVES) { const int row = rb * 64 + rr;
            const f32x4* xr = (const f32x4*)(xin + (size_t)row * D) + lane;
            f32x4 v[8]; float ss = 0.f;
#pragma unroll
            for (int j = 0; j < 8; ++j) { v[j] = xr[64 * j]; ss += (v[j][0] * v[j][0] + v[j][1] * v[j][1]) + (v[j][2] * v[j][2] + v[j][3] * v[j][3]); }
            const float rstd = rsqrtf(wave_sum(ss) * (1.f / 2048.f) + EPS);
            u32x2* o = (u32x2*)(outp + (size_t)row * D) + lane;
#pragma unroll
            for (int j = 0; j < 8; ++j) { const int col = 4 * lane + 256 * j; const f32x4 A4 = *(const LAS f32x4*)(Av + col), B4 = *(const LAS f32x4*)(Bv + col);
                const f32x4 y = v[j] * rstd * A4 + B4; u32x2 w; w.x = cvt_pk_bf16(y[0], y[1]); w.y = cvt_pk_bf16(y[2], y[3]); o[64 * j] = w; }
        }
    }
    if (FROM_PART) {
        float* modw = (float*)(a.ws + WS_MOD);
        for (int idx = blockIdx.x * 512 + tid; idx < 8 * 12288; idx += gridDim.x * 512) { const int b = idx / 12288, j = idx % 12288; float s = bada[j];
#pragma unroll
            for (int kq = 0; kq < 4; ++kq) s += modp[((size_t)kq * 8 + b) * 12288 + j];
            modw[idx] = s; }
    }
}

__device__ __forceinline__ void transpose_out(const LAS unsigned short* tl, int pitch, int C, bf16* dst, size_t ldT, int tid) {
    for (int idx = tid; idx < C * 8; idx += 512) { const int cc = idx >> 3, tc = (idx & 7) * 8;
        unsigned e[8];
#pragma unroll
        for (int i = 0; i < 8; ++i) e[i] = tl[(tc + i) * pitch + cc];
        u32x4 o; o.x = e[0] | (e[1] << 16); o.y = e[2] | (e[3] << 16); o.z = e[4] | (e[5] << 16); o.w = e[6] | (e[7] << 16);
        *(u32x4*)(dst + (size_t)cc * ldT + tc) = o; }
}
__device__ __forceinline__ void rot8(const u32x4 x1, const u32x4 x2, const float* cosT, const float* sinT, int t, int jc, float (&o1)[8], float (&o2)[8]) {
    const f32x4 c0 = *(const f32x4*)(cosT + t * 128 + jc), c1 = *(const f32x4*)(cosT + t * 128 + jc + 4), s0 = *(const f32x4*)(sinT + t * 128 + jc), s1 = *(const f32x4*)(sinT + t * 128 + jc + 4);
    const float a1[8] = {bflo(x1.x), bfhi(x1.x), bflo(x1.y), bfhi(x1.y), bflo(x1.z), bfhi(x1.z), bflo(x1.w), bfhi(x1.w)};
    const float a2[8] = {bflo(x2.x), bfhi(x2.x), bflo(x2.y), bfhi(x2.y), bflo(x2.z), bfhi(x2.z), bflo(x2.w), bfhi(x2.w)};
    const float cs[8] = {c0[0], c0[1], c0[2], c0[3], c1[0], c1[1], c1[2], c1[3]}, sn[8] = {s0[0], s0[1], s0[2], s0[3], s1[0], s1[1], s1[2], s1[3]};
#pragma unroll
    for (int i = 0; i < 8; ++i) { o1[i] = a1[i] * cs[i] - a2[i] * sn[i]; o2[i] = a1[i] * sn[i] + a2[i] * cs[i]; }
}
__device__ __forceinline__ u32x4 pack8f(const float (&o)[8], float sc) { u32x4 w; w.x = cvt_pk_bf16(o[0] * sc, o[1] * sc); w.y = cvt_pk_bf16(o[2] * sc, o[3] * sc); w.z = cvt_pk_bf16(o[4] * sc, o[5] * sc); w.w = cvt_pk_bf16(o[6] * sc, o[7] * sc); return w; }

__device__ __forceinline__ void phase3(const Args& a, LAS unsigned char* lds) {
    const int tid = threadIdx.x;
    unsigned char* ws = a.ws;
    const bf16* proj = (const bf16*)(ws + WS_PROJ);
    const float* cosT = (const float*)(ws + WS_COS); const float* sinT = (const float*)(ws + WS_SIN);
    bf16* Qr = (bf16*)(ws + WS_QR); bf16* Kr = (bf16*)(ws + WS_KR); bf16* KzT = (bf16*)(ws + WS_KZT); bf16* VT = (bf16*)(ws + WS_VT);
    bf16* kcmp = (bf16*)(ws + WS_KCMP); bf16* vcmp = (bf16*)(ws + WS_VCMP); bf16* vsT = (bf16*)(ws + WS_VST); bf16* vwT = (bf16*)(ws + WS_VWT);
    LAS unsigned short* tl = (LAS unsigned short*)lds; constexpr int P2 = 258;
    for (int it = blockIdx.x; it < NB * 32; it += gridDim.x) {
        const int b = it >> 5, t0 = (it & 31) * 64;
        const bf16* pr = proj + (size_t)(b * T + t0) * NP;
        for (int h = 0; h < 4; ++h) {
            const float lg = ret_lg(h);
            __syncthreads();
            for (int ch = tid; ch < 1024; ch += 512) { const int tk = ch >> 4, jc = (ch & 15) * 8, t = t0 + tk;
                const bf16* p = pr + (size_t)tk * NP + h * 256 + jc;
                float o1[8], o2[8];
                rot8(*(const u32x4*)(p + C_RK), *(const u32x4*)(p + C_RK + 128), cosT, sinT, t, jc, o1, o2);
                bf16* kd = Kr + ((size_t)(b * 4 + h) * T + t) * 256 + jc;
                *(u32x4*)kd = pack8f(o1, 0.0625f); *(u32x4*)(kd + 128) = pack8f(o2, 0.0625f);
                const float zs = 0.0625f * __expf(lg * (float)(127 - (t & 127)));
                const u32x4 z1 = pack8f(o1, zs), z2 = pack8f(o2, zs);
                LAS unsigned* d1 = (LAS unsigned*)(tl + tk * P2 + jc); d1[0] = z1.x; d1[1] = z1.y; d1[2] = z1.z; d1[3] = z1.w;
                LAS unsigned* d2 = (LAS unsigned*)(tl + tk * P2 + 128 + jc); d2[0] = z2.x; d2[1] = z2.y; d2[2] = z2.z; d2[3] = z2.w;
                rot8(*(const u32x4*)(p + C_RQ), *(const u32x4*)(p + C_RQ + 128), cosT, sinT, t, jc, o1, o2);
                bf16* qd = Qr + ((size_t)(b * 4 + h) * T + t) * 256 + jc;
                *(u32x4*)qd = pack8f(o1, 1.f); *(u32x4*)(qd + 128) = pack8f(o2, 1.f);
            }
            __syncthreads();
            transpose_out(tl, P2, 256, KzT + ((size_t)(b * 4 + h) * 256) * T + t0, T, tid);
            __syncthreads();
            for (int ch = tid; ch < 64 * 32; ch += 512) { const int tk = ch >> 5, dc = (ch & 31) * 8;
                const u32x4 v = *(const u32x4*)(pr + (size_t)tk * NP + C_RV + h * 256 + dc);
                LAS unsigned* d1 = (LAS unsigned*)(tl + tk * P2 + dc); d1[0] = v.x; d1[1] = v.y; d1[2] = v.z; d1[3] = v.w; }
            __syncthreads();
            transpose_out(tl, P2, 256, VT + ((size_t)(b * 4 + h) * 256) * T + t0, T, tid);
        }
        for (int g = 0; g < 2; ++g) {
            for (int ch = tid; ch < 1024; ch += 512) { const int tk = ch >> 4, dc = (ch & 15) * 8;
                const bf16* p = pr + (size_t)tk * NP + g * 128 + dc; const size_t o = ((size_t)(b * 2 + g) * T + t0 + tk) * 128 + dc;
                *(u32x4*)(kcmp + o) = *(const u32x4*)(p + C_KC); *(u32x4*)(vcmp + o) = *(const u32x4*)(p + C_VC); }
#pragma unroll
            for (int sel = 0; sel < 2; ++sel) {
                __syncthreads();
                for (int ch = tid; ch < 1024; ch += 512) { const int tk = ch >> 4, dc = (ch & 15) * 8;
                    const u32x4 v = *(const u32x4*)(pr + (size_t)tk * NP + (sel ? C_VW : C_VS) + g * 128 + dc);
                    LAS unsigned* d1 = (LAS unsigned*)(tl + tk * P2 + dc); d1[0] = v.x; d1[1] = v.y; d1[2] = v.z; d1[3] = v.w; }
                __syncthreads();
                transpose_out(tl, P2, 128, (sel ? vwT : vsT) + ((size_t)(b * 2 + g) * 128) * T + t0, T, tid);
            }
        }
    }
}

__device__ __forceinline__ void phase4(const Args& a, LAS unsigned char* lds) {
    const int tid = threadIdx.x, lane = tid & 63, wave = __builtin_amdgcn_readfirstlane(tid >> 6), q = lane >> 4, r = lane & 15;
    unsigned char* ws = a.ws;
    {
        const bf16* VT = (const bf16*)(ws + WS_VT); const bf16* KzT = (const bf16*)(ws + WS_KZT); bf16* SP = (bf16*)(ws + WS_SP);
        for (int it = blockIdx.x; it < 256; it += gridDim.x) {
            const int b = it >> 5, h = (it >> 3) & 3, es = it & 7;
            const float cd = __expf(ret_lg(h) * 128.f);
            const bf16* VTb = VT + ((size_t)(b * 4 + h) * 256 + es * 32) * T;
            const bf16* KzTb = KzT + ((size_t)(b * 4 + h) * 256 + wave * 32) * T;
            bf16* Sp = SP + (size_t)(b * 4 + h) * 16 * 65536;
            f32x4 S[2][2];
#pragma unroll
            for (int mt = 0; mt < 2; ++mt)
#pragma unroll
                for (int nt = 0; nt < 2; ++nt) S[mt][nt] = (f32x4){0.f, 0.f, 0.f, 0.f};
            for (int n = 0; n < 16; ++n) {
#pragma unroll
                for (int mt = 0; mt < 2; ++mt)
#pragma unroll
                    for (int nt = 0; nt < 2; ++nt) { const int e = es * 32 + 16 * mt + r, d = wave * 32 + 16 * nt + 4 * q;
                        u32x2 w; w.x = cvt_pk_bf16(S[mt][nt][0], S[mt][nt][1]); w.y = cvt_pk_bf16(S[mt][nt][2], S[mt][nt][3]);
                        *(u32x2*)(Sp + ((size_t)n * 256 + e) * 256 + d) = w; }
                if (n == 15) break;
#pragma unroll
                for (int mt = 0; mt < 2; ++mt)
#pragma unroll
                    for (int nt = 0; nt < 2; ++nt) S[mt][nt] = S[mt][nt] * cd;
#pragma unroll
                for (int k0 = 0; k0 < 128; k0 += 32) {
                    bf16x8 af[2], bfr[2];
#pragma unroll
                    for (int mt = 0; mt < 2; ++mt) af[mt] = *(const bf16x8*)(VTb + (size_t)(16 * mt + r) * T + n * 128 + k0 + 8 * q);
#pragma unroll
                    for (int nt = 0; nt < 2; ++nt) bfr[nt] = *(const bf16x8*)(KzTb + (size_t)(16 * nt + r) * T + n * 128 + k0 + 8 * q);
#pragma unroll
                    for (int mt = 0; mt < 2; ++mt)
#pragma unroll
                        for (int nt = 0; nt < 2; ++nt) S[mt][nt] = MFMA16(bfr[nt], af[mt], S[mt][nt]);
                }
            }
        }
    }
    {
        const int gw = blockIdx.x * NWAVES + wave, NGW = gridDim.x * NWAVES;
        for (int wi = gw; wi < 2048; wi += NGW) { const int ten = wi >> 10, rt = (wi >> 4) & 63, ct = wi & 15;
            const bf16* A = (const bf16*)(ws + (ten ? WS_VCMP : WS_KCMP)) + (size_t)(rt * 32) * 2048;
            const bf16* Bt = (const bf16*)(ws + (ten ? WS_W1V : WS_W1K)) + (size_t)(ct * 32) * 2048;
            f32x4 acc[2][2];
#pragma unroll
            for (int mt = 0; mt < 2; ++mt)
#pragma unroll
                for (int nt = 0; nt < 2; ++nt) acc[mt][nt] = (f32x4){0.f, 0.f, 0.f, 0.f};
#pragma unroll 2
            for (int k0 = 0; k0 < 2048; k0 += 32) {
                bf16x8 af[2], bfr[2];
#pragma unroll
                for (int mt = 0; mt < 2; ++mt) af[mt] = *(const bf16x8*)(A + (size_t)(16 * mt + r) * 2048 + k0 + 8 * q);
#pragma unroll
                for (int nt = 0; nt < 2; ++nt) bfr[nt] = *(const bf16x8*)(Bt + (size_t)(16 * nt + r) * 2048 + k0 + 8 * q);
#pragma unroll
                for (int mt = 0; mt < 2; ++mt)
#pragma unroll
                    for (int nt = 0; nt < 2; ++nt) acc[mt][nt] = MFMA16(bfr[nt], af[mt], acc[mt][nt]);
            }
            float* Y = (float*)(ws + (ten ? WS_YV : WS_YK));
#pragma unroll
            for (int mt = 0; mt < 2; ++mt)
#pragma unroll
                for (int nt = 0; nt < 2; ++nt) *(f32x4*)(Y + (size_t)(rt * 32 + 16 * mt + r) * 512 + ct * 32 + 16 * nt + 4 * q) = acc[mt][nt];
        }
    }
}

__device__ __forceinline__ void phase5(const Args& a, LAS unsigned char* lds) {
    const int tid = threadIdx.x, lane = tid & 63, wave = __builtin_amdgcn_readfirstlane(tid >> 6), q = lane >> 4, r = lane & 15;
    unsigned char* ws = a.ws;
    const int gw = blockIdx.x * NWAVES + wave, NGW = gridDim.x * NWAVES;
    for (int wi = gw; wi < 256; wi += NGW) { const int ten = wi >> 7, rt = wi & 127, row = rt * 16 + r, c = row & 127;
        const float* Y = (const float*)(ws + (ten ? WS_YV : WS_YK)); const float* bias = (const float*)(ws + (ten ? WS_BIAS1V : WS_BIAS1K));
        const bf16* W2T = (const bf16*)(ws + (ten ? WS_W2VT : WS_W2KT));
        f32x4 acc[8];
#pragma unroll
        for (int nt = 0; nt < 8; ++nt) acc[nt] = (f32x4){0.f, 0.f, 0.f, 0.f};
#pragma unroll
        for (int k0 = 0; k0 < 256; k0 += 32) { const int kk = k0 + 8 * q;
            bf16x8 af = (bf16x8){0, 0, 0, 0, 0, 0, 0, 0};
            if (c < 127) {
                const f32x4 y0 = *(const f32x4*)(Y + (size_t)row * 512 + kk), y1 = *(const f32x4*)(Y + (size_t)row * 512 + kk + 4);
                const f32x4 z0 = *(const f32x4*)(Y + (size_t)(row + 1) * 512 + 256 + kk), z1 = *(const f32x4*)(Y + (size_t)(row + 1) * 512 + 256 + kk + 4);
                const f32x4 b0 = *(const f32x4*)(bias + kk), b1 = *(const f32x4*)(bias + kk + 4);
                f32x4 h0 = y0 + z0 + b0, h1 = y1 + z1 + b1;
#pragma unroll
                for (int i = 0; i < 4; ++i) { h0[i] = silu_f(h0[i]); h1[i] = silu_f(h1[i]); }
                af = pack8(h0, h1);
            }
#pragma unroll
            for (int nt = 0; nt < 8; ++nt) { const bf16x8 bfr = *(const bf16x8*)(W2T + (size_t)(16 * nt + r) * 256 + kk); acc[nt] = MFMA16(bfr, af, acc[nt]); }
        }
        if (!ten) { bf16* kc = (bf16*)(ws + WS_KC);
#pragma unroll
            for (int nt = 0; nt < 8; ++nt) { u32x2 w; w.x = cvt_pk_bf16(acc[nt][0], acc[nt][1]); w.y = cvt_pk_bf16(acc[nt][2], acc[nt][3]); *(u32x2*)(kc + (size_t)row * 128 + 16 * nt + 4 * q) = w; }
        } else { bf16* vct = (bf16*)(ws + WS_VCT);
#pragma unroll
            for (int nt = 0; nt < 8; ++nt)
#pragma unroll
                for (int j = 0; j < 4; ++j) vct[((size_t)(row >> 7) * 128 + 16 * nt + 4 * q + j) * 128 + c] = (bf16)(cvt_pk_bf16(acc[nt][j], 0.f) & 0xffffu);
        }
    }
}

__device__ __forceinline__ void r2_item(const Args& a, int it) {
    int tid = threadIdx.x; asm volatile("" : "+v"(tid));
    const int lane = tid & 63, wave = __builtin_amdgcn_readfirstlane(tid >> 6), q = lane >> 4, r = lane & 15;
    unsigned char* ws = a.ws;
    const int b = it >> 6, h = (it >> 4) & 3, n = it & 15;
    const float lg = ret_lg(h);
    const int ti = 16 * wave + r;
    const bf16* Qrow = (const bf16*)(ws + WS_QR) + ((size_t)(b * 4 + h) * T + n * 128 + ti) * 256;
    const bf16* Kb = (const bf16*)(ws + WS_KR) + ((size_t)(b * 4 + h) * T + n * 128) * 256;
    const bf16* VTb = (const bf16*)(ws + WS_VT) + ((size_t)(b * 4 + h) * 256) * T + n * 128;
    const bf16* Sp = (const bf16*)(ws + WS_SP) + ((size_t)(b * 4 + h) * 16 + n) * 65536;
    f32x4 s[8];
#pragma unroll
    for (int nt = 0; nt < 8; ++nt) s[nt] = (f32x4){0.f, 0.f, 0.f, 0.f};
#pragma unroll 2
    for (int k0 = 0; k0 < 256; k0 += 32) { const bf16x8 af = *(const bf16x8*)(Qrow + k0 + 8 * q);
#pragma unroll
        for (int nt = 0; nt < 8; ++nt) { const bf16x8 bfr = *(const bf16x8*)(Kb + (size_t)(16 * nt + r) * 256 + k0 + 8 * q); s[nt] = MFMA16(bfr, af, s[nt]); } }
    bf16x8 pf[4];
#pragma unroll
    for (int nt = 0; nt < 8; ++nt)
#pragma unroll
        for (int j = 0; j < 4; ++j) { const int dd = ti - (16 * nt + 4 * q + j); s[nt][j] = dd >= 0 ? s[nt][j] * __expf(lg * (float)dd) : 0.f; }
#pragma unroll
    for (int ks = 0; ks < 4; ++ks) pf[ks] = pack8(s[2 * ks], s[2 * ks + 1]);
    f32x4 o[16];
#pragma unroll
    for (int nt = 0; nt < 16; ++nt) o[nt] = (f32x4){0.f, 0.f, 0.f, 0.f};
#pragma unroll 2
    for (int k0 = 0; k0 < 256; k0 += 32) { const bf16x8 af = *(const bf16x8*)(Qrow + k0 + 8 * q);
#pragma unroll
        for (int nt = 0; nt < 16; ++nt) { const bf16x8 bfr = *(const bf16x8*)(Sp + (size_t)(16 * nt + r) * 256 + k0 + 8 * q); o[nt] = MFMA16(bfr, af, o[nt]); } }
    const float qd = __expf(lg * (float)(ti + 1));
#pragma unroll
    for (int nt = 0; nt < 16; ++nt) o[nt] = o[nt] * qd;
#pragma unroll
    for (int ks = 0; ks < 4; ++ks)
#pragma unroll
        for (int nt = 0; nt < 16; ++nt) { const bf16* vp = VTb + (size_t)(16 * nt + r) * T + 32 * ks + 4 * q;
            const bf16x8 vf = cat4(*(const bf16x4*)vp, *(const bf16x4*)(vp + 16)); o[nt] = MFMA16(vf, pf[ks], o[nt]); }
    float sm = 0.f;
#pragma unroll
    for (int nt = 0; nt < 16; ++nt) sm += (o[nt][0] + o[nt][1]) + (o[nt][2] + o[nt][3]);
    sm += __shfl_xor(sm, 16); sm += __shfl_xor(sm, 32);
    const float mu = sm * (1.f / 256.f); float vs = 0.f;
#pragma unroll
    for (int nt = 0; nt < 16; ++nt) { const f32x4 d = o[nt] - mu; vs += (d[0] * d[0] + d[1] * d[1]) + (d[2] * d[2] + d[3] * d[3]); }
    vs += __shfl_xor(vs, 16); vs += __shfl_xor(vs, 32);
    const float rstd = rsqrtf(vs * (1.f / 256.f) + EPS);
    const size_t rowg = (size_t)b * T + n * 128 + ti;
    const bf16* gp = (const bf16*)(ws + WS_PROJ) + rowg * NP + C_RG + h * 256;
    const float* gn = a.in[I_GNG] + h * 256;
    bf16* op = (bf16*)(ws + WS_CAT) + rowg * 2048 + h * 256;
#pragma unroll
    for (int nt = 0; nt < 16; ++nt) { const int e = 16 * nt + 4 * q;
        const u32x2 gw2 = *(const u32x2*)(gp + e); const f32x4 g4 = *(const f32x4*)(gn + e);
        const float g0 = bflo(gw2.x), g1 = bfhi(gw2.x), g2 = bflo(gw2.y), g3 = bfhi(gw2.y);
        const float y0 = (o[nt][0] - mu) * rstd * g4[0] * silu_f(g0), y1 = (o[nt][1] - mu) * rstd * g4[1] * silu_f(g1);
        const float y2 = (o[nt][2] - mu) * rstd * g4[2] * silu_f(g2), y3 = (o[nt][3] - mu) * rstd * g4[3] * silu_f(g3);
        u32x2 w; w.x = cvt_pk_bf16(y0, y1); w.y = cvt_pk_bf16(y2, y3); *(u32x2*)(op + e) = w; }
}

constexpr float NSA_SCL = 0.08838834764831845f * 1.4426950408889634f;
constexpr int QP = 272, KP = 272, VP = 136, VCP = 264;
#ifndef NSA_NBR
#define NSA_NBR 2
#endif
constexpr int NSA_QS = 0, NSA_KS = 69632, NSA_VS = NSA_KS + 34816;

template <int S> __device__ __forceinline__ bf16x8 pack_step(const f32x16& x) {
    u32x4 p; p.x = cvt_pk_bf16(x[8 * S], x[8 * S + 1]); p.y = cvt_pk_bf16(x[8 * S + 2], x[8 * S + 3]); p.z = cvt_pk_bf16(x[8 * S + 4], x[8 * S + 5]); p.w = cvt_pk_bf16(x[8 * S + 6], x[8 * S + 7]);
    return __builtin_bit_cast(bf16x8, p);
}
__device__ __forceinline__ f32x16 zero16() { f32x16 z;
#pragma unroll
    for (int i = 0; i < 16; ++i) z[i] = 0.f;
    return z; }

__device__ __forceinline__ void attn_tile(const LAS unsigned char* qrow, const LAS unsigned char* Ks, const LAS unsigned char* Vs, int r, int h, float& m, float& l, f32x16 (&O)[4], int lo, int hi) {
    f32x16 st[2]; st[0] = zero16(); st[1] = zero16();
#pragma unroll
    for (int ks = 0; ks < 8; ++ks) { const bf16x8 qf = *(const LAS bf16x8*)(qrow + (16 * ks + 8 * h) * 2);
#pragma unroll
        for (int kb = 0; kb < 2; ++kb) { const bf16x8 kf = *(const LAS bf16x8*)(Ks + (32 * kb + r) * KP + (16 * ks + 8 * h) * 2); st[kb] = MFMA32(kf, qf, st[kb]); }
        if (ks & 1) asm volatile("" ::: "memory"); }
    float tmax = -1e30f;
#pragma unroll
    for (int kb = 0; kb < 2; ++kb)
#pragma unroll
        for (int reg = 0; reg < 16; ++reg) { constexpr int dummy = 0; (void)dummy; const int KC = 32 * kb + (reg & 3) + 8 * (reg >> 2); const float v = (KC > lo && KC <= hi) ? st[kb][reg] * NSA_SCL : -1e30f; st[kb][reg] = v; tmax = fmaxf(tmax, v); }
    tmax = fmaxf(tmax, __shfl_xor(tmax, 32));
    const float mn = fmaxf(m, tmax), alpha = __builtin_amdgcn_exp2f(m - mn);
    float rs = 0.f;
#pragma unroll
    for (int kb = 0; kb < 2; ++kb)
#pragma unroll
        for (int reg = 0; reg < 16; ++reg) { const float v = st[kb][reg]; const float p = v > -1e29f ? __builtin_amdgcn_exp2f(v - mn) : 0.f; st[kb][reg] = p; rs += p; }
    rs += __shfl_xor(rs, 32);
    l = l * alpha + rs; m = mn;
#pragma unroll
    for (int eb = 0; eb < 4; ++eb) O[eb] = O[eb] * alpha;
#pragma unroll
    for (int kb = 0; kb < 2; ++kb) {
        { const bf16x8 pf = pack_step<0>(st[kb]);
#pragma unroll
          for (int eb = 0; eb < 4; ++eb) { const LAS unsigned char* vp = Vs + (32 * eb + r) * VP + (32 * kb + 4 * h) * 2; const bf16x8 vf = cat4(*(const LAS bf16x4*)vp, *(const LAS bf16x4*)(vp + 16)); O[eb] = MFMA32(vf, pf, O[eb]); } }
        asm volatile("" ::: "memory");
        { const bf16x8 pf = pack_step<1>(st[kb]);
#pragma unroll
          for (int eb = 0; eb < 4; ++eb) { const LAS unsigned char* vp = Vs + (32 * eb + r) * VP + (32 * kb + 16 + 4 * h) * 2; const bf16x8 vf = cat4(*(const LAS bf16x4*)vp, *(const LAS bf16x4*)(vp + 16)); O[eb] = MFMA32(vf, pf, O[eb]); } }
        asm volatile("" ::: "memory");
    }
}

__device__ __forceinline__ void nsa_item(const Args& a, LAS unsigned char* lds, int item) {
    int tid = threadIdx.x; asm volatile("" : "+v"(tid));
    const int lane = tid & 63, w = __builtin_amdgcn_readfirstlane(tid >> 6), h = lane >> 5, r = lane & 31;
    unsigned char* ws = a.ws;
    const int bg = item & 15, qt = 31 - (item >> 4), b = bg >> 1, g = bg & 1, t0 = qt * 64, cur = qt;
    const bf16* proj = (const bf16*)(ws + WS_PROJ);
    LAS unsigned char* Qs = lds + NSA_QS; LAS unsigned char* Ks = lds + NSA_KS; LAS unsigned char* Vs = lds + NSA_VS;
    LAS unsigned* bmask = (LAS unsigned*)(lds + MISC_OFF + 64);
    const int tok = t0 + 8 * w + (r >> 2), head = r & 3;
    const LAS unsigned char* qrow = Qs + (32 * w + r) * QP;
    __syncthreads();
    if (tid == 0) *bmask = 0u;
    for (int ch = tid; ch < 4096; ch += 512) { const int row = ch >> 4, dc = (ch & 15) * 8;
        *(LAS u32x4*)(Qs + row * QP + dc * 2) = *(const u32x4*)(proj + (size_t)(b * T + t0 + (row >> 2)) * NP + C_NQ + (g * 4 + (row & 3)) * 128 + dc); }
    { const bf16* kc = (const bf16*)(ws + WS_KC) + (size_t)bg * 16384; const bf16* vct = (const bf16*)(ws + WS_VCT) + (size_t)bg * 16384;
      for (int ch = tid; ch < 2048; ch += 512) { const int row = ch >> 4, dc = (ch & 15) * 8;
          *(LAS u32x4*)(Ks + row * KP + dc * 2) = *(const u32x4*)(kc + row * 128 + dc);
          const u32x4 v = *(const u32x4*)(vct + row * 128 + dc); LAS u32x2* d = (LAS u32x2*)(Vs + row * VCP + dc * 2); d[0] = (u32x2){v.x, v.y}; d[1] = (u32x2){v.z, v.w}; } }
    __syncthreads();
    float gt0, gt1, gt2;
    { const bf16* gp = proj + (size_t)(b * T + tok) * NP + C_NG + (g * 4 + head) * 3; gt0 = sigmoid_f(bf2f(gp[0])); gt1 = sigmoid_f(bf2f(gp[1])); gt2 = sigmoid_f(bf2f(gp[2])); }
    unsigned selmask;
    bf16* op = (bf16*)(ws + WS_CAT) + (size_t)(b * T + tok) * 2048 + 1024 + (g * 4 + head) * 128;
    {
        f32x16 st[4]; f32x16 Ot[4];
#pragma unroll
        for (int kb = 0; kb < 4; ++kb) st[kb] = zero16();
#pragma unroll
        for (int ks = 0; ks < 8; ++ks) { const bf16x8 qf = *(const LAS bf16x8*)(qrow + (16 * ks + 8 * h) * 2);
#pragma unroll
            for (int kb = 0; kb < 4; ++kb) { const bf16x8 kf = *(const LAS bf16x8*)(Ks + (32 * kb + r) * KP + (16 * ks + 8 * h) * 2); st[kb] = MFMA32(kf, qf, st[kb]); }
            asm volatile("" ::: "memory"); }
        float mx = -1e30f;
        const int clim = (tok - 31) >> 4;
        const int climh = (clim < 126 ? clim : 126) - 4 * h;
#pragma unroll
        for (int kb = 0; kb < 4; ++kb)
#pragma unroll
            for (int reg = 0; reg < 16; ++reg) { const int KC = 32 * kb + (reg & 3) + 8 * (reg >> 2);
                const float v = (KC <= climh) ? st[kb][reg] * NSA_SCL : -1e30f; st[kb][reg] = v; mx = fmaxf(mx, v); }
        mx = fmaxf(mx, __shfl_xor(mx, 32));
        float sm = 0.f;
#pragma unroll
        for (int kb = 0; kb < 4; ++kb)
#pragma unroll
            for (int reg = 0; reg < 16; ++reg) { const float v = st[kb][reg]; const float p = v > -1e29f ? __builtin_amdgcn_exp2f(v - mx) : 0.f; st[kb][reg] = p; sm += p; }
        sm += __shfl_xor(sm, 32);
        const float inv = sm > 0.f ? 1.f / sm : 0.f;
#pragma unroll
        for (int kb = 0; kb < 4; ++kb) st[kb] = st[kb] * inv;
        float imp[16], lastv[16];
#pragma unroll
        for (int i = 0; i < 16; ++i) { const int kb = i >> 2, rq = i & 3; imp[i] = (st[kb][4 * rq] + st[kb][4 * rq + 1]) + (st[kb][4 * rq + 2] + st[kb][4 * rq + 3]); lastv[i] = __shfl_xor(st[kb][4 * rq + 3], 32); }
#pragma unroll
        for (int i = 0; i < 16; ++i) { const float prev = h ? lastv[i] : (i > 0 ? lastv[i > 0 ? i - 1 : 0] : 0.f); imp[i] += prev; }
#pragma unroll
        for (int i = 0; i < 16; ++i) { imp[i] += __shfl_xor(imp[i], 1); imp[i] += __shfl_xor(imp[i], 2); }
        float sc[16], so[16];
#pragma unroll
        for (int i = 0; i < 16; ++i) { const int s = 2 * i + h; const bool forced = (s == 0) || (s == cur) || (s == cur - 1); sc[i] = s <= cur ? imp[i] + (forced ? 1e4f : 0.f) : -1.f; }
#pragma unroll
        for (int i = 0; i < 16; ++i) so[i] = __shfl_xor(sc[i], 32);
        unsigned mine = 0u;
#pragma unroll
        for (int i = 0; i < 16; ++i) { int rank = 0;
#pragma unroll
            for (int i2 = 0; i2 < 16; ++i2) {
                rank += (sc[i2] > sc[i] || (sc[i2] == sc[i] && i2 < i)) ? 1 : 0;
                const bool lower = h ? (i2 <= i) : (i2 < i);
                rank += (so[i2] > sc[i] || (so[i2] == sc[i] && lower)) ? 1 : 0; }
            if (rank < 16 && (2 * i + h) <= cur) mine |= 1u << (2 * i + h); }
        selmask = mine | __shfl_xor(mine, 32);
        if ((lane & 35) == 0) __hip_atomic_fetch_or(bmask, selmask, __ATOMIC_RELAXED, __HIP_MEMORY_SCOPE_WORKGROUP);
#pragma unroll
        for (int eb = 0; eb < 4; ++eb) Ot[eb] = zero16();
#pragma unroll
        for (int kb = 0; kb < 4; ++kb) {
            { const bf16x8 pf = pack_step<0>(st[kb]);
#pragma unroll
              for (int eb = 0; eb < 4; ++eb) { const LAS unsigned char* vp = Vs + (32 * eb + r) * VCP + (32 * kb + 4 * h) * 2; const bf16x8 vf = cat4(*(const LAS bf16x4*)vp, *(const LAS bf16x4*)(vp + 16)); Ot[eb] = MFMA32(vf, pf, Ot[eb]); } }
            asm volatile("" ::: "memory");
            { const bf16x8 pf = pack_step<1>(st[kb]);
#pragma unroll
              for (int eb = 0; eb < 4; ++eb) { const LAS unsigned char* vp = Vs + (32 * eb + r) * VCP + (32 * kb + 16 + 4 * h) * 2; const bf16x8 vf = cat4(*(const LAS bf16x4*)vp, *(const LAS bf16x4*)(vp + 16)); Ot[eb] = MFMA32(vf, pf, Ot[eb]); } }
            asm volatile("" ::: "memory");
        }
#pragma unroll
        for (int eb = 0; eb < 4; ++eb)
#pragma unroll
            for (int rq = 0; rq < 4; ++rq) { u32x2 wv; wv.x = cvt_pk_bf16(Ot[eb][4 * rq] * gt0, Ot[eb][4 * rq + 1] * gt0); wv.y = cvt_pk_bf16(Ot[eb][4 * rq + 2] * gt0, Ot[eb][4 * rq + 3] * gt0);
                *(u32x2*)(op + 32 * eb + 8 * rq + 4 * h) = wv; }
    }
    __syncthreads();
    const unsigned blockmask = *bmask;
#pragma unroll 1
    for (int br = 0; br < NSA_NBR; ++br) {
        f32x16 O[4];
#pragma unroll
        for (int eb = 0; eb < 4; ++eb) O[eb] = zero16();
        float m = -1e30f, l = 0.f;
        const int kcol = (br ? C_KW : C_KS) + g * 128;
        const bf16* vT = (const bf16*)(ws + (br ? WS_VWT : WS_VST)) + (size_t)bg * 128 * T;
        const int jlo = br ? (cur > 8 ? cur - 8 : 0) : 0;
#pragma unroll 1
        for (int j = jlo; j <= cur; ++j) {
            if (!br && !((blockmask >> j) & 1u)) continue;
            __syncthreads();
            for (int ch = tid; ch < 1024; ch += 512) { const int kk = ch >> 4, dc = (ch & 15) * 8;
                *(LAS u32x4*)(Ks + kk * KP + dc * 2) = *(const u32x4*)(proj + (size_t)(b * T + 64 * j + kk) * NP + kcol + dc); }
            for (int ch = tid; ch < 1024; ch += 512) { const int e = ch >> 3, k8 = (ch & 7) * 8;
                const u32x4 v = *(const u32x4*)(vT + (size_t)e * T + 64 * j + k8); LAS u32x2* d = (LAS u32x2*)(Vs + e * VP + k8 * 2); d[0] = (u32x2){v.x, v.y}; d[1] = (u32x2){v.z, v.w}; }
            __syncthreads();
            const int kbase = 64 * j;
            if (!br) {
                const bool mysel = (selmask >> j) & 1u;
                if (__ballot(mysel) != 0ull) attn_tile(qrow, Ks, Vs, r, h, m, l, O, -1000000, mysel ? (tok - kbase - 4 * h) : -1000000);
            } else {
                attn_tile(qrow, Ks, Vs, r, h, m, l, O, tok - kbase - 4 * h - 512, tok - kbase - 4 * h);
            }
        }
        const float sc = (l > 0.f ? 1.f / l : 0.f) * (br ? gt2 : gt1);
        VM_WAIT();
#pragma unroll
        for (int eb = 0; eb < 4; ++eb)
#pragma unroll
            for (int rq = 0; rq < 4; ++rq) { u32x2* p = (u32x2*)(op + 32 * eb + 8 * rq + 4 * h); const u32x2 old = *p;
                u32x2 wv; wv.x = cvt_pk_bf16(bflo(old.x) + O[eb][4 * rq] * sc, bfhi(old.x) + O[eb][4 * rq + 1] * sc); wv.y = cvt_pk_bf16(bflo(old.y) + O[eb][4 * rq + 2] * sc, bfhi(old.y) + O[eb][4 * rq + 3] * sc);
                *p = wv; }
    }
}

__device__ __forceinline__ void phase6(const Args& a, LAS unsigned char* lds) {
    for (int it = blockIdx.x; it < 1024; it += gridDim.x) {
#if defined(P6_ONLY_NSA)
        if (it < 512) nsa_item(a, lds, it);
#elif defined(P6_ONLY_R2)
        if (it >= 512) r2_item(a, it - 512);
#else
        if (it < 512) nsa_item(a, lds, it); else r2_item(a, it - 512);
#endif
    }
}

__device__ __forceinline__ void phase9(const Args& a, LAS unsigned char* lds) {
    const int tid = threadIdx.x, lane = tid & 63, wave = __builtin_amdgcn_readfirstlane(tid >> 6), q = lane >> 4, r = lane & 15;
    unsigned char* ws = a.ws;
    const bf16* h2 = (const bf16*)(ws + WS_H); const bf16* wrt = (const bf16*)(ws + WS_WRT);
    const float* bgrp = a.in[I_BGRP]; const float* bexp = a.in[I_BEXP];
    unsigned* cnt = (unsigned*)(ws + WS_CTL) + CW_CNT; int* asg = (int*)(ws + WS_ASG); float* rw = (float*)(ws + WS_RW);
    LAS float* lg = (LAS float*)(lds + wave * 8192);
    const int gw = blockIdx.x * NWAVES + wave, NGW = gridDim.x * NWAVES;
    for (int wi = gw; wi < M / 16; wi += NGW) {
        const bf16* A = h2 + (size_t)(wi * 16 + r) * D;
        f32x4 acc[5];
#pragma unroll
        for (int nt = 0; nt < 5; ++nt) acc[nt] = (f32x4){0.f, 0.f, 0.f, 0.f};
#pragma unroll 2
        for (int k0 = 0; k0 < D; k0 += 32) { const bf16x8 af = *(const bf16x8*)(A + k0 + 8 * q);
#pragma unroll
            for (int nt = 0; nt < 5; ++nt) { const bf16x8 bfr = *(const bf16x8*)(wrt + (size_t)(16 * nt + r) * D + k0 + 8 * q); acc[nt] = MFMA16(bfr, af, acc[nt]); } }
#pragma unroll
        for (int nt = 0; nt < 5; ++nt) *(LAS f32x4*)(lg + r * 84 + 16 * nt + 4 * q) = acc[nt];
        LDS_WAIT();
        if (lane < 16) {
            const int tok = wi * 16 + lane; const LAS float* L = lg + lane * 84;
            float gl[8]; float gmax = -3.0e38f; int gi = 0;
#pragma unroll
            for (int i = 0; i < 8; ++i) { gl[i] = L[i] + bgrp[i]; if (gl[i] > gmax) { gmax = gl[i]; gi = i; } }
            float gs = 0.f;
#pragma unroll
            for (int i = 0; i < 8; ++i) gs += __expf(gl[i] - gmax);
            const float pg = 1.f / gs;
            float el[8]; float m1 = -3.0e38f; int i1 = 0;
#pragma unroll
            for (int i = 0; i < 8; ++i) { el[i] = L[8 + gi * 8 + i] + bexp[gi * 8 + i]; if (el[i] > m1) { m1 = el[i]; i1 = i; } }
            float m2 = -3.0e38f; int i2 = 0;
#pragma unroll
            for (int i = 0; i < 8; ++i) { if (i != i1 && el[i] > m2) { m2 = el[i]; i2 = i; } }
            const float e2 = __expf(m2 - m1); const float w1 = pg / (1.f + e2), w2 = pg * e2 / (1.f + e2);
            const int ea = gi * 8 + i1, eb = gi * 8 + i2;
            const unsigned pa = atomicAdd(cnt + ea, 1u); asg[(size_t)ea * CAP + pa] = tok * 2;     rw[(size_t)ea * CAP + pa] = w1;
            const unsigned pb = atomicAdd(cnt + eb, 1u); asg[(size_t)eb * CAP + pb] = tok * 2 + 1; rw[(size_t)eb * CAP + pb] = w2;
        }
        LDS_WAIT();
    }
}

__device__ __forceinline__ void moe_tables(const Args& a, LAS unsigned char* lds) {
    const int tid = threadIdx.x;
    LAS int* cntL = (LAS int*)lds; LAS int* tstart = cntL + 64; LAS int* off = tstart + 80;
    const unsigned* cnt = (const unsigned*)(a.ws + WS_CTL) + CW_CNT;
    __syncthreads();
    if (tid < 64) cntL[tid] = (int)__hip_atomic_load(cnt + tid, __ATOMIC_RELAXED, __HIP_MEMORY_SCOPE_AGENT);
    __syncthreads();
    if (tid == 0) { int ts = 0, o = 0; for (int e = 0; e < 64; ++e) { tstart[e] = ts; off[e] = o; ts += (cntL[e] + 63) >> 6; o += ((cntL[e] + 255) >> 8) << 8; } tstart[64] = ts; }
    __syncthreads();
}
__device__ __forceinline__ void phase10(const Args& a, LAS unsigned char* lds) {
    const int tid = threadIdx.x, lane = tid & 63, wave = __builtin_amdgcn_readfirstlane(tid >> 6), q = lane >> 4, r = lane & 15;
    unsigned char* ws = a.ws;
    moe_tables(a, lds);
    const LAS int* cntL = (const LAS int*)lds; const LAS int* tstart = cntL + 64; const LAS int* off = tstart + 80;
    const bf16* h2 = (const bf16*)(ws + WS_H); const bf16* wgu = (const bf16*)(ws + WS_WGU); const int* asg = (const int*)(ws + WS_ASG); bf16* abuf = (bf16*)(ws + WS_A);
    const int total = tstart[64] * 16;
    const int gw = blockIdx.x * NWAVES + wave, NGW = gridDim.x * NWAVES;
    for (int wi = gw; wi < total; wi += NGW) {
        const int tile = wi >> 4, ct = wi & 15;
        int e = 0; while (tstart[e + 1] <= tile) ++e;
        const int rt = tile - tstart[e], ne = cntL[e];
        const bf16* arow[4]; const bf16* brow[4];
#pragma unroll
        for (int mt = 0; mt < 4; ++mt) { const int p = rt * 64 + 16 * mt + r; const int tok = p < ne ? (asg[(size_t)e * CAP + p] >> 1) : 0; arow[mt] = h2 + (size_t)tok * D + 8 * q; }
#pragma unroll
        for (int nt = 0; nt < 4; ++nt) { const int c = ct * 32 + 16 * (nt & 1) + r; brow[nt] = wgu + ((size_t)e * 1024 + (c >> 7) * 256 + (nt >> 1) * 128 + (c & 127)) * D + 8 * q; }
        f32x4 acc[4][4];
#pragma unroll
        for (int mt = 0; mt < 4; ++mt)
#pragma unroll
            for (int nt = 0; nt < 4; ++nt) acc[mt][nt] = (f32x4){0.f, 0.f, 0.f, 0.f};
        for (int k0 = 0; k0 < D; k0 += 32) {
            bf16x8 af[4], bfr[4];
#pragma unroll
            for (int mt = 0; mt < 4; ++mt) af[mt] = *(const bf16x8*)(arow[mt] + k0);
#pragma unroll
            for (int nt = 0; nt < 4; ++nt) bfr[nt] = *(const bf16x8*)(brow[nt] + k0);
#pragma unroll
            for (int mt = 0; mt < 4; ++mt)
#pragma unroll
                for (int nt = 0; nt < 4; ++nt) acc[mt][nt] = MFMA16(bfr[nt], af[mt], acc[mt][nt]);
        }
#pragma unroll
        for (int mt = 0; mt < 4; ++mt) { const int p = rt * 64 + 16 * mt + r;
            if (p < ne) {
#pragma unroll
                for (int n2 = 0; n2 < 2; ++n2) { const f32x4 gv = acc[mt][n2], uv = acc[mt][n2 + 2];
                    u32x2 w; w.x = cvt_pk_bf16(silu_f(gv[0]) * uv[0], silu_f(gv[1]) * uv[1]); w.y = cvt_pk_bf16(silu_f(gv[2]) * uv[2], silu_f(gv[3]) * uv[3]);
                    *(u32x2*)(abuf + (size_t)(off[e] + p) * DE + ct * 32 + 16 * n2 + 4 * q) = w; } } }
    }
}
__device__ __forceinline__ void phase11(const Args& a, LAS unsigned char* lds) {
    const int tid = threadIdx.x, lane = tid & 63, wave = __builtin_amdgcn_readfirstlane(tid >> 6), q = lane >> 4, r = lane & 15;
    unsigned char* ws = a.ws;
    moe_tables(a, lds);
    const LAS int* cntL = (const LAS int*)lds; const LAS int* tstart = cntL + 64; const LAS int* off = tstart + 80;
    const bf16* abuf = (const bf16*)(ws + WS_A); const bf16* wd = (const bf16*)(ws + WS_WD); const int* asg = (const int*)(ws + WS_ASG); const float* rw = (const float*)(ws + WS_RW);
    bf16* ybuf = (bf16*)(ws + WS_Y);
    const int total = tstart[64] * 32;
    const int gw = blockIdx.x * NWAVES + wave, NGW = gridDim.x * NWAVES;
    for (int wi = gw; wi < total; wi += NGW) {
        const int tile = wi >> 5, ct = wi & 31;
        int e = 0; while (tstart[e + 1] <= tile) ++e;
        const int rt = tile - tstart[e], ne = cntL[e];
        const bf16* arow[4]; const bf16* brow[4];
#pragma unroll
        for (int mt = 0; mt < 4; ++mt) { const int p = rt * 64 + 16 * mt + r; arow[mt] = abuf + (size_t)(off[e] + (p < ne ? p : 0)) * DE + 8 * q; }
#pragma unroll
        for (int nt = 0; nt < 4; ++nt) brow[nt] = wd + ((size_t)e * 2048 + ct * 64 + 16 * nt + r) * DE + 8 * q;
        f32x4 acc[4][4];
#pragma unroll
        for (int mt = 0; mt < 4; ++mt)
#pragma unroll
            for (int nt = 0; nt < 4; ++nt) acc[mt][nt] = (f32x4){0.f, 0.f, 0.f, 0.f};
        for (int k0 = 0; k0 < DE; k0 += 32) {
            bf16x8 af[4], bfr[4];
#pragma unroll
            for (int mt = 0; mt < 4; ++mt) af[mt] = *(const bf16x8*)(arow[mt] + k0);
#pragma unroll
            for (int nt = 0; nt < 4; ++nt) bfr[nt] = *(const bf16x8*)(brow[nt] + k0);
#pragma unroll
            for (int mt = 0; mt < 4; ++mt)
#pragma unroll
                for (int nt = 0; nt < 4; ++nt) acc[mt][nt] = MFMA16(bfr[nt], af[mt], acc[mt][nt]);
        }
#pragma unroll
        for (int mt = 0; mt < 4; ++mt) { const int p = rt * 64 + 16 * mt + r;
            if (p < ne) { const int av = asg[(size_t)e * CAP + p]; const float wv = rw[(size_t)e * CAP + p];
#pragma unroll
                for (int nt = 0; nt < 4; ++nt) { const f32x4 v = acc[mt][nt] * wv; u32x2 w; w.x = cvt_pk_bf16(v[0], v[1]); w.y = cvt_pk_bf16(v[2], v[3]);
                    *(u32x2*)(ybuf + (size_t)av * D + ct * 64 + 16 * nt + 4 * q) = w; } } }
    }
}

template <bool WITH_MOE>
__device__ __forceinline__ void phase12(const Args& a) {
    const int tid = threadIdx.x, lane = tid & 63, wave = __builtin_amdgcn_readfirstlane(tid >> 6);
    const float* mod = (const float*)(a.ws + WS_MOD); const bf16* ybuf = (const bf16*)(a.ws + WS_Y); const float* fg = a.in[I_FG];
    const int gw = blockIdx.x * NWAVES + wave, NGW = gridDim.x * NWAVES;
    for (int row = gw; row < M; row += NGW) {
        const int b = row >> 11;
        f32x4* xr = (f32x4*)(a.out + (size_t)row * D) + lane;
        const u32x2* y0 = (const u32x2*)(ybuf + (size_t)(2 * row) * D) + lane; const u32x2* y1 = (const u32x2*)(ybuf + (size_t)(2 * row + 1) * D) + lane;
        const f32x4* g2 = (const f32x4*)(mod + (size_t)b * 12288 + 5 * 2048) + lane;
        f32x4 v[8]; float ss = 0.f;
#pragma unroll
        for (int j = 0; j < 8; ++j) { v[j] = xr[64 * j];
            if (WITH_MOE) { const u32x2 p0 = y0[64 * j], p1 = y1[64 * j]; const f32x4 gg = g2[64 * j];
                v[j][0] += gg[0] * (bflo(p0.x) + bflo(p1.x)); v[j][1] += gg[1] * (bfhi(p0.x) + bfhi(p1.x)); v[j][2] += gg[2] * (bflo(p0.y) + bflo(p1.y)); v[j][3] += gg[3] * (bfhi(p0.y) + bfhi(p1.y)); }
            ss += (v[j][0] * v[j][0] + v[j][1] * v[j][1]) + (v[j][2] * v[j][2] + v[j][3] * v[j][3]); }
        const float rstd = rsqrtf(wave_sum(ss) * (1.f / 2048.f) + EPS);
#pragma unroll
        for (int j = 0; j < 8; ++j) { const f32x4 f4 = *((const f32x4*)fg + lane + 64 * j); xr[64 * j] = v[j] * rstd * f4; }
    }
}

constexpr int NPHASES = 13;
#ifndef MK_N_LAUNCHES
#define MK_N_LAUNCHES 1
#endif
__global__ void __launch_bounds__(NWAVES * 64, 2) fwd(Args a) {
    extern __shared__ __attribute__((aligned(16))) unsigned char lds_raw[];
    LAS unsigned char* lds = (LAS unsigned char*)lds_raw;
    const int tid = threadIdx.x;
    if (tid < 64) ((LAS unsigned*)(lds + MISC_OFF))[tid] = 0u;
    __syncthreads();
    XcdBarrier bar; bar.bar = (unsigned*)(a.ws + WS_CTL) + CW_BAR; bar.x = 0; bar.st = nullptr;
    if (a.ph_hi - a.ph_lo > 1) bar = xcd_barrier_post((unsigned*)(a.ws + WS_CTL) + CW_BAR, (volatile LAS unsigned*)(lds + MISC_OFF) + 8);
    unsigned char* ws = a.ws;
#ifndef ONLY_PHASE
#define ONLY_PHASE -1
#endif
#define IN(k) ((ONLY_PHASE < 0 || ONLY_PHASE == (k)) && a.ph_lo <= (k) && (k) < a.ph_hi)
#define SEAM(k) do { if (IN(k) && IN((k) + 1)) xcd_barrier(bar); } while (0)
    if (IN(0)) phase0(a, lds);
    SEAM(0);
    if (IN(1)) norm_mod_phase<true>(a, lds, a.in[I_X], a.in[I_N1G], 0, 1, (bf16*)(ws + WS_H));
    SEAM(1);
    if (IN(2)) { pg8::Gemm g{(const bf16*)(ws + WS_H), (const bf16*)(ws + WS_WIN), M, NP, D}; pg8::StaticOrder S; S.init(M, NP, (int)gridDim.x, (int)blockIdx.x);
        pg8::EpiBf16 E{(bf16*)(ws + WS_PROJ), NP};
        pg8::gemm_phase<pg8::EpiBf16, pg8::StaticOrder, true, true>(lds, g, S, E); }
    SEAM(2);
    if (IN(3)) phase3(a, lds);
    SEAM(3);
    if (IN(4)) phase4(a, lds);
    SEAM(4);
    if (IN(5)) phase5(a, lds);
    SEAM(5);
    if (IN(6)) phase6(a, lds);
    SEAM(6);
    if (IN(7)) { pg8::Gemm g{(const bf16*)(ws + WS_CAT), (const bf16*)(ws + WS_WOUT), M, D, D}; pg8::StaticOrder S; S.init(M, D, (int)gridDim.x, (int)blockIdx.x);
        pg8::EpiResGate E{a.in[I_X], a.out, D, (const float*)(ws + WS_MOD) + 2 * 2048, 12288, T};
        pg8::gemm_phase<pg8::EpiResGate, pg8::StaticOrder, true, true>(lds, g, S, E); }
    SEAM(7);
    if (IN(8)) norm_mod_phase<false>(a, lds, a.out, a.in[I_N2G], 3, 4, (bf16*)(ws + WS_H));
    SEAM(8);
    if (IN(9)) phase9(a, lds);
    SEAM(9);
    if (IN(10)) phase10(a, lds);
    SEAM(10);
    if (IN(11)) phase11(a, lds);
    SEAM(11);
    if (IN(12)) phase12<true>(a);
#undef IN
#undef SEAM
}

extern "C" void kernel_launch(void* const* d_in, const int* in_sizes, int n_in, void* d_out, int out_size, void* d_ws, size_t ws_size, hipStream_t stream) {
    static int grid = 0;
    if (grid == 0) {
        if (n_in != 23 || out_size != M * D || ws_size < WS_END) { fprintf(stderr, "kernel_launch: unexpected shapes (n_in %d, out %d, ws %zu < %zu); nothing launched\n", n_in, out_size, ws_size, (size_t)WS_END); grid = -1; return; }
        int dev = 0, cus = 0, per_cu = 0;
        if (hipGetDevice(&dev) != hipSuccess || hipDeviceGetAttribute(&cus, hipDeviceAttributeMultiprocessorCount, dev) != hipSuccess) { grid = -1; return; }
        if (hipFuncSetAttribute((const void*)fwd, hipFuncAttributeMaxDynamicSharedMemorySize, LDS_BYTES) != hipSuccess) { fprintf(stderr, "kernel_launch: hipFuncSetAttribute failed\n"); grid = -1; return; }
        if (hipOccupancyMaxActiveBlocksPerMultiprocessor(&per_cu, (const void*)fwd, NWAVES * 64, LDS_BYTES) != hipSuccess || per_cu < 1) fprintf(stderr, "kernel_launch: occupancy query reports %d\n", per_cu);
        (void)hipGetLastError();
        grid = cus;
    }
    if (grid < 0) return;
    if (hipMemsetAsync((char*)d_ws + WS_CTL, 0, CTL_ZERO_BYTES, stream) != hipSuccess) return;
    Args a{};
    for (int i = 0; i < 23; ++i) a.in[i] = (const float*)d_in[i];
    a.out = (float*)d_out; a.ws = (unsigned char*)d_ws;
    constexpr int NL = MK_N_LAUNCHES;
    for (int li = 0; li < NL; ++li) {
        a.ph_lo = (NL == 1) ? 0 : li; a.ph_hi = (NL == 1) ? NPHASES : li + 1;
        hipLaunchKernelGGL(fwd, dim3(grid), dim3(NWAVES * 64), LDS_BYTES, stream, a);
        const hipError_t le = hipPeekAtLastError();
        if (le != hipSuccess) { fprintf(stderr, "kernel_launch: launch %d failed: %s\n", li, hipGetErrorName(le)); break; }
    }
}
```

```cpp
#include <hip/hip_runtime.h>
#include <cstdio>
#include <cstdint>
namespace pg8 {
#define PG8_LAS __attribute__((address_space(3)))
typedef unsigned short bf16_t;
typedef short bf16x8 __attribute__((ext_vector_type(8)));
typedef float f32x4 __attribute__((ext_vector_type(4)));
typedef unsigned u32x4 __attribute__((ext_vector_type(4)));
constexpr int BM = 256, BK = 64, HALF = 128, HTB = HALF * BK * 2  , STAGE_BYTES = 8 * HTB, NXCD = 8, WGM = 8;

__host__ __device__ __forceinline__ int lds_byte(int r, int c) { const int st = (r >> 4) * 2 + (c >> 5), rr = r & 15, cc = c & 31, ob = rr * 64 + cc * 2; return st * 1024 + (ob ^ (((ob >> 9) & 1) << 5)); }
__host__ __device__ __forceinline__ void stage_rc(int b, int& R, int& C) { const int st = b / 1024, sb = b % 1024, swz = sb ^ (((sb >> 9) & 1) << 5); R = (st >> 1) * 16 + swz / 64; C = (st & 1) * 32 + (swz % 64) / 2; }
__host__ __device__ __forceinline__ int perm32(int rho) { const int n = rho >> 4, i = rho & 15; return 8 * (i >> 2) + 4 * n + (i & 3); }

struct Unit { int pm, pn, e, ord; };
struct Gemm { const bf16_t* A; const bf16_t* Bt; int M, N, K; };

struct StaticOrder {
    int nM, nN, nwg, G, c;
    __host__ __device__ void init(int M, int N, int G_, int c_) { nM = M / BM; nN = N / BM; nwg = nM * nN; G = G_; c = c_; }
    __host__ __device__ bool next(int i, Unit& u) const {
        const long L = (long)i * G + c; if (L >= nwg) return false;
        int wgid = (int)L; { const int q = nwg / NXCD, r = nwg % NXCD, xcd = wgid % NXCD, off = wgid / NXCD; wgid = (xcd < r ? xcd * (q + 1) : r * (q + 1) + (xcd - r) * q) + off; }
        const int nig = WGM * nN, gid = wgid / nig, fm = gid * WGM, gsz = (nM - fm) < WGM ? (nM - fm) : WGM;
        u.pm = fm + ((wgid % nig) % gsz); u.pn = (wgid % nig) / gsz; return true;
    }
    __device__ __forceinline__ void a_ready(const Unit&) const {}
    __device__ __forceinline__ void done(const Unit&) const {}
};


typedef float f32x2 __attribute__((ext_vector_type(2)));
typedef __bf16 bf16x2_t __attribute__((ext_vector_type(2)));
__device__ __forceinline__ unsigned cvt_pk_bf16(float lo, float hi) { f32x2 v = {lo, hi}; bf16x2_t r = __builtin_convertvector(v, bf16x2_t); return __builtin_bit_cast(unsigned, r); }

struct EpiBf16 {
    static constexpr bool PERM = true, AFTER_DRAIN = false;
    bf16_t* O; int ldc;
    __device__ __forceinline__ void operator()(const f32x4 (&acc)[2][2][4][2], const Unit& u, int wr, int wc, int fr, int fq) const {
        const int row0 = u.pm * BM + wr * 64 + fr; const int col0 = u.pn * BM + wc * 32 + 8 * fq;
#pragma unroll
        for (int ai = 0; ai < 2; ++ai)
#pragma unroll
            for (int m = 0; m < 4; ++m) { bf16_t* rowp = O + (size_t)(row0 + ai * HALF + m * 16) * ldc + col0;
#pragma unroll
                for (int bj = 0; bj < 2; ++bj) { const f32x4 v0 = acc[ai][bj][m][0], v1 = acc[ai][bj][m][1];
                    u32x4 w; w.x = cvt_pk_bf16(v0[0], v0[1]); w.y = cvt_pk_bf16(v0[2], v0[3]); w.z = cvt_pk_bf16(v1[0], v1[1]); w.w = cvt_pk_bf16(v1[2], v1[3]);
                    *(u32x4*)(rowp + bj * HALF) = w; } }
    }
};
struct EpiResGate {
    static constexpr bool PERM = false, AFTER_DRAIN = false;
    const float* base; float* out; int ldc; const float* gate; int gstride; int rows_per_batch;
    __device__ __forceinline__ void operator()(const f32x4 (&acc)[2][2][4][2], const Unit& u, int wr, int wc, int fr, int fq) const {
        const int row0 = u.pm * BM + wr * 64 + fr, col0 = u.pn * BM + wc * 32 + 4 * fq;
        const float* gp = gate + (size_t)((u.pm * BM) / rows_per_batch) * gstride + col0;
        f32x4 gv[2][2];
#pragma unroll
        for (int bj = 0; bj < 2; ++bj)
#pragma unroll
            for (int n = 0; n < 2; ++n) gv[bj][n] = *(const f32x4*)(gp + bj * HALF + n * 16);
#pragma unroll
        for (int ai = 0; ai < 2; ++ai)
#pragma unroll
            for (int m = 0; m < 4; ++m) { const size_t off = (size_t)(row0 + ai * HALF + m * 16) * ldc + col0;
#pragma unroll
                for (int bj = 0; bj < 2; ++bj)
#pragma unroll
                    for (int n = 0; n < 2; ++n) { const f32x4 bs = *(const f32x4*)(base + off + bj * HALF + n * 16);
                        *(f32x4*)(out + off + bj * HALF + n * 16) = bs + gv[bj][n] * acc[ai][bj][m][n]; } }
    }
};


struct PlainOrder : StaticOrder {
    const bf16_t* Bt; int K;
    __device__ __forceinline__ void a_offs(const Unit& u, int tid, unsigned (&v)[2][2]) const {
#pragma unroll
        for (int h = 0; h < 2; ++h)
#pragma unroll
            for (int i = 0; i < 2; ++i) { int R, C; stage_rc(tid * 16 + i * 8192, R, C); v[h][i] = (unsigned)((u.pm * BM + h * HALF + R) * K + C) * 2u; }
    }
    __device__ __forceinline__ const char* b_base(const Unit& u) const { return (const char*)Bt + (size_t)u.pn * ((size_t)BM * K * 2); }
};
struct MoeOrder {
    const PG8_LAS int* cntL; const PG8_LAS int* tst; int npn, G, c;
    __device__ __forceinline__ bool next(int i, Unit& u) const {
        const int L = i * G + c; if (L >= tst[64] * npn) return false;
        const int tile = L / npn; u.pn = L - tile * npn; int e = 0; while (tst[e + 1] <= tile) ++e; u.e = e; u.pm = tile - tst[e]; u.ord = i; return true; }
};
struct MoeOrder1 : MoeOrder {
    const PG8_LAS int* tab; const bf16_t* Bt; int K;
    __device__ __forceinline__ void a_offs(const Unit& u, int tid, unsigned (&v)[2][2]) const {
#pragma unroll
        for (int h = 0; h < 2; ++h)
#pragma unroll
            for (int i = 0; i < 2; ++i) { int R, C; stage_rc(tid * 16 + i * 8192, R, C); v[h][i] = (unsigned)(tab[u.ord * 256 + h * HALF + R] * K + C) * 2u; }
    }
    __device__ __forceinline__ const char* b_base(const Unit& u) const { return (const char*)Bt + ((size_t)u.e * 1024 + (size_t)u.pn * 256) * ((size_t)K * 2); }
};
struct MoeOrder2 : MoeOrder {
    const bf16_t* Bt; int K;
    __device__ __forceinline__ void a_offs(const Unit& u, int tid, unsigned (&v)[2][2]) const {
        const int row0 = 256 * (tst[u.e] + u.pm);
#pragma unroll
        for (int h = 0; h < 2; ++h)
#pragma unroll
            for (int i = 0; i < 2; ++i) { int R, C; stage_rc(tid * 16 + i * 8192, R, C); v[h][i] = (unsigned)((row0 + h * HALF + R) * K + C) * 2u; }
    }
    __device__ __forceinline__ const char* b_base(const Unit& u) const { return (const char*)Bt + ((size_t)u.e * 2048 + (size_t)u.pn * 256) * ((size_t)K * 2); }
};
struct EpiMoe1 {
    static constexpr bool PERM = true, AFTER_DRAIN = false;
    bf16_t* abuf; const PG8_LAS int* cntL; const PG8_LAS int* tst;
    __device__ __forceinline__ void operator()(const f32x4 (&acc)[2][2][4][2], const Unit& u, int wr, int wc, int fr, int fq) const {
        const int ne = cntL[u.e]; const size_t row0 = (size_t)256 * (tst[u.e] + u.pm);
        asm volatile("" : "+v"(fr), "+v"(fq));
#pragma unroll
        for (int ai = 0; ai < 2; ++ai)
#pragma unroll
            for (int m = 0; m < 4; ++m) { const int r = ai * HALF + wr * 64 + m * 16 + fr;
                if (u.pm * 256 + r < ne) { const f32x4 g0 = acc[ai][0][m][0], g1 = acc[ai][0][m][1], u0 = acc[ai][1][m][0], u1 = acc[ai][1][m][1];
                    f32x4 a0, a1;
#pragma unroll
                    for (int j = 0; j < 4; ++j) { a0[j] = g0[j] * __builtin_amdgcn_rcpf(1.f + __builtin_amdgcn_exp2f(-1.4426950408889634f * g0[j])) * u0[j]; a1[j] = g1[j] * __builtin_amdgcn_rcpf(1.f + __builtin_amdgcn_exp2f(-1.4426950408889634f * g1[j])) * u1[j]; }
                    u32x4 w; w.x = cvt_pk_bf16(a0[0], a0[1]); w.y = cvt_pk_bf16(a0[2], a0[3]); w.z = cvt_pk_bf16(a1[0], a1[1]); w.w = cvt_pk_bf16(a1[2], a1[3]);
                    *(u32x4*)(abuf + (row0 + r) * 512 + u.pn * 128 + wc * 32 + 8 * fq) = w; } }
    }
};
struct EpiMoe2 {
    static constexpr bool PERM = true, AFTER_DRAIN = false;
    bf16_t* ybuf; const int* asg; const float* rw; const PG8_LAS int* cntL; int cap, ldy;
    __device__ __forceinline__ void operator()(const f32x4 (&acc)[2][2][4][2], const Unit& u, int wr, int wc, int fr, int fq) const {
        const int ne = cntL[u.e];
#pragma unroll
        for (int ai = 0; ai < 2; ++ai)
#pragma unroll
            for (int m = 0; m < 4; ++m) { const int p = u.pm * 256 + ai * HALF + wr * 64 + m * 16 + fr;
                if (p < ne) { const int av = asg[(size_t)u.e * cap + p]; const float wv = rw[(size_t)u.e * cap + p];
                    bf16_t* rowp = ybuf + (size_t)av * ldy + u.pn * BM + wc * 32 + 8 * fq;
#pragma unroll
                    for (int bj = 0; bj < 2; ++bj) { const f32x4 v0 = acc[ai][bj][m][0] * wv, v1 = acc[ai][bj][m][1] * wv;
                        u32x4 w; w.x = cvt_pk_bf16(v0[0], v0[1]); w.y = cvt_pk_bf16(v0[2], v0[3]); w.z = cvt_pk_bf16(v1[0], v1[1]); w.w = cvt_pk_bf16(v1[2], v1[3]);
                        *(u32x4*)(rowp + bj * HALF) = w; } } }
    }
};


template <class Epi, class Sched, bool ALIGN_EPI = false>
__device__ __forceinline__ void gemm_phase2(PG8_LAS unsigned char* lds, const Gemm g, const Sched& S, const Epi& E) {
    const int tid = threadIdx.x, wid = __builtin_amdgcn_readfirstlane(tid >> 6), lane = tid & 63, wr = wid >> 2, wc = wid & 3, fr = lane & 15, fq = lane >> 4;
    const int K = g.K, nt = K / BK;
    unsigned vC[2][2], vN[2][2], voffB[2];
#pragma unroll
    for (int i = 0; i < 2; ++i) { int R, C; stage_rc(tid * 16 + i * 8192, R, C); const int Rb = Epi::PERM ? ((R & ~31) + perm32(R & 31)) : R; voffB[i] = (unsigned)(Rb * K + C) * 2u; }
    const size_t kstep = (size_t)(BK * 2);
    const size_t hstep = (size_t)HALF * K * 2;
    const unsigned ldsw = (unsigned)wid * 1024u;
    const int aoff = lds_byte(wr * 64 + fr, fq * 8), boff = lds_byte(wc * 32 + fr, fq * 8);
#define PG8_SA(b, h) (((b) * 2 + (h)) * HTB)
#define PG8_SB(b, h) ((4 + (b) * 2 + (h)) * HTB)
#define PG8_STAGE(bufoff, gbase, voff) do { _Pragma("unroll") for (int _i = 0; _i < 2; ++_i) \
        __builtin_amdgcn_global_load_lds((const unsigned*)((const char*)(gbase) + (voff)[_i]), (PG8_LAS unsigned*)(lds + (bufoff) + ldsw + _i * 8192), 16, 0, 0); } while (0)
#define PG8_LDA(dst, b, h) do { _Pragma("unroll") for (int m = 0; m < 4; ++m) _Pragma("unroll") for (int k = 0; k < 2; ++k) dst[m][k] = *(const PG8_LAS bf16x8*)(lds + PG8_SA(b, h) + aoff + m * 2048 + k * 1024); } while (0)
#define PG8_LDB(dst, b, h) do { _Pragma("unroll") for (int n = 0; n < 2; ++n) _Pragma("unroll") for (int k = 0; k < 2; ++k) dst[n][k] = *(const PG8_LAS bf16x8*)(lds + PG8_SB(b, h) + boff + n * 2048 + k * 1024); } while (0)
#define PG8_MMA(ai, bj, At, Bt) do { __builtin_amdgcn_s_setprio(1); _Pragma("unroll") for (int m = 0; m < 4; ++m) _Pragma("unroll") for (int n = 0; n < 2; ++n) _Pragma("unroll") for (int k = 0; k < 2; ++k) \
        acc[ai][bj][m][n] = __builtin_amdgcn_mfma_f32_16x16x32_bf16(Bt[n][k], At[m][k], acc[ai][bj][m][n], 0, 0, 0); __builtin_amdgcn_s_setprio(0); } while (0)
#define PG8_WAIT_V(n) asm volatile("s_waitcnt vmcnt(" #n ")" ::: "memory")
#define PG8_WAIT_L(n) asm volatile("s_waitcnt lgkmcnt(" #n ")" ::: "memory")
#define PG8_BAR __builtin_amdgcn_s_barrier()
#define PG8_SCHED __builtin_amdgcn_sched_barrier(0)
    Unit cur, nxt; int ui = 0;
    if (!S.next(0, cur)) return;
    f32x4 acc[2][2][4][2];
#pragma unroll
    for (int a = 0; a < 2; ++a)
#pragma unroll
        for (int b = 0; b < 2; ++b)
#pragma unroll
            for (int m = 0; m < 4; ++m)
#pragma unroll
                for (int n = 0; n < 2; ++n) acc[a][b][m][n] = (f32x4){0.f, 0.f, 0.f, 0.f};
    bf16x8 At[4][2], B0[2][2], B1[2][2];
    const char* Ab = (const char*)g.A; const char* cB = S.b_base(cur);
    S.a_offs(cur, tid, vC);
    PG8_STAGE(PG8_SB(0, 0), cB, voffB); PG8_STAGE(PG8_SB(0, 1), cB + hstep, voffB); PG8_STAGE(PG8_SA(0, 0), Ab, vC[0]); PG8_STAGE(PG8_SA(0, 1), Ab, vC[1]);
    if (wr == 1) PG8_BAR;
    PG8_WAIT_V(2); PG8_BAR;
    PG8_STAGE(PG8_SB(1, 0), cB + kstep, voffB); PG8_STAGE(PG8_SA(1, 0), Ab + kstep, vC[0]); PG8_STAGE(PG8_SB(1, 1), cB + hstep + kstep, voffB);
    PG8_WAIT_V(6); PG8_BAR;
    for (;;) {
        const bool has_next = S.next(ui + 1, nxt);
        const char* nB = cB;
        if (has_next) { S.a_offs(nxt, tid, vN); nB = S.b_base(nxt); }
        else {
#pragma unroll
            for (int hh = 0; hh < 2; ++hh)
#pragma unroll
                for (int i = 0; i < 2; ++i) vN[hh][i] = vC[hh][i]; }
        for (int t = 0; t < nt; t += 2) {
            const bool last = (t == nt - 2);
            const char* a1 = Ab + (size_t)(t + 1) * kstep;
            const char* a2 = last ? Ab : Ab + (size_t)(t + 2) * kstep; const char* b2 = last ? nB : cB + (size_t)(t + 2) * kstep;
            const char* a3 = a2 + kstep; const char* b3 = b2 + kstep;
            unsigned v2[2][2];
#pragma unroll
            for (int hh = 0; hh < 2; ++hh)
#pragma unroll
                for (int i = 0; i < 2; ++i) v2[hh][i] = last ? vN[hh][i] : vC[hh][i];
            PG8_LDB(B0, 0, 0); PG8_LDB(B1, 0, 1); PG8_SCHED; PG8_LDA(At, 0, 0); PG8_STAGE(PG8_SA(1, 1), a1, vC[1]);
            PG8_WAIT_V(8); PG8_WAIT_L(0); PG8_BAR; PG8_MMA(0, 0, At, B0); PG8_MMA(0, 1, At, B1); PG8_BAR; PG8_SCHED;
            PG8_LDA(At, 0, 1); PG8_STAGE(PG8_SB(0, 0), b2, voffB); PG8_STAGE(PG8_SB(0, 1), b2 + hstep, voffB); PG8_STAGE(PG8_SA(0, 0), a2, v2[0]);
            PG8_WAIT_V(8); PG8_WAIT_L(0); PG8_BAR; PG8_MMA(1, 0, At, B0); PG8_MMA(1, 1, At, B1); PG8_BAR; PG8_SCHED;
            PG8_LDB(B0, 1, 0); PG8_LDB(B1, 1, 1); PG8_SCHED; PG8_LDA(At, 1, 0); PG8_STAGE(PG8_SA(0, 1), a2, v2[1]);
            PG8_WAIT_V(8); PG8_WAIT_L(0); PG8_BAR; PG8_MMA(0, 0, At, B0); PG8_MMA(0, 1, At, B1); PG8_BAR; PG8_SCHED;
            PG8_LDA(At, 1, 1); PG8_STAGE(PG8_SB(1, 0), b3, voffB); PG8_STAGE(PG8_SB(1, 1), b3 + hstep, voffB); PG8_STAGE(PG8_SA(1, 0), a3, v2[0]);
            PG8_WAIT_V(8); PG8_WAIT_L(0); PG8_BAR; PG8_MMA(1, 0, At, B0); PG8_MMA(1, 1, At, B1); PG8_BAR; PG8_SCHED;
        }
        if constexpr (ALIGN_EPI) { if (wr == 0) PG8_BAR; }
        E(acc, cur, wr, wc, fr, fq);
        if (!has_next) break;
#pragma unroll
        for (int a = 0; a < 2; ++a)
#pragma unroll
            for (int b = 0; b < 2; ++b)
#pragma unroll
                for (int m = 0; m < 4; ++m)
#pragma unroll
                    for (int n = 0; n < 2; ++n) acc[a][b][m][n] = (f32x4){0.f, 0.f, 0.f, 0.f};
        cur = nxt; cB = nB; ++ui;
#pragma unroll
        for (int hh = 0; hh < 2; ++hh)
#pragma unroll
            for (int i = 0; i < 2; ++i) vC[hh][i] = vN[hh][i];
        if constexpr (ALIGN_EPI) { if (wr == 1) PG8_BAR; }
    }
    PG8_WAIT_V(0);
    if constexpr (!ALIGN_EPI) { if (wr == 0) PG8_BAR; }
    PG8_BAR;
#undef PG8_SA
#undef PG8_SB
#undef PG8_STAGE
#undef PG8_LDA
#undef PG8_LDB
#undef PG8_MMA
#undef PG8_WAIT_V
#undef PG8_WAIT_L
#undef PG8_BAR
#undef PG8_SCHED
}
}

constexpr int NB = 8, T = 2048, D = 2048, M = NB * T;
constexpr int NP = 6912, PROJ = 6680;
constexpr int C_RQ = 0, C_RK = 1024, C_RV = 2048, C_RG = 3072, C_NQ = 4096, C_KC = 5120, C_VC = 5376, C_KS = 5632, C_VS = 5888, C_KW = 6144, C_VW = 6400, C_NG = 6656;
constexpr int NEXP = 64, DE = 512, CAP = 32768;
constexpr float EPS = 1e-6f;
constexpr int NWAVES = 8;

constexpr size_t MiB = 1u << 20;
constexpr size_t WS_CTL = 0, CTL_ZERO_BYTES = 1 * MiB;
constexpr size_t WS_SMALL = 1 * MiB;
constexpr size_t WS_BIAS1K = WS_SMALL, WS_BIAS1V = WS_SMALL + 1024, WS_W2KT = WS_SMALL + 4096, WS_W2VT = WS_W2KT + 65536, WS_WRT = WS_W2VT + 65536;
constexpr size_t WS_MODP = 2 * MiB;
constexpr size_t WS_MOD = WS_MODP + 4 * 8 * 12288 * 4;
constexpr size_t WS_COS = 4 * MiB, WS_SIN = 5 * MiB;
constexpr size_t WS_W1K = 6 * MiB, WS_W1V = 8 * MiB;
constexpr size_t WS_YK = 10 * MiB, WS_YV = 14 * MiB;
constexpr size_t WS_KC = 18 * MiB, WS_VCT = 19 * MiB;
constexpr size_t WS_ASG = 26 * MiB, WS_RW = 34 * MiB;
constexpr size_t WS_WIN = 42 * MiB;
constexpr size_t WS_WOUT = 70 * MiB;
constexpr size_t WS_WGU = 78 * MiB;
constexpr size_t WS_WD = 334 * MiB;
constexpr size_t WS_H = 462 * MiB;
constexpr size_t WS_PROJ = 526 * MiB;
constexpr size_t WS_Y = 526 * MiB;
constexpr size_t WS_A = 654 * MiB;
constexpr size_t WS_QR = 742 * MiB, WS_KR = 774 * MiB, WS_KZT = 806 * MiB, WS_VT = 838 * MiB;
constexpr size_t WS_SP = 870 * MiB;
constexpr size_t WS_KCMP = 934 * MiB, WS_VCMP = 942 * MiB, WS_VST = 950 * MiB, WS_VWT = 958 * MiB;
constexpr size_t WS_CAT = 966 * MiB;
constexpr size_t WS_END = 1030 * MiB;
constexpr int CW_BAR = 4096;
constexpr int CW_CNT = 8192;

constexpr int LDS_BYTES = 147456;
constexpr int MISC_OFF = LDS_BYTES - 256;

#define GAS __attribute__((address_space(1)))
#define LAS __attribute__((address_space(3)))
typedef unsigned short bf16;
typedef short bf16x8 __attribute__((ext_vector_type(8)));
typedef short bf16x4 __attribute__((ext_vector_type(4)));
typedef float f32x4 __attribute__((ext_vector_type(4)));
typedef float f32x16 __attribute__((ext_vector_type(16)));
typedef unsigned u32x4 __attribute__((ext_vector_type(4)));
typedef unsigned u32x2 __attribute__((ext_vector_type(2)));
#define LDS_WAIT() asm volatile("s_waitcnt lgkmcnt(0)" ::: "memory")
#define VM_WAIT() asm volatile("s_waitcnt vmcnt(0)" ::: "memory")
#define MFMA16(a, b, c) __builtin_amdgcn_mfma_f32_16x16x32_bf16((a), (b), (c), 0, 0, 0)
#define MFMA32(a, b, c) __builtin_amdgcn_mfma_f32_32x32x16_bf16((a), (b), (c), 0, 0, 0)
using pg8::cvt_pk_bf16;
__device__ __forceinline__ float bf2f(unsigned short b) { return __uint_as_float(((unsigned)b) << 16); }
__device__ __forceinline__ float bflo(unsigned w) { return __uint_as_float(w << 16); }
__device__ __forceinline__ float bfhi(unsigned w) { return __uint_as_float(w & 0xffff0000u); }
__device__ __forceinline__ float wave_sum(float v) {
#pragma unroll
    for (int o = 1; o < 64; o <<= 1) v += __shfl_xor(v, o);
    return v;
}
__device__ __forceinline__ float silu_f(float x) { return x / (1.f + __expf(-x)); }
__device__ __forceinline__ float sigmoid_f(float x) { return 1.f / (1.f + __expf(-x)); }
__device__ __forceinline__ bf16x8 cat4(bf16x4 lo, bf16x4 hi) { return __builtin_shufflevector(lo, hi, 0, 1, 2, 3, 4, 5, 6, 7); }
__device__ __forceinline__ bf16x8 pack8(const f32x4 a, const f32x4 b) { u32x4 p; p.x = cvt_pk_bf16(a[0], a[1]); p.y = cvt_pk_bf16(a[2], a[3]); p.z = cvt_pk_bf16(b[0], b[1]); p.w = cvt_pk_bf16(b[2], b[3]); return __builtin_bit_cast(bf16x8, p); }

#define XB_TMO      128
#define XB_XCNT(j)  (256  + 64 * (j))
#define XB_XSUB(j)  (1280 + 64 * (j))
#define XB_XGEN(j)  (2304 + 64 * (j))
#define XB_TOP      3328
#define XB_TOPGEN   3392
#define XCD_BAR_WORDS 3456
#define XB_SPIN_CAP (1u << 18)

__device__ __forceinline__ unsigned xb_ld(unsigned* p)              { return __hip_atomic_load(p, __ATOMIC_RELAXED, __HIP_MEMORY_SCOPE_AGENT); }
__device__ __forceinline__ unsigned xb_add(unsigned* p, unsigned v) { return __hip_atomic_fetch_add(p, v, __ATOMIC_RELAXED, __HIP_MEMORY_SCOPE_AGENT); }
__device__ __forceinline__ unsigned xb_xcc_id() { return (unsigned)__builtin_amdgcn_s_getreg((3 << 11) | 20) & 0xFu; }
#define XB_SPIN(cond, bar) do { unsigned _sp = 0; while (cond) { __builtin_amdgcn_s_sleep(1); \
    if ((++_sp & 255u) == 0u) { if (xb_ld(&(bar)[XB_TMO])) break; if (_sp > XB_SPIN_CAP) { atomicAdd(&(bar)[XB_TMO], 1u); break; } } } } while (0)

struct XcdBarrier {
    unsigned* bar; unsigned x;
    volatile LAS unsigned* st;
};

__device__ __forceinline__ XcdBarrier xcd_barrier_post(unsigned* bar, volatile LAS unsigned* st) {
    XcdBarrier b; b.bar = bar; b.x = xb_xcc_id(); b.st = st;
    if (threadIdx.x == 0) (void)xb_add(&bar[XB_XCNT(b.x)], 1u);
    return b;
}
__device__ __forceinline__ void xcd_barrier_complete(unsigned* bar, unsigned x, unsigned& nloc, unsigned& nx) {
    const unsigned G = gridDim.x * gridDim.y * gridDim.z;
    unsigned sum, cnt, mine, sp = 0u;
    for (;;) {
        sum = 0u; cnt = 0u; mine = 0u;
#pragma unroll
        for (unsigned j = 0; j < 16; ++j) { const unsigned c = xb_ld(&bar[XB_XCNT(j)]); sum += c; cnt += (c > 0u) ? 1u : 0u; mine = (j == x) ? c : mine; }
        if (sum == G) break;
        __builtin_amdgcn_s_sleep(1);
        if ((++sp & 255u) == 0u) { if (xb_ld(&bar[XB_TMO])) break; if (sp > XB_SPIN_CAP) { atomicAdd(&bar[XB_TMO], 1u); break; } }
    }
    nloc = mine > 0u ? mine : 1u; nx = cnt > 0u ? cnt : 1u;
}

__device__ __forceinline__ void xcd_barrier(const XcdBarrier& b) {
    asm volatile("s_waitcnt vmcnt(0)" ::: "memory");
    __syncthreads();
    if (threadIdx.x == 0) {
        unsigned* bar = b.bar;
        __builtin_amdgcn_s_waitcnt(0);
        unsigned nloc = b.st[0], nx = b.st[1];
        if (nloc == 0u) { xcd_barrier_complete(bar, b.x, nloc, nx); b.st[0] = nloc; b.st[1] = nx; }
        const unsigned old = xb_add(&bar[XB_XSUB(b.x)], 1u);
        const unsigned gen = old / nloc;
        if (old + 1u == (gen + 1u) * nloc) {
            __builtin_amdgcn_fence(__ATOMIC_RELEASE, "agent");
            asm volatile("s_waitcnt vmcnt(0)" ::: "memory");
            const unsigned og = xb_add(&bar[XB_TOP], 1u);
            const unsigned tg = og / nx;
            if (og + 1u == (tg + 1u) * nx) xb_add(&bar[XB_TOPGEN], 1u);
            else XB_SPIN(xb_ld(&bar[XB_TOPGEN]) == tg, bar);
            __builtin_amdgcn_fence(__ATOMIC_ACQUIRE, "agent");
            xb_add(&bar[XB_XGEN(b.x)], 1u);
            asm volatile("s_waitcnt vmcnt(0)" ::: "memory");
        } else {
            XB_SPIN(xb_ld(&bar[XB_XGEN(b.x)]) == gen, bar);
            __builtin_amdgcn_fence(__ATOMIC_ACQUIRE, "agent");
            asm volatile("s_waitcnt vmcnt(0)" ::: "memory");
        }
    }
    __syncthreads();
}

struct Args { const float* in[23]; float* out; unsigned char* ws; int ph_lo, ph_hi; };
enum { I_X = 0, I_C, I_WADA, I_BADA, I_N1G, I_N2G, I_FG, I_WIN, I_GNG, I_PK, I_W1K, I_W2K, I_PV, I_W1V, I_W2V, I_WOUT, I_WGRP, I_BGRP, I_WEXP, I_BEXP, I_WGATE, I_WUP, I_WDOWN };

__device__ __forceinline__ float ret_lg(int h) { return h == 0 ? -0.0317486983145803f : (h == 1 ? -0.015748356968139168f : (h == 2 ? -0.007843177461025893f : -0.003913899321136329f)); }

__device__ __forceinline__ void transpose_tile(const float* __restrict__ W, int ldw, int k0, int n0, int nmax, bf16* __restrict__ WT, int ldt, int drow0, int dcol0, LAS float* scr, int lane) {
#pragma unroll 8
    for (int i = 0; i < 32; ++i) { const int kk = 2 * i + (lane >> 5); const int n = n0 + (lane & 31);
        const float v = (n < nmax) ? W[(size_t)(k0 + kk) * ldw + n] : 0.f; scr[kk * 33 + (lane & 31)] = v; }
    LDS_WAIT();
    const int c = lane & 7;
#pragma unroll
    for (int j = 0; j < 4; ++j) { const int nn = (lane >> 3) + 8 * j; const LAS float* s = scr + (8 * c) * 33 + nn;
        u32x4 o; o.x = cvt_pk_bf16(s[0 * 33], s[1 * 33]); o.y = cvt_pk_bf16(s[2 * 33], s[3 * 33]); o.z = cvt_pk_bf16(s[4 * 33], s[5 * 33]); o.w = cvt_pk_bf16(s[6 * 33], s[7 * 33]);
        *(u32x4*)(WT + (size_t)(drow0 + nn) * ldt + dcol0 + 8 * c) = o; }
    LDS_WAIT();
}

__device__ __forceinline__ void phase0(const Args& a, LAS unsigned char* lds) {
    const int tid = threadIdx.x, lane = tid & 63, wave = __builtin_amdgcn_readfirstlane(tid >> 6);
    unsigned char* ws = a.ws;
    {
        LAS float* cact = (LAS float*)lds;
        LAS float* red = (LAS float*)(lds + 16384);
        const float* c = a.in[I_C]; const float* wada = a.in[I_WADA];
        float* modp = (float*)(ws + WS_MODP);
        for (int it = blockIdx.x; it < 768; it += gridDim.x) {
            const int kq = it / 192, cc = it % 192;
            __syncthreads();
            for (int i = tid; i < 8 * 512; i += 512) { const int b = i >> 9, k = i & 511; cact[i] = silu_f(c[b * 2048 + kq * 512 + k]); }
            __syncthreads();
            float acc[8];
#pragma unroll
            for (int b = 0; b < 8; ++b) acc[b] = 0.f;
            const float* wp = wada + (size_t)(kq * 512 + wave * 64) * 12288 + cc * 64 + lane;
#pragma unroll 8
            for (int kk = 0; kk < 64; ++kk) { const float wv = wp[(size_t)kk * 12288];
#pragma unroll
                for (int b = 0; b < 8; ++b) acc[b] += cact[b * 512 + wave * 64 + kk] * wv; }
#pragma unroll
            for (int b = 0; b < 8; ++b) red[(wave * 8 + b) * 64 + lane] = acc[b];
            __syncthreads();
            { const int b = tid >> 6, l = tid & 63; float s = 0.f;
#pragma unroll
              for (int w = 0; w < 8; ++w) s += red[(w * 8 + b) * 64 + l];
              modp[((size_t)kq * 8 + b) * 12288 + cc * 64 + l] = s; }
        }
    }
    for (int ten = blockIdx.x; ten < 2; ten += gridDim.x) {
        const float* pe = a.in[ten ? I_PV : I_PK]; const float* w1 = a.in[ten ? I_W1V : I_W1K]; float* bias = (float*)(ws + (ten ? WS_BIAS1V : WS_BIAS1K));
        const int n = tid & 255, half = tid >> 8; float s = 0.f;
        for (int k = half * 2048; k < half * 2048 + 2048; ++k) s += pe[k] * w1[(size_t)k * 256 + n];
        __syncthreads(); LAS float* red = (LAS float*)lds; red[tid] = s; __syncthreads();
        if (tid < 256) bias[tid] = red[tid] + red[tid + 256];
    }
    __syncthreads();
    {
        LAS float* scr = (LAS float*)(lds + wave * 16384);
        const int gw = blockIdx.x * NWAVES + wave, NGW = gridDim.x * NWAVES;
        constexpr int I_IN = 216 * 32, I_OUT = 64 * 32, I_G = 64 * 512, I_W1 = 512, I_W2 = 16;
        constexpr int NITEMS = I_IN + I_OUT + 3 * I_G + 2 * I_W1 + 2 * I_W2;
        for (int it = gw; it < NITEMS; it += NGW) {
            int r = it;
            if (r < I_IN) { const int kb = r / 216, nb = r % 216; transpose_tile(a.in[I_WIN], PROJ, 64 * kb, 32 * nb, PROJ, (bf16*)(ws + WS_WIN), 2048, 32 * nb, 64 * kb, scr, lane); continue; } r -= I_IN;
            if (r < I_OUT) { const int kb = r / 64, nb = r % 64; transpose_tile(a.in[I_WOUT], 2048, 64 * kb, 32 * nb, 2048, (bf16*)(ws + WS_WOUT), 2048, 32 * nb, 64 * kb, scr, lane); continue; } r -= I_OUT;
            if (r < 2 * I_G) { const int up = r >= I_G ? 1 : 0; r -= up * I_G; const int e = r >> 9, rr = r & 511, kb = rr >> 4, nb = rr & 15, n0 = 32 * nb;
                const float* W = a.in[up ? I_WUP : I_WGATE] + (size_t)e * 2048 * 512;
                transpose_tile(W, 512, 64 * kb, n0, 512, (bf16*)(ws + WS_WGU), 2048, e * 1024 + (n0 >> 7) * 256 + up * 128 + (n0 & 127), 64 * kb, scr, lane); continue; } r -= 2 * I_G;
            if (r < I_G) { const int e = r >> 9, rr = r & 511, kb = rr >> 6, nb = rr & 63;
                transpose_tile(a.in[I_WDOWN] + (size_t)e * 512 * 2048, 2048, 64 * kb, 32 * nb, 2048, (bf16*)(ws + WS_WD), 512, e * 2048 + 32 * nb, 64 * kb, scr, lane); continue; } r -= I_G;
            if (r < 2 * I_W1) { const int ten = r >= I_W1 ? 1 : 0; r -= ten * I_W1; const int kb = r >> 3, nb = r & 7, k0 = 64 * kb;
                transpose_tile(a.in[ten ? I_W1V : I_W1K], 256, k0, 32 * nb, 256, (bf16*)(ws + (ten ? WS_W1V : WS_W1K)), 2048, (k0 >= 2048 ? 256 : 0) + 32 * nb, k0 & 2047, scr, lane); continue; } r -= 2 * I_W1;
            { const int ten = r >= I_W2 ? 1 : 0; r -= ten * I_W2; const int kb = r >> 2, nb = r & 3;
                transpose_tile(a.in[ten ? I_W2V : I_W2K], 128, 64 * kb, 32 * nb, 128, (bf16*)(ws + (ten ? WS_W2VT : WS_W2KT)), 256, 32 * nb, 64 * kb, scr, lane); }
        }
    }
    {
        const int gt = blockIdx.x * 512 + tid, NT = gridDim.x * 512;
        bf16* wrt = (bf16*)(ws + WS_WRT); const float* wg = a.in[I_WGRP]; const float* we = a.in[I_WEXP];
        for (int idx = gt; idx < 80 * 2048; idx += NT) { const int n = idx >> 11, k = idx & 2047;
            const float v = n < 8 ? wg[k * 8 + n] : (n < 72 ? we[k * 64 + (n - 8)] : 0.f); wrt[idx] = (bf16)(cvt_pk_bf16(v, 0.f) & 0xffffu); }
        float* cosT = (float*)(ws + WS_COS); float* sinT = (float*)(ws + WS_SIN);
        for (int idx = gt; idx < 2048 * 128; idx += NT) { const int pos = idx >> 7, j = idx & 127;
            const float inv = exp2f(-(float)j * 0.10381025296523007f);
            const double rev = (double)pos * (double)inv * 0.15915494309189535;
            const float fr = (float)(rev - __builtin_floor(rev));
            cosT[idx] = __builtin_amdgcn_cosf(fr); sinT[idx] = __builtin_amdgcn_sinf(fr); }
    }
}

template <bool FROM_PART>
__device__ __forceinline__ void norm_mod_phase(const Args& a, LAS unsigned char* lds, const float* xin, const float* gvec, int sh_chunk, int sc_chunk, bf16* outp) {
    const int tid = threadIdx.x, lane = tid & 63, wave = __builtin_amdgcn_readfirstlane(tid >> 6);
    LAS float* Av = (LAS float*)lds; LAS float* Bv = Av + 2048;
    const float* modp = (const float*)(a.ws + WS_MODP); const float* mod = (const float*)(a.ws + WS_MOD); const float* bada = a.in[I_BADA];
    int prev_b = -1;
    for (int rb = blockIdx.x; rb < M / 64; rb += gridDim.x) {
        const int b = rb >> 5;
        if (b != prev_b) {
            __syncthreads();
            for (int j = tid; j < 2048; j += 512) { float sh, sc;
                if (FROM_PART) { sh = bada[sh_chunk * 2048 + j]; sc = bada[sc_chunk * 2048 + j];
#pragma unroll
                    for (int kq = 0; kq < 4; ++kq) { sh += modp[((size_t)kq * 8 + b) * 12288 + sh_chunk * 2048 + j]; sc += modp[((size_t)kq * 8 + b) * 12288 + sc_chunk * 2048 + j]; } }
                else { sh = mod[b * 12288 + sh_chunk * 2048 + j]; sc = mod[b * 12288 + sc_chunk * 2048 + j]; }
                Av[j] = gvec[j] * (1.f + sc); Bv[j] = sh; }
            __syncthreads(); prev_b = b;
        }
        for (int rr = wave; rr < 64; rr += NWAVES) { const int row = rb * 64 + rr;
            const f32x4* xr = (const f32x4*)(xin + (size_t)row * D) + lane;
            f32x4 v[8]; float ss = 0.f;
#pragma unroll
            for (int j = 0; j < 8; ++j) { v[j] = xr[64 * j]; ss += (v[j][0] * v[j][0] + v[j][1] * v[j][1]) + (v[j][2] * v[j][2] + v[j][3] * v[j][3]); }
            const float rstd = rsqrtf(wave_sum(ss) * (1.f / 2048.f) + EPS);
            u32x2* o = (u32x2*)(outp + (size_t)row * D) + lane;
#pragma unroll
            for (int j = 0; j < 8; ++j) { const int col = 4 * lane + 256 * j; const f32x4 A4 = *(const LAS f32x4*)(Av + col), B4 = *(const LAS f32x4*)(Bv + col);
                const f32x4 y = v[j] * rstd * A4 + B4; u32x2 w; w.x = cvt_pk_bf16(y[0], y[1]); w.y = cvt_pk_bf16(y[2], y[3]); o[64 * j] = w; }
        }
    }
    if (FROM_PART) {
        float* modw = (float*)(a.ws + WS_MOD);
        for (int idx = blockIdx.x * 512 + tid; idx < 8 * 12288; idx += gridDim.x * 512) { const int b = idx / 12288, j = idx % 12288; float s = bada[j];
#pragma unroll
            for (int kq = 0; kq < 4; ++kq) s += modp[((size_t)kq * 8 + b) * 12288 + j];
            modw[idx] = s; }
    }
}

__device__ __forceinline__ void transpose_out(const LAS unsigned short* tl, int pitch, int C, bf16* dst, size_t ldT, int tid) {
    for (int idx = tid; idx < C * 8; idx += 512) { const int cc = idx >> 3, tc = (idx & 7) * 8;
        unsigned e[8];
#pragma unroll
        for (int i = 0; i < 8; ++i) e[i] = tl[(tc + i) * pitch + cc];
        u32x4 o; o.x = e[0] | (e[1] << 16); o.y = e[2] | (e[3] << 16); o.z = e[4] | (e[5] << 16); o.w = e[6] | (e[7] << 16);
        *(u32x4*)(dst + (size_t)cc * ldT + tc) = o; }
}
__device__ __forceinline__ void rot8(const u32x4 x1, const u32x4 x2, const float* cosT, const float* sinT, int t, int jc, float (&o1)[8], float (&o2)[8]) {
    const f32x4 c0 = *(const f32x4*)(cosT + t * 128 + jc), c1 = *(const f32x4*)(cosT + t * 128 + jc + 4), s0 = *(const f32x4*)(sinT + t * 128 + jc), s1 = *(const f32x4*)(sinT + t * 128 + jc + 4);
    const float a1[8] = {bflo(x1.x), bfhi(x1.x), bflo(x1.y), bfhi(x1.y), bflo(x1.z), bfhi(x1.z), bflo(x1.w), bfhi(x1.w)};
    const float a2[8] = {bflo(x2.x), bfhi(x2.x), bflo(x2.y), bfhi(x2.y), bflo(x2.z), bfhi(x2.z), bflo(x2.w), bfhi(x2.w)};
    const float cs[8] = {c0[0], c0[1], c0[2], c0[3], c1[0], c1[1], c1[2], c1[3]}, sn[8] = {s0[0], s0[1], s0[2], s0[3], s1[0], s1[1], s1[2], s1[3]};
#pragma unroll
    for (int i = 0; i < 8; ++i) { o1[i] = a1[i] * cs[i] - a2[i] * sn[i]; o2[i] = a1[i] * sn[i] + a2[i] * cs[i]; }
}
__device__ __forceinline__ u32x4 pack8f(const float (&o)[8], float sc) { u32x4 w; w.x = cvt_pk_bf16(o[0] * sc, o[1] * sc); w.y = cvt_pk_bf16(o[2] * sc, o[3] * sc); w.z = cvt_pk_bf16(o[4] * sc, o[5] * sc); w.w = cvt_pk_bf16(o[6] * sc, o[7] * sc); return w; }

__device__ __forceinline__ void phase3(const Args& a, LAS unsigned char* lds) {
    const int tid = threadIdx.x;
    unsigned char* ws = a.ws;
    const bf16* proj = (const bf16*)(ws + WS_PROJ);
    const float* cosT = (const float*)(ws + WS_COS); const float* sinT = (const float*)(ws + WS_SIN);
    bf16* Qr = (bf16*)(ws + WS_QR); bf16* Kr = (bf16*)(ws + WS_KR); bf16* KzT = (bf16*)(ws + WS_KZT); bf16* VT = (bf16*)(ws + WS_VT);
    bf16* kcmp = (bf16*)(ws + WS_KCMP); bf16* vcmp = (bf16*)(ws + WS_VCMP); bf16* vsT = (bf16*)(ws + WS_VST); bf16* vwT = (bf16*)(ws + WS_VWT);
    LAS unsigned short* tl = (LAS unsigned short*)lds; constexpr int P2 = 258;
    for (int it = blockIdx.x; it < NB * 32; it += gridDim.x) {
        const int b = it >> 5, t0 = (it & 31) * 64;
        const bf16* pr = proj + (size_t)(b * T + t0) * NP;
        for (int h = 0; h < 4; ++h) {
            const float lg = ret_lg(h);
            __syncthreads();
            for (int ch = tid; ch < 1024; ch += 512) { const int tk = ch >> 4, jc = (ch & 15) * 8, t = t0 + tk;
                const bf16* p = pr + (size_t)tk * NP + h * 256 + jc;
                float o1[8], o2[8];
                rot8(*(const u32x4*)(p + C_RK), *(const u32x4*)(p + C_RK + 128), cosT, sinT, t, jc, o1, o2);
                bf16* kd = Kr + ((size_t)(b * 4 + h) * T + t) * 256 + jc;
                *(u32x4*)kd = pack8f(o1, 0.0625f); *(u32x4*)(kd + 128) = pack8f(o2, 0.0625f);
                const float zs = 0.0625f * __expf(lg * (float)(127 - (t & 127)));
                const u32x4 z1 = pack8f(o1, zs), z2 = pack8f(o2, zs);
                LAS unsigned* d1 = (LAS unsigned*)(tl + tk * P2 + jc); d1[0] = z1.x; d1[1] = z1.y; d1[2] = z1.z; d1[3] = z1.w;
                LAS unsigned* d2 = (LAS unsigned*)(tl + tk * P2 + 128 + jc); d2[0] = z2.x; d2[1] = z2.y; d2[2] = z2.z; d2[3] = z2.w;
                rot8(*(const u32x4*)(p + C_RQ), *(const u32x4*)(p + C_RQ + 128), cosT, sinT, t, jc, o1, o2);
                bf16* qd = Qr + ((size_t)(b * 4 + h) * T + t) * 256 + jc;
                *(u32x4*)qd = pack8f(o1, 1.f); *(u32x4*)(qd + 128) = pack8f(o2, 1.f);
            }
            __syncthreads();
            transpose_out(tl, P2, 256, KzT + ((size_t)(b * 4 + h) * 256) * T + t0, T, tid);
            __syncthreads();
            for (int ch = tid; ch < 64 * 32; ch += 512) { const int tk = ch >> 5, dc = (ch & 31) * 8;
                const u32x4 v = *(const u32x4*)(pr + (size_t)tk * NP + C_RV + h * 256 + dc);
                LAS unsigned* d1 = (LAS unsigned*)(tl + tk * P2 + dc); d1[0] = v.x; d1[1] = v.y; d1[2] = v.z; d1[3] = v.w; }
            __syncthreads();
            transpose_out(tl, P2, 256, VT + ((size_t)(b * 4 + h) * 256) * T + t0, T, tid);
        }
        for (int g = 0; g < 2; ++g) {
            for (int ch = tid; ch < 1024; ch += 512) { const int tk = ch >> 4, dc = (ch & 15) * 8;
                const bf16* p = pr + (size_t)tk * NP + g * 128 + dc; const size_t o = ((size_t)(b * 2 + g) * T + t0 + tk) * 128 + dc;
                *(u32x4*)(kcmp + o) = *(const u32x4*)(p + C_KC); *(u32x4*)(vcmp + o) = *(const u32x4*)(p + C_VC); }
#pragma unroll
            for (int sel = 0; sel < 2; ++sel) {
                __syncthreads();
                for (int ch = tid; ch < 1024; ch += 512) { const int tk = ch >> 4, dc = (ch & 15) * 8;
                    const u32x4 v = *(const u32x4*)(pr + (size_t)tk * NP + (sel ? C_VW : C_VS) + g * 128 + dc);
                    LAS unsigned* d1 = (LAS unsigned*)(tl + tk * P2 + dc); d1[0] = v.x; d1[1] = v.y; d1[2] = v.z; d1[3] = v.w; }
                __syncthreads();
                transpose_out(tl, P2, 128, (sel ? vwT : vsT) + ((size_t)(b * 2 + g) * 128) * T + t0, T, tid);
            }
        }
    }
}

__device__ __forceinline__ void phase4(const Args& a, LAS unsigned char* lds) {
    const int tid = threadIdx.x, lane = tid & 63, wave = __builtin_amdgcn_readfirstlane(tid >> 6), q = lane >> 4, r = lane & 15;
    unsigned char* ws = a.ws;
    {
        const bf16* VT = (const bf16*)(ws + WS_VT); const bf16* KzT = (const bf16*)(ws + WS_KZT); bf16* SP = (bf16*)(ws + WS_SP);
        for (int it = blockIdx.x; it < 256; it += gridDim.x) {
            const int b = it >> 5, h = (it >> 3) & 3, es = it & 7;
            const float cd = __expf(ret_lg(h) * 128.f);
            const bf16* VTb = VT + ((size_t)(b * 4 + h) * 256 + es * 32) * T;
            const bf16* KzTb = KzT + ((size_t)(b * 4 + h) * 256 + wave * 32) * T;
            bf16* Sp = SP + (size_t)(b * 4 + h) * 16 * 65536;
            f32x4 S[2][2];
#pragma unroll
            for (int mt = 0; mt < 2; ++mt)
#pragma unroll
                for (int nt = 0; nt < 2; ++nt) S[mt][nt] = (f32x4){0.f, 0.f, 0.f, 0.f};
            for (int n = 0; n < 16; ++n) {
#pragma unroll
                for (int mt = 0; mt < 2; ++mt)
#pragma unroll
                    for (int nt = 0; nt < 2; ++nt) { const int e = es * 32 + 16 * mt + r, d = wave * 32 + 16 * nt + 4 * q;
                        u32x2 w; w.x = cvt_pk_bf16(S[mt][nt][0], S[mt][nt][1]); w.y = cvt_pk_bf16(S[mt][nt][2], S[mt][nt][3]);
                        *(u32x2*)(Sp + ((size_t)n * 256 + e) * 256 + d) = w; }
                if (n == 15) break;
#pragma unroll
                for (int mt = 0; mt < 2; ++mt)
#pragma unroll
                    for (int nt = 0; nt < 2; ++nt) S[mt][nt] = S[mt][nt] * cd;
#pragma unroll
                for (int k0 = 0; k0 < 128; k0 += 32) {
                    bf16x8 af[2], bfr[2];
#pragma unroll
                    for (int mt = 0; mt < 2; ++mt) af[mt] = *(const bf16x8*)(VTb + (size_t)(16 * mt + r) * T + n * 128 + k0 + 8 * q);
#pragma unroll
                    for (int nt = 0; nt < 2; ++nt) bfr[nt] = *(const bf16x8*)(KzTb + (size_t)(16 * nt + r) * T + n * 128 + k0 + 8 * q);
#pragma unroll
                    for (int mt = 0; mt < 2; ++mt)
#pragma unroll
                        for (int nt = 0; nt < 2; ++nt) S[mt][nt] = MFMA16(bfr[nt], af[mt], S[mt][nt]);
                }
            }
        }
    }
    {
        const int gw = blockIdx.x * NWAVES + wave, NGW = gridDim.x * NWAVES;
        for (int wi = gw; wi < 2048; wi += NGW) { const int ten = wi >> 10, rt = (wi >> 4) & 63, ct = wi & 15;
            const bf16* A = (const bf16*)(ws + (ten ? WS_VCMP : WS_KCMP)) + (size_t)(rt * 32) * 2048;
            const bf16* Bt = (const bf16*)(ws + (ten ? WS_W1V : WS_W1K)) + (size_t)(ct * 32) * 2048;
            f32x4 acc[2][2];
#pragma unroll
            for (int mt = 0; mt < 2; ++mt)
#pragma unroll
                for (int nt = 0; nt < 2; ++nt) acc[mt][nt] = (f32x4){0.f, 0.f, 0.f, 0.f};
#pragma unroll 2
            for (int k0 = 0; k0 < 2048; k0 += 32) {
                bf16x8 af[2], bfr[2];
#pragma unroll
                for (int mt = 0; mt < 2; ++mt) af[mt] = *(const bf16x8*)(A + (size_t)(16 * mt + r) * 2048 + k0 + 8 * q);
#pragma unroll
                for (int nt = 0; nt < 2; ++nt) bfr[nt] = *(const bf16x8*)(Bt + (size_t)(16 * nt + r) * 2048 + k0 + 8 * q);
#pragma unroll
                for (int mt = 0; mt < 2; ++mt)
#pragma unroll
                    for (int nt = 0; nt < 2; ++nt) acc[mt][nt] = MFMA16(bfr[nt], af[mt], acc[mt][nt]);
            }
            float* Y = (float*)(ws + (ten ? WS_YV : WS_YK));
#pragma unroll
            for (int mt = 0; mt < 2; ++mt)
#pragma unroll
                for (int nt = 0; nt < 2; ++nt) *(f32x4*)(Y + (size_t)(rt * 32 + 16 * mt + r) * 512 + ct * 32 + 16 * nt + 4 * q) = acc[mt][nt];
        }
    }
}

__device__ __forceinline__ void phase5(const Args& a, LAS unsigned char* lds) {
    const int tid = threadIdx.x, lane = tid & 63, wave = __builtin_amdgcn_readfirstlane(tid >> 6), q = lane >> 4, r = lane & 15;
    unsigned char* ws = a.ws;
    const int gw = blockIdx.x * NWAVES + wave, NGW = gridDim.x * NWAVES;
    for (int wi = gw; wi < 256; wi += NGW) { const int ten = wi >> 7, rt = wi & 127, row = rt * 16 + r, c = row & 127;
        const float* Y = (const float*)(ws + (ten ? WS_YV : WS_YK)); const float* bias = (const float*)(ws + (ten ? WS_BIAS1V : WS_BIAS1K));
        const bf16* W2T = (const bf16*)(ws + (ten ? WS_W2VT : WS_W2KT));
        f32x4 acc[8];
#pragma unroll
        for (int nt = 0; nt < 8; ++nt) acc[nt] = (f32x4){0.f, 0.f, 0.f, 0.f};
#pragma unroll
        for (int k0 = 0; k0 < 256; k0 += 32) { const int kk = k0 + 8 * q;
            bf16x8 af = (bf16x8){0, 0, 0, 0, 0, 0, 0, 0};
            if (c < 127) {
                const f32x4 y0 = *(const f32x4*)(Y + (size_t)row * 512 + kk), y1 = *(const f32x4*)(Y + (size_t)row * 512 + kk + 4);
                const f32x4 z0 = *(const f32x4*)(Y + (size_t)(row + 1) * 512 + 256 + kk), z1 = *(const f32x4*)(Y + (size_t)(row + 1) * 512 + 256 + kk + 4);
                const f32x4 b0 = *(const f32x4*)(bias + kk), b1 = *(const f32x4*)(bias + kk + 4);
                f32x4 h0 = y0 + z0 + b0, h1 = y1 + z1 + b1;
#pragma unroll
                for (int i = 0; i < 4; ++i) { h0[i] = silu_f(h0[i]); h1[i] = silu_f(h1[i]); }
                af = pack8(h0, h1);
            }
#pragma unroll
            for (int nt = 0; nt < 8; ++nt) { const bf16x8 bfr = *(const bf16x8*)(W2T + (size_t)(16 * nt + r) * 256 + kk); acc[nt] = MFMA16(bfr, af, acc[nt]); }
        }
        if (!ten) { bf16* kc = (bf16*)(ws + WS_KC);
#pragma unroll
            for (int nt = 0; nt < 8; ++nt) { u32x2 w; w.x = cvt_pk_bf16(acc[nt][0], acc[nt][1]); w.y = cvt_pk_bf16(acc[nt][2], acc[nt][3]); *(u32x2*)(kc + (size_t)row * 128 + 16 * nt + 4 * q) = w; }
        } else { bf16* vct = (bf16*)(ws + WS_VCT);
#pragma unroll
            for (int nt = 0; nt < 8; ++nt)
#pragma unroll
                for (int j = 0; j < 4; ++j) vct[((size_t)(row >> 7) * 128 + 16 * nt + 4 * q + j) * 128 + c] = (bf16)(cvt_pk_bf16(acc[nt][j], 0.f) & 0xffffu);
        }
    }
}

__device__ __forceinline__ void r2_item(const Args& a, int it) {
    int tid = threadIdx.x; asm volatile("" : "+v"(tid));
    const int lane = tid & 63, wave = __builtin_amdgcn_readfirstlane(tid >> 6), q = lane >> 4, r = lane & 15;
    unsigned char* ws = a.ws;
    const int b = it >> 6, h = (it >> 4) & 3, n = it & 15;
    const float lg = ret_lg(h);
    const int ti = 16 * wave + r;
    const bf16* Qrow = (const bf16*)(ws + WS_QR) + ((size_t)(b * 4 + h) * T + n * 128 + ti) * 256;
    const bf16* Kb = (const bf16*)(ws + WS_KR) + ((size_t)(b * 4 + h) * T + n * 128) * 256;
    const bf16* VTb = (const bf16*)(ws + WS_VT) + ((size_t)(b * 4 + h) * 256) * T + n * 128;
    const bf16* Sp = (const bf16*)(ws + WS_SP) + ((size_t)(b * 4 + h) * 16 + n) * 65536;
    f32x4 s[8];
#pragma unroll
    for (int nt = 0; nt < 8; ++nt) s[nt] = (f32x4){0.f, 0.f, 0.f, 0.f};
#pragma unroll 2
    for (int k0 = 0; k0 < 256; k0 += 32) { const bf16x8 af = *(const bf16x8*)(Qrow + k0 + 8 * q);
#pragma unroll
        for (int nt = 0; nt < 8; ++nt) { const bf16x8 bfr = *(const bf16x8*)(Kb + (size_t)(16 * nt + r) * 256 + k0 + 8 * q); s[nt] = MFMA16(bfr, af, s[nt]); } }
    bf16x8 pf[4];
#pragma unroll
    for (int nt = 0; nt < 8; ++nt)
#pragma unroll
        for (int j = 0; j < 4; ++j) { const int dd = ti - (16 * nt + 4 * q + j); s[nt][j] = dd >= 0 ? s[nt][j] * __expf(lg * (float)dd) : 0.f; }
#pragma unroll
    for (int ks = 0; ks < 4; ++ks) pf[ks] = pack8(s[2 * ks], s[2 * ks + 1]);
    f32x4 o[16];
#pragma unroll
    for (int nt = 0; nt < 16; ++nt) o[nt] = (f32x4){0.f, 0.f, 0.f, 0.f};
#pragma unroll 2
    for (int k0 = 0; k0 < 256; k0 += 32) { const bf16x8 af = *(const bf16x8*)(Qrow + k0 + 8 * q);
#pragma unroll
        for (int nt = 0; nt < 16; ++nt) { const bf16x8 bfr = *(const bf16x8*)(Sp + (size_t)(16 * nt + r) * 256 + k0 + 8 * q); o[nt] = MFMA16(bfr, af, o[nt]); } }
    const float qd = __expf(lg * (float)(ti + 1));
#pragma unroll
    for (int nt = 0; nt < 16; ++nt) o[nt] = o[nt] * qd;
#pragma unroll
    for (int ks = 0; ks < 4; ++ks)
#pragma unroll
        for (int nt = 0; nt < 16; ++nt) { const bf16* vp = VTb + (size_t)(16 * nt + r) * T + 32 * ks + 4 * q;
            const bf16x8 vf = cat4(*(const bf16x4*)vp, *(const bf16x4*)(vp + 16)); o[nt] = MFMA16(vf, pf[ks], o[nt]); }
    float sm = 0.f;
#pragma unroll
    for (int nt = 0; nt < 16; ++nt) sm += (o[nt][0] + o[nt][1]) + (o[nt][2] + o[nt][3]);
    sm += __shfl_xor(sm, 16); sm += __shfl_xor(sm, 32);
    const float mu = sm * (1.f / 256.f); float vs = 0.f;
#pragma unroll
    for (int nt = 0; nt < 16; ++nt) { const f32x4 d = o[nt] - mu; vs += (d[0] * d[0] + d[1] * d[1]) + (d[2] * d[2] + d[3] * d[3]); }
    vs += __shfl_xor(vs, 16); vs += __shfl_xor(vs, 32);
    const float rstd = rsqrtf(vs * (1.f / 256.f) + EPS);
    const size_t rowg = (size_t)b * T + n * 128 + ti;
    const bf16* gp = (const bf16*)(ws + WS_PROJ) + rowg * NP + C_RG + h * 256;
    const float* gn = a.in[I_GNG] + h * 256;
    bf16* op = (bf16*)(ws + WS_CAT) + rowg * 2048 + h * 256;
#pragma unroll
    for (int nt = 0; nt < 16; ++nt) { const int e = 16 * nt + 4 * q;
        const u32x2 gw2 = *(const u32x2*)(gp + e); const f32x4 g4 = *(const f32x4*)(gn + e);
        const float g0 = bflo(gw2.x), g1 = bfhi(gw2.x), g2 = bflo(gw2.y), g3 = bfhi(gw2.y);
        const float y0 = (o[nt][0] - mu) * rstd * g4[0] * silu_f(g0), y1 = (o[nt][1] - mu) * rstd * g4[1] * silu_f(g1);
        const float y2 = (o[nt][2] - mu) * rstd * g4[2] * silu_f(g2), y3 = (o[nt][3] - mu) * rstd * g4[3] * silu_f(g3);
        u32x2 w; w.x = cvt_pk_bf16(y0, y1); w.y = cvt_pk_bf16(y2, y3); *(u32x2*)(op + e) = w; }
}

constexpr float NSA_SCL = 0.08838834764831845f * 1.4426950408889634f;
constexpr int QP = 272, KP = 272, VP = 136, VCP = 264;
#ifndef NSA_NBR
#define NSA_NBR 2
#endif
constexpr int NSA_QS = 0, NSA_KS = 69632, NSA_VS = NSA_KS + 34816;

template <int S> __device__ __forceinline__ bf16x8 pack_step(const f32x16& x) {
    u32x4 p; p.x = cvt_pk_bf16(x[8 * S], x[8 * S + 1]); p.y = cvt_pk_bf16(x[8 * S + 2], x[8 * S + 3]); p.z = cvt_pk_bf16(x[8 * S + 4], x[8 * S + 5]); p.w = cvt_pk_bf16(x[8 * S + 6], x[8 * S + 7]);
    return __builtin_bit_cast(bf16x8, p);
}
__device__ __forceinline__ f32x16 zero16() { f32x16 z;
#pragma unroll
    for (int i = 0; i < 16; ++i) z[i] = 0.f;
    return z; }

__device__ __forceinline__ void attn_tile(const LAS unsigned char* qrow, const LAS unsigned char* Ks, const LAS unsigned char* Vs, int r, int h, float& m, float& l, f32x16 (&O)[4], int lo, int hi) {
    f32x16 st[2]; st[0] = zero16(); st[1] = zero16();
#pragma unroll
    for (int ks = 0; ks < 8; ++ks) { const bf16x8 qf = *(const LAS bf16x8*)(qrow + (16 * ks + 8 * h) * 2);
#pragma unroll
        for (int kb = 0; kb < 2; ++kb) { const bf16x8 kf = *(const LAS bf16x8*)(Ks + (32 * kb + r) * KP + (16 * ks + 8 * h) * 2); st[kb] = MFMA32(kf, qf, st[kb]); }
        if (ks & 1) asm volatile("" ::: "memory"); }
    float tmax = -1e30f;
#pragma unroll
    for (int kb = 0; kb < 2; ++kb)
#pragma unroll
        for (int reg = 0; reg < 16; ++reg) { constexpr int dummy = 0; (void)dummy; const int KC = 32 * kb + (reg & 3) + 8 * (reg >> 2); const float v = (KC > lo && KC <= hi) ? st[kb][reg] * NSA_SCL : -1e30f; st[kb][reg] = v; tmax = fmaxf(tmax, v); }
    tmax = fmaxf(tmax, __shfl_xor(tmax, 32));
    const float mn = fmaxf(m, tmax), alpha = __builtin_amdgcn_exp2f(m - mn);
    float rs = 0.f;
#pragma unroll
    for (int kb = 0; kb < 2; ++kb)
#pragma unroll
        for (int reg = 0; reg < 16; ++reg) { const float v = st[kb][reg]; const float p = v > -1e29f ? __builtin_amdgcn_exp2f(v - mn) : 0.f; st[kb][reg] = p; rs += p; }
    rs += __shfl_xor(rs, 32);
    l = l * alpha + rs; m = mn;
#pragma unroll
    for (int eb = 0; eb < 4; ++eb) O[eb] = O[eb] * alpha;
#pragma unroll
    for (int kb = 0; kb < 2; ++kb) {
        { const bf16x8 pf = pack_step<0>(st[kb]);
#pragma unroll
          for (int eb = 0; eb < 4; ++eb) { const LAS unsigned char* vp = Vs + (32 * eb + r) * VP + (32 * kb + 4 * h) * 2; const bf16x8 vf = cat4(*(const LAS bf16x4*)vp, *(const LAS bf16x4*)(vp + 16)); O[eb] = MFMA32(vf, pf, O[eb]); } }
        asm volatile("" ::: "memory");
        { const bf16x8 pf = pack_step<1>(st[kb]);
#pragma unroll
          for (int eb = 0; eb < 4; ++eb) { const LAS unsigned char* vp = Vs + (32 * eb + r) * VP + (32 * kb + 16 + 4 * h) * 2; const bf16x8 vf = cat4(*(const LAS bf16x4*)vp, *(const LAS bf16x4*)(vp + 16)); O[eb] = MFMA32(vf, pf, O[eb]); } }
        asm volatile("" ::: "memory");
    }
}

__device__ __forceinline__ void nsa_item(const Args& a, LAS unsigned char* lds, int item) {
    int tid = threadIdx.x; asm volatile("" : "+v"(tid));
    const int lane = tid & 63, w = __builtin_amdgcn_readfirstlane(tid >> 6), h = lane >> 5, r = lane & 31;
    unsigned char* ws = a.ws;
    const int bg = item & 15, qt = 31 - (item >> 4), b = bg >> 1, g = bg & 1, t0 = qt * 64, cur = qt;
    const bf16* proj = (const bf16*)(ws + WS_PROJ);
    LAS unsigned char* Qs = lds + NSA_QS; LAS unsigned char* Ks = lds + NSA_KS; LAS unsigned char* Vs = lds + NSA_VS;
    LAS unsigned* bmask = (LAS unsigned*)(lds + MISC_OFF + 64);
    const int tok = t0 + 8 * w + (r >> 2), head = r & 3;
    const LAS unsigned char* qrow = Qs + (32 * w + r) * QP;
    __syncthreads();
    if (tid == 0) *bmask = 0u;
    for (int ch = tid; ch < 4096; ch += 512) { const int row = ch >> 4, dc = (ch & 15) * 8;
        *(LAS u32x4*)(Qs + row * QP + dc * 2) = *(const u32x4*)(proj + (size_t)(b * T + t0 + (row >> 2)) * NP + C_NQ + (g * 4 + (row & 3)) * 128 + dc); }
    { const bf16* kc = (const bf16*)(ws + WS_KC) + (size_t)bg * 16384; const bf16* vct = (const bf16*)(ws + WS_VCT) + (size_t)bg * 16384;
      for (int ch = tid; ch < 2048; ch += 512) { const int row = ch >> 4, dc = (ch & 15) * 8;
          *(LAS u32x4*)(Ks + row * KP + dc * 2) = *(const u32x4*)(kc + row * 128 + dc);
          const u32x4 v = *(const u32x4*)(vct + row * 128 + dc); LAS u32x2* d = (LAS u32x2*)(Vs + row * VCP + dc * 2); d[0] = (u32x2){v.x, v.y}; d[1] = (u32x2){v.z, v.w}; } }
    __syncthreads();
    float gt0, gt1, gt2;
    { const bf16* gp = proj + (size_t)(b * T + tok) * NP + C_NG + (g * 4 + head) * 3; gt0 = sigmoid_f(bf2f(gp[0])); gt1 = sigmoid_f(bf2f(gp[1])); gt2 = sigmoid_f(bf2f(gp[2])); }
    unsigned selmask;
    bf16* op = (bf16*)(ws + WS_CAT) + (size_t)(b * T + tok) * 2048 + 1024 + (g * 4 + head) * 128;
    {
        f32x16 st[4]; f32x16 Ot[4];
#pragma unroll
        for (int kb = 0; kb < 4; ++kb) st[kb] = zero16();
#pragma unroll
        for (int ks = 0; ks < 8; ++ks) { const bf16x8 qf = *(const LAS bf16x8*)(qrow + (16 * ks + 8 * h) * 2);
#pragma unroll
            for (int kb = 0; kb < 4; ++kb) { const bf16x8 kf = *(const LAS bf16x8*)(Ks + (32 * kb + r) * KP + (16 * ks + 8 * h) * 2); st[kb] = MFMA32(kf, qf, st[kb]); }
            asm volatile("" ::: "memory"); }
        float mx = -1e30f;
        const int clim = (tok - 31) >> 4;
        const int climh = (clim < 126 ? clim : 126) - 4 * h;
#pragma unroll
        for (int kb = 0; kb < 4; ++kb)
#pragma unroll
            for (int reg = 0; reg < 16; ++reg) { const int KC = 32 * kb + (reg & 3) + 8 * (reg >> 2);
                const float v = (KC <= climh) ? st[kb][reg] * NSA_SCL : -1e30f; st[kb][reg] = v; mx = fmaxf(mx, v); }
        mx = fmaxf(mx, __shfl_xor(mx, 32));
        float sm = 0.f;
#pragma unroll
        for (int kb = 0; kb < 4; ++kb)
#pragma unroll
            for (int reg = 0; reg < 16; ++reg) { const float v = st[kb][reg]; const float p = v > -1e29f ? __builtin_amdgcn_exp2f(v - mx) : 0.f; st[kb][reg] = p; sm += p; }
        sm += __shfl_xor(sm, 32);
        const float inv = sm > 0.f ? 1.f / sm : 0.f;
#pragma unroll
        for (int kb = 0; kb < 4; ++kb) st[kb] = st[kb] * inv;
        float imp[16], lastv[16];
#pragma unroll
        for (int i = 0; i < 16; ++i) { const int kb = i >> 2, rq = i & 3; imp[i] = (st[kb][4 * rq] + st[kb][4 * rq + 1]) + (st[kb][4 * rq + 2] + st[kb][4 * rq + 3]); lastv[i] = __shfl_xor(st[kb][4 * rq + 3], 32); }
#pragma unroll
        for (int i = 0; i < 16; ++i) { const float prev = h ? lastv[i] : (i > 0 ? lastv[i > 0 ? i - 1 : 0] : 0.f); imp[i] += prev; }
#pragma unroll
        for (int i = 0; i < 16; ++i) { imp[i] += __shfl_xor(imp[i], 1); imp[i] += __shfl_xor(imp[i], 2); }
        float sc[16], so[16];
#pragma unroll
        for (int i = 0; i < 16; ++i) { const int s = 2 * i + h; const bool forced = (s == 0) || (s == cur) || (s == cur - 1); sc[i] = s <= cur ? imp[i] + (forced ? 1e4f : 0.f) : -1.f; }
#pragma unroll
        for (int i = 0; i < 16; ++i) so[i] = __shfl_xor(sc[i], 32);
        unsigned mine = 0u;
#pragma unroll
        for (int i = 0; i < 16; ++i) { int rank = 0;
#pragma unroll
            for (int i2 = 0; i2 < 16; ++i2) {
                rank += (sc[i2] > sc[i] || (sc[i2] == sc[i] && i2 < i)) ? 1 : 0;
                const bool lower = h ? (i2 <= i) : (i2 < i);
                rank += (so[i2] > sc[i] || (so[i2] == sc[i] && lower)) ? 1 : 0; }
            if (rank < 16 && (2 * i + h) <= cur) mine |= 1u << (2 * i + h); }
        selmask = mine | __shfl_xor(mine, 32);
        if ((lane & 35) == 0) __hip_atomic_fetch_or(bmask, selmask, __ATOMIC_RELAXED, __HIP_MEMORY_SCOPE_WORKGROUP);
#pragma unroll
        for (int eb = 0; eb < 4; ++eb) Ot[eb] = zero16();
#pragma unroll
        for (int kb = 0; kb < 4; ++kb) {
            { const bf16x8 pf = pack_step<0>(st[kb]);
#pragma unroll
              for (int eb = 0; eb < 4; ++eb) { const LAS unsigned char* vp = Vs + (32 * eb + r) * VCP + (32 * kb + 4 * h) * 2; const bf16x8 vf = cat4(*(const LAS bf16x4*)vp, *(const LAS bf16x4*)(vp + 16)); Ot[eb] = MFMA32(vf, pf, Ot[eb]); } }
            asm volatile("" ::: "memory");
            { const bf16x8 pf = pack_step<1>(st[kb]);
#pragma unroll
              for (int eb = 0; eb < 4; ++eb) { const LAS unsigned char* vp = Vs + (32 * eb + r) * VCP + (32 * kb + 16 + 4 * h) * 2; const bf16x8 vf = cat4(*(const LAS bf16x4*)vp, *(const LAS bf16x4*)(vp + 16)); Ot[eb] = MFMA32(vf, pf, Ot[eb]); } }
            asm volatile("" ::: "memory");
        }
#pragma unroll
        for (int eb = 0; eb < 4; ++eb)
#pragma unroll
            for (int rq = 0; rq < 4; ++rq) { u32x2 wv; wv.x = cvt_pk_bf16(Ot[eb][4 * rq] * gt0, Ot[eb][4 * rq + 1] * gt0); wv.y = cvt_pk_bf16(Ot[eb][4 * rq + 2] * gt0, Ot[eb][4 * rq + 3] * gt0);
                *(u32x2*)(op + 32 * eb + 8 * rq + 4 * h) = wv; }
    }
    __syncthreads();
    const unsigned blockmask = *bmask;
#pragma unroll 1
    for (int br = 0; br < NSA_NBR; ++br) {
        f32x16 O[4];
#pragma unroll
        for (int eb = 0; eb < 4; ++eb) O[eb] = zero16();
        float m = -1e30f, l = 0.f;
        const int kcol = (br ? C_KW : C_KS) + g * 128;
        const bf16* vT = (const bf16*)(ws + (br ? WS_VWT : WS_VST)) + (size_t)bg * 128 * T;
        const int jlo = br ? (cur > 8 ? cur - 8 : 0) : 0;
#pragma unroll 1
        for (int j = jlo; j <= cur; ++j) {
            if (!br && !((blockmask >> j) & 1u)) continue;
            __syncthreads();
            for (int ch = tid; ch < 1024; ch += 512) { const int kk = ch >> 4, dc = (ch & 15) * 8;
                *(LAS u32x4*)(Ks + kk * KP + dc * 2) = *(const u32x4*)(proj + (size_t)(b * T + 64 * j + kk) * NP + kcol + dc); }
            for (int ch = tid; ch < 1024; ch += 512) { const int e = ch >> 3, k8 = (ch & 7) * 8;
                const u32x4 v = *(const u32x4*)(vT + (size_t)e * T + 64 * j + k8); LAS u32x2* d = (LAS u32x2*)(Vs + e * VP + k8 * 2); d[0] = (u32x2){v.x, v.y}; d[1] = (u32x2){v.z, v.w}; }
            __syncthreads();
            const int kbase = 64 * j;
            if (!br) {
                const bool mysel = (selmask >> j) & 1u;
                if (__ballot(mysel) != 0ull) attn_tile(qrow, Ks, Vs, r, h, m, l, O, -1000000, mysel ? (tok - kbase - 4 * h) : -1000000);
            } else {
                attn_tile(qrow, Ks, Vs, r, h, m, l, O, tok - kbase - 4 * h - 512, tok - kbase - 4 * h);
            }
        }
        const float sc = (l > 0.f ? 1.f / l : 0.f) * (br ? gt2 : gt1);
        VM_WAIT();
#pragma unroll
        for (int eb = 0; eb < 4; ++eb)
#pragma unroll
            for (int rq = 0; rq < 4; ++rq) { u32x2* p = (u32x2*)(op + 32 * eb + 8 * rq + 4 * h); const u32x2 old = *p;
                u32x2 wv; wv.x = cvt_pk_bf16(bflo(old.x) + O[eb][4 * rq] * sc, bfhi(old.x) + O[eb][4 * rq + 1] * sc); wv.y = cvt_pk_bf16(bflo(old.y) + O[eb][4 * rq + 2] * sc, bfhi(old.y) + O[eb][4 * rq + 3] * sc);
                *p = wv; }
    }
}

__device__ __forceinline__ void phase6(const Args& a, LAS unsigned char* lds) {
    for (int it = blockIdx.x; it < 1024; it += gridDim.x) {
#if defined(P6_ONLY_NSA)
        if (it < 512) nsa_item(a, lds, it);
#elif defined(P6_ONLY_R2)
        if (it >= 512) r2_item(a, it - 512);
#else
        if (it < 512) nsa_item(a, lds, it); else r2_item(a, it - 512);
#endif
    }
}

__device__ __forceinline__ void phase9(const Args& a, LAS unsigned char* lds) {
    const int tid = threadIdx.x, lane = tid & 63, wave = __builtin_amdgcn_readfirstlane(tid >> 6), q = lane >> 4, r = lane & 15;
    unsigned char* ws = a.ws;
    const bf16* h2 = (const bf16*)(ws + WS_H); const bf16* wrt = (const bf16*)(ws + WS_WRT);
    const float* bgrp = a.in[I_BGRP]; const float* bexp = a.in[I_BEXP];
    unsigned* cnt = (unsigned*)(ws + WS_CTL) + CW_CNT; int* asg = (int*)(ws + WS_ASG); float* rw = (float*)(ws + WS_RW);
    LAS float* lg = (LAS float*)(lds + wave * 8192);
    const int gw = blockIdx.x * NWAVES + wave, NGW = gridDim.x * NWAVES;
    for (int wi = gw; wi < M / 16; wi += NGW) {
        const bf16* A = h2 + (size_t)(wi * 16 + r) * D;
        f32x4 acc[5];
#pragma unroll
        for (int nt = 0; nt < 5; ++nt) acc[nt] = (f32x4){0.f, 0.f, 0.f, 0.f};
#pragma unroll 2
        for (int k0 = 0; k0 < D; k0 += 32) { const bf16x8 af = *(const bf16x8*)(A + k0 + 8 * q);
#pragma unroll
            for (int nt = 0; nt < 5; ++nt) { const bf16x8 bfr = *(const bf16x8*)(wrt + (size_t)(16 * nt + r) * D + k0 + 8 * q); acc[nt] = MFMA16(bfr, af, acc[nt]); } }
#pragma unroll
        for (int nt = 0; nt < 5; ++nt) *(LAS f32x4*)(lg + r * 84 + 16 * nt + 4 * q) = acc[nt];
        LDS_WAIT();
        if (lane < 16) {
            const int tok = wi * 16 + lane; const LAS float* L = lg + lane * 84;
            float gl[8]; float gmax = -3.0e38f; int gi = 0;
#pragma unroll
            for (int i = 0; i < 8; ++i) { gl[i] = L[i] + bgrp[i]; if (gl[i] > gmax) { gmax = gl[i]; gi = i; } }
            float gs = 0.f;
#pragma unroll
            for (int i = 0; i < 8; ++i) gs += __expf(gl[i] - gmax);
            const float pg = 1.f / gs;
            float el[8]; float m1 = -3.0e38f; int i1 = 0;
#pragma unroll
            for (int i = 0; i < 8; ++i) { el[i] = L[8 + gi * 8 + i] + bexp[gi * 8 + i]; if (el[i] > m1) { m1 = el[i]; i1 = i; } }
            float m2 = -3.0e38f; int i2 = 0;
#pragma unroll
            for (int i = 0; i < 8; ++i) { if (i != i1 && el[i] > m2) { m2 = el[i]; i2 = i; } }
            const float e2 = __expf(m2 - m1); const float w1 = pg / (1.f + e2), w2 = pg * e2 / (1.f + e2);
            const int ea = gi * 8 + i1, eb = gi * 8 + i2;
            const unsigned pa = atomicAdd(cnt + ea, 1u); asg[(size_t)ea * CAP + pa] = tok * 2;     rw[(size_t)ea * CAP + pa] = w1;
            const unsigned pb = atomicAdd(cnt + eb, 1u); asg[(size_t)eb * CAP + pb] = tok * 2 + 1; rw[(size_t)eb * CAP + pb] = w2;
        }
        LDS_WAIT();
    }
}

constexpr int MOE_TAB_OFF = 131072;
__device__ __forceinline__ void moe_tables(const Args& a, LAS unsigned char* lds) {
    const int tid = threadIdx.x;
    LAS int* cntL = (LAS int*)(lds + MOE_TAB_OFF); LAS int* tst = cntL + 64;
    const unsigned* cnt = (const unsigned*)(a.ws + WS_CTL) + CW_CNT;
    __syncthreads();
    if (tid < 64) cntL[tid] = (int)__hip_atomic_load(cnt + tid, __ATOMIC_RELAXED, __HIP_MEMORY_SCOPE_AGENT);
    __syncthreads();
    if (tid == 0) { int ts = 0; for (int e = 0; e < 64; ++e) { tst[e] = ts; ts += (cntL[e] + 255) >> 8; } tst[64] = ts; }
    __syncthreads();
}
__device__ __forceinline__ void phase10(const Args& a, LAS unsigned char* lds) {
    const int tid = threadIdx.x;
    unsigned char* ws = a.ws;
    moe_tables(a, lds);
    const LAS int* cntL = (const LAS int*)(lds + MOE_TAB_OFF); const LAS int* tst = cntL + 64; LAS int* tab = (LAS int*)(lds + MOE_TAB_OFF + 1024);
    pg8::MoeOrder1 S; S.cntL = cntL; S.tst = tst; S.npn = 4; S.G = (int)gridDim.x; S.c = (int)blockIdx.x; S.tab = tab; S.Bt = (const bf16*)(ws + WS_WGU); S.K = D;
    { const int* asg = (const int*)(ws + WS_ASG); pg8::Unit u;
      for (int i = 0; i < 12 && S.next(i, u); ++i) if (tid < 256) { const int p = u.pm * 256 + tid; tab[i * 256 + tid] = p < cntL[u.e] ? (asg[(size_t)u.e * CAP + p] >> 1) : 0; } }
    __syncthreads();
    pg8::Gemm g{(const bf16*)(ws + WS_H), (const bf16*)(ws + WS_WGU), 0, 0, D};
    pg8::EpiMoe1 E{(bf16*)(ws + WS_A), cntL, tst};
    pg8::gemm_phase2<pg8::EpiMoe1, pg8::MoeOrder1, true>(lds, g, S, E);
}
__device__ __forceinline__ void phase11(const Args& a, LAS unsigned char* lds) {
    unsigned char* ws = a.ws;
    moe_tables(a, lds);
    const LAS int* cntL = (const LAS int*)(lds + MOE_TAB_OFF); const LAS int* tst = cntL + 64;
    pg8::MoeOrder2 S; S.cntL = cntL; S.tst = tst; S.npn = 8; S.G = (int)gridDim.x; S.c = (int)blockIdx.x; S.Bt = (const bf16*)(ws + WS_WD); S.K = DE;
    pg8::Gemm g{(const bf16*)(ws + WS_A), (const bf16*)(ws + WS_WD), 0, 0, DE};
    pg8::EpiMoe2 E{(bf16*)(ws + WS_Y), (const int*)(ws + WS_ASG), (const float*)(ws + WS_RW), cntL, CAP, D};
    pg8::gemm_phase2<pg8::EpiMoe2, pg8::MoeOrder2, true>(lds, g, S, E);
}

template <bool WITH_MOE>
__device__ __forceinline__ void phase12(const Args& a) {
    const int tid = threadIdx.x, lane = tid & 63, wave = __builtin_amdgcn_readfirstlane(tid >> 6);
    const float* mod = (const float*)(a.ws + WS_MOD); const bf16* ybuf = (const bf16*)(a.ws + WS_Y); const float* fg = a.in[I_FG];
    const int gw = blockIdx.x * NWAVES + wave, NGW = gridDim.x * NWAVES;
    for (int row = gw; row < M; row += NGW) {
        const int b = row >> 11;
        f32x4* xr = (f32x4*)(a.out + (size_t)row * D) + lane;
        const u32x2* y0 = (const u32x2*)(ybuf + (size_t)(2 * row) * D) + lane; const u32x2* y1 = (const u32x2*)(ybuf + (size_t)(2 * row + 1) * D) + lane;
        const f32x4* g2 = (const f32x4*)(mod + (size_t)b * 12288 + 5 * 2048) + lane;
        f32x4 v[8]; float ss = 0.f;
#pragma unroll
        for (int j = 0; j < 8; ++j) { v[j] = xr[64 * j];
            if (WITH_MOE) { const u32x2 p0 = y0[64 * j], p1 = y1[64 * j]; const f32x4 gg = g2[64 * j];
                v[j][0] += gg[0] * (bflo(p0.x) + bflo(p1.x)); v[j][1] += gg[1] * (bfhi(p0.x) + bfhi(p1.x)); v[j][2] += gg[2] * (bflo(p0.y) + bflo(p1.y)); v[j][3] += gg[3] * (bfhi(p0.y) + bfhi(p1.y)); }
            ss += (v[j][0] * v[j][0] + v[j][1] * v[j][1]) + (v[j][2] * v[j][2] + v[j][3] * v[j][3]); }
        const float rstd = rsqrtf(wave_sum(ss) * (1.f / 2048.f) + EPS);
#pragma unroll
        for (int j = 0; j < 8; ++j) { const f32x4 f4 = *((const f32x4*)fg + lane + 64 * j); xr[64 * j] = v[j] * rstd * f4; }
    }
}

constexpr int NPHASES = 13;
#ifndef MK_N_LAUNCHES
#define MK_N_LAUNCHES 1
#endif
__global__ void __launch_bounds__(NWAVES * 64, 2) fwd(Args a) {
    extern __shared__ __attribute__((aligned(16))) unsigned char lds_raw[];
    LAS unsigned char* lds = (LAS unsigned char*)lds_raw;
    const int tid = threadIdx.x;
    if (tid < 64) ((LAS unsigned*)(lds + MISC_OFF))[tid] = 0u;
    __syncthreads();
    XcdBarrier bar; bar.bar = (unsigned*)(a.ws + WS_CTL) + CW_BAR; bar.x = 0; bar.st = nullptr;
    if (a.ph_hi - a.ph_lo > 1) bar = xcd_barrier_post((unsigned*)(a.ws + WS_CTL) + CW_BAR, (volatile LAS unsigned*)(lds + MISC_OFF) + 8);
    unsigned char* ws = a.ws;
#ifndef ONLY_PHASE
#define ONLY_PHASE -1
#endif
#define IN(k) ((ONLY_PHASE < 0 || ONLY_PHASE == (k)) && a.ph_lo <= (k) && (k) < a.ph_hi)
#define SEAM(k) do { if (IN(k) && IN((k) + 1)) xcd_barrier(bar); } while (0)
#ifndef REP0
#define REP0 1
#endif
#ifndef REP3
#define REP3 1
#endif
#ifndef REP6
#define REP6 1
#endif
#ifndef REP10
#define REP10 1
#endif
    if (IN(0)) for (int rep = 0; rep < REP0; ++rep) { phase0(a, lds); if (rep + 1 < REP0) xcd_barrier(bar); }
    SEAM(0);
    if (IN(1)) norm_mod_phase<true>(a, lds, a.in[I_X], a.in[I_N1G], 0, 1, (bf16*)(ws + WS_H));
    SEAM(1);
    if (IN(2)) { pg8::Gemm g{(const bf16*)(ws + WS_H), (const bf16*)(ws + WS_WIN), M, NP, D}; pg8::PlainOrder S; S.init(M, NP, (int)gridDim.x, (int)blockIdx.x); S.Bt = g.Bt; S.K = D;
        pg8::EpiBf16 E{(bf16*)(ws + WS_PROJ), NP};
        pg8::gemm_phase2<pg8::EpiBf16, pg8::PlainOrder, true>(lds, g, S, E); }
    SEAM(2);
    if (IN(3)) for (int rep = 0; rep < REP3; ++rep) { phase3(a, lds); if (rep + 1 < REP3) xcd_barrier(bar); }
    SEAM(3);
    if (IN(4)) phase4(a, lds);
    SEAM(4);
    if (IN(5)) phase5(a, lds);
    SEAM(5);
    if (IN(6)) for (int rep = 0; rep < REP6; ++rep) { phase6(a, lds); if (rep + 1 < REP6) xcd_barrier(bar); }
    SEAM(6);
    if (IN(7)) { pg8::Gemm g{(const bf16*)(ws + WS_CAT), (const bf16*)(ws + WS_WOUT), M, D, D}; pg8::PlainOrder S; S.init(M, D, (int)gridDim.x, (int)blockIdx.x); S.Bt = g.Bt; S.K = D;
        pg8::EpiResGate E{a.in[I_X], a.out, D, (const float*)(ws + WS_MOD) + 2 * 2048, 12288, T};
        pg8::gemm_phase2<pg8::EpiResGate, pg8::PlainOrder, true>(lds, g, S, E); }
    SEAM(7);
    if (IN(8)) norm_mod_phase<false>(a, lds, a.out, a.in[I_N2G], 3, 4, (bf16*)(ws + WS_H));
    SEAM(8);
    if (IN(9)) phase9(a, lds);
    SEAM(9);
    for (int rep = 0; rep < REP10; ++rep) {
    if (IN(10)) phase10(a, lds);
    SEAM(10);
    if (IN(11)) phase11(a, lds);
    if (rep + 1 < REP10) xcd_barrier(bar); }
    SEAM(11);
    if (IN(12)) phase12<true>(a);
#undef IN
#undef SEAM
}

extern "C" void kernel_launch(void* const* d_in, const int* in_sizes, int n_in, void* d_out, int out_size, void* d_ws, size_t ws_size, hipStream_t stream) {
    static int grid = 0;
    if (grid == 0) {
        if (n_in != 23 || out_size != M * D || ws_size < WS_END) { fprintf(stderr, "kernel_launch: unexpected shapes (n_in %d, out %d, ws %zu < %zu); nothing launched\n", n_in, out_size, ws_size, (size_t)WS_END); grid = -1; return; }
        int dev = 0, cus = 0, per_cu = 0;
        if (hipGetDevice(&dev) != hipSuccess || hipDeviceGetAttribute(&cus, hipDeviceAttributeMultiprocessorCount, dev) != hipSuccess) { grid = -1; return; }
        if (hipFuncSetAttribute((const void*)fwd, hipFuncAttributeMaxDynamicSharedMemorySize, LDS_BYTES) != hipSuccess) { fprintf(stderr, "kernel_launch: hipFuncSetAttribute failed\n"); grid = -1; return; }
        if (hipOccupancyMaxActiveBlocksPerMultiprocessor(&per_cu, (const void*)fwd, NWAVES * 64, LDS_BYTES) != hipSuccess || per_cu < 1) fprintf(stderr, "kernel_launch: occupancy query reports %d\n", per_cu);
        (void)hipGetLastError();
        grid = cus;
    }
    if (grid < 0) return;
    if (hipMemsetAsync((char*)d_ws + WS_CTL, 0, CTL_ZERO_BYTES, stream) != hipSuccess) return;
    Args a{};
    for (int i = 0; i < 23; ++i) a.in[i] = (const float*)d_in[i];
    a.out = (float*)d_out; a.ws = (unsigned char*)d_ws;
    constexpr int NL = MK_N_LAUNCHES;
    for (int li = 0; li < NL; ++li) {
        a.ph_lo = (NL == 1) ? 0 : li; a.ph_hi = (NL == 1) ? NPHASES : li + 1;
        hipLaunchKernelGGL(fwd, dim3(grid), dim3(NWAVES * 64), LDS_BYTES, stream, a);
        const hipError_t le = hipPeekAtLastError();
        if (le != hipSuccess) { fprintf(stderr, "kernel_launch: launch %d failed: %s\n", li, hipGetErrorName(le)); break; }
    }
}
```

```cpp
#include <hip/hip_runtime.h>
#include <cstdio>
#include <cstdint>
namespace pg8 {
#define PG8_LAS __attribute__((address_space(3)))
typedef unsigned short bf16_t;
typedef short bf16x8 __attribute__((ext_vector_type(8)));
typedef float f32x4 __attribute__((ext_vector_type(4)));
typedef unsigned u32x4 __attribute__((ext_vector_type(4)));
constexpr int BM = 256, BK = 64, HALF = 128, HTB = HALF * BK * 2  , STAGE_BYTES = 8 * HTB, NXCD = 8, WGM = 8;

__host__ __device__ __forceinline__ int lds_byte(int r, int c) { const int st = (r >> 4) * 2 + (c >> 5), rr = r & 15, cc = c & 31, ob = rr * 64 + cc * 2; return st * 1024 + (ob ^ (((ob >> 9) & 1) << 5)); }
__host__ __device__ __forceinline__ void stage_rc(int b, int& R, int& C) { const int st = b / 1024, sb = b % 1024, swz = sb ^ (((sb >> 9) & 1) << 5); R = (st >> 1) * 16 + swz / 64; C = (st & 1) * 32 + (swz % 64) / 2; }
__host__ __device__ __forceinline__ int perm32(int rho) { const int n = rho >> 4, i = rho & 15; return 8 * (i >> 2) + 4 * n + (i & 3); }

struct Unit { int pm, pn, e, ord; };
struct Gemm { const bf16_t* A; const bf16_t* Bt; int M, N, K; };

struct StaticOrder {
    int nM, nN, nwg, G, c;
    __host__ __device__ void init(int M, int N, int G_, int c_) { nM = M / BM; nN = N / BM; nwg = nM * nN; G = G_; c = c_; }
    __host__ __device__ bool next(int i, Unit& u) const {
        const long L = (long)i * G + c; if (L >= nwg) return false;
        int wgid = (int)L; { const int q = nwg / NXCD, r = nwg % NXCD, xcd = wgid % NXCD, off = wgid / NXCD; wgid = (xcd < r ? xcd * (q + 1) : r * (q + 1) + (xcd - r) * q) + off; }
        const int nig = WGM * nN, gid = wgid / nig, fm = gid * WGM, gsz = (nM - fm) < WGM ? (nM - fm) : WGM;
        u.pm = fm + ((wgid % nig) % gsz); u.pn = (wgid % nig) / gsz; return true;
    }
    __device__ __forceinline__ void a_ready(const Unit&) const {}
    __device__ __forceinline__ void done(const Unit&) const {}
};


typedef float f32x2 __attribute__((ext_vector_type(2)));
typedef __bf16 bf16x2_t __attribute__((ext_vector_type(2)));
__device__ __forceinline__ unsigned cvt_pk_bf16(float lo, float hi) { f32x2 v = {lo, hi}; bf16x2_t r = __builtin_convertvector(v, bf16x2_t); return __builtin_bit_cast(unsigned, r); }

struct EpiBf16 {
    static constexpr bool PERM = true, AFTER_DRAIN = false;
    bf16_t* O; int ldc;
    __device__ __forceinline__ void operator()(const f32x4 (&acc)[2][2][4][2], const Unit& u, int wr, int wc, int fr, int fq) const {
        const int row0 = u.pm * BM + wr * 64 + fr; const int col0 = u.pn * BM + wc * 32 + 8 * fq;
#pragma unroll
        for (int ai = 0; ai < 2; ++ai)
#pragma unroll
            for (int m = 0; m < 4; ++m) { bf16_t* rowp = O + (size_t)(row0 + ai * HALF + m * 16) * ldc + col0;
#pragma unroll
                for (int bj = 0; bj < 2; ++bj) { const f32x4 v0 = acc[ai][bj][m][0], v1 = acc[ai][bj][m][1];
                    u32x4 w; w.x = cvt_pk_bf16(v0[0], v0[1]); w.y = cvt_pk_bf16(v0[2], v0[3]); w.z = cvt_pk_bf16(v1[0], v1[1]); w.w = cvt_pk_bf16(v1[2], v1[3]);
                    *(u32x4*)(rowp + bj * HALF) = w; } }
    }
};
struct EpiResGate {
    static constexpr bool PERM = false, AFTER_DRAIN = false;
    const float* base; float* out; int ldc; const float* gate; int gstride; int rows_per_batch;
    __device__ __forceinline__ void operator()(const f32x4 (&acc)[2][2][4][2], const Unit& u, int wr, int wc, int fr, int fq) const {
        const int row0 = u.pm * BM + wr * 64 + fr, col0 = u.pn * BM + wc * 32 + 4 * fq;
        const float* gp = gate + (size_t)((u.pm * BM) / rows_per_batch) * gstride + col0;
        f32x4 gv[2][2];
#pragma unroll
        for (int bj = 0; bj < 2; ++bj)
#pragma unroll
            for (int n = 0; n < 2; ++n) gv[bj][n] = *(const f32x4*)(gp + bj * HALF + n * 16);
#pragma unroll
        for (int ai = 0; ai < 2; ++ai)
#pragma unroll
            for (int m = 0; m < 4; ++m) { const size_t off = (size_t)(row0 + ai * HALF + m * 16) * ldc + col0;
#pragma unroll
                for (int bj = 0; bj < 2; ++bj)
#pragma unroll
                    for (int n = 0; n < 2; ++n) { const f32x4 bs = *(const f32x4*)(base + off + bj * HALF + n * 16);
                        *(f32x4*)(out + off + bj * HALF + n * 16) = bs + gv[bj][n] * acc[ai][bj][m][n]; } }
    }
};


struct PlainOrder : StaticOrder {
    const bf16_t* Bt; int K;
    __device__ __forceinline__ void a_offs(const Unit& u, int tid, unsigned (&v)[2][2]) const {
#pragma unroll
        for (int h = 0; h < 2; ++h)
#pragma unroll
            for (int i = 0; i < 2; ++i) { int R, C; stage_rc(tid * 16 + i * 8192, R, C); v[h][i] = (unsigned)((u.pm * BM + h * HALF + R) * K + C) * 2u; }
    }
    __device__ __forceinline__ const char* b_base(const Unit& u) const { return (const char*)Bt + (size_t)u.pn * ((size_t)BM * K * 2); }
};
struct MoeOrder {
    const PG8_LAS int* cntL; const PG8_LAS int* tst; int npn, G, c;
    __device__ __forceinline__ bool next(int i, Unit& u) const {
        const int L = i * G + c; if (L >= tst[64] * npn) return false;
        const int tile = L / npn; u.pn = L - tile * npn; int e = 0; while (tst[e + 1] <= tile) ++e; u.e = e; u.pm = tile - tst[e]; u.ord = i; return true; }
};
struct MoeOrder1 : MoeOrder {
    const PG8_LAS int* tab; const bf16_t* Bt; int K;
    __device__ __forceinline__ void a_offs(const Unit& u, int tid, unsigned (&v)[2][2]) const {
#pragma unroll
        for (int h = 0; h < 2; ++h)
#pragma unroll
            for (int i = 0; i < 2; ++i) { int R, C; stage_rc(tid * 16 + i * 8192, R, C); v[h][i] = (unsigned)(tab[u.ord * 256 + h * HALF + R] * K + C) * 2u; }
    }
    __device__ __forceinline__ const char* b_base(const Unit& u) const { return (const char*)Bt + ((size_t)u.e * 1024 + (size_t)u.pn * 256) * ((size_t)K * 2); }
};
struct MoeOrder2 : MoeOrder {
    const bf16_t* Bt; int K;
    __device__ __forceinline__ void a_offs(const Unit& u, int tid, unsigned (&v)[2][2]) const {
        const int row0 = 256 * (tst[u.e] + u.pm);
#pragma unroll
        for (int h = 0; h < 2; ++h)
#pragma unroll
            for (int i = 0; i < 2; ++i) { int R, C; stage_rc(tid * 16 + i * 8192, R, C); v[h][i] = (unsigned)((row0 + h * HALF + R) * K + C) * 2u; }
    }
    __device__ __forceinline__ const char* b_base(const Unit& u) const { return (const char*)Bt + ((size_t)u.e * 2048 + (size_t)u.pn * 256) * ((size_t)K * 2); }
};
struct EpiMoe1 {
    static constexpr bool PERM = true, AFTER_DRAIN = false;
    bf16_t* abuf; const PG8_LAS int* cntL; const PG8_LAS int* tst;
    __device__ __forceinline__ void operator()(const f32x4 (&acc)[2][2][4][2], const Unit& u, int wr, int wc, int fr, int fq) const {
        const int ne = cntL[u.e]; const size_t row0 = (size_t)256 * (tst[u.e] + u.pm);
        asm volatile("" : "+v"(fr), "+v"(fq));
#pragma unroll
        for (int ai = 0; ai < 2; ++ai)
#pragma unroll
            for (int m = 0; m < 4; ++m) { const int r = ai * HALF + wr * 64 + m * 16 + fr;
                if (u.pm * 256 + r < ne) { const f32x4 g0 = acc[ai][0][m][0], g1 = acc[ai][0][m][1], u0 = acc[ai][1][m][0], u1 = acc[ai][1][m][1];
                    f32x4 a0, a1;
#pragma unroll
                    for (int j = 0; j < 4; ++j) { a0[j] = g0[j] * __builtin_amdgcn_rcpf(1.f + __builtin_amdgcn_exp2f(-1.4426950408889634f * g0[j])) * u0[j]; a1[j] = g1[j] * __builtin_amdgcn_rcpf(1.f + __builtin_amdgcn_exp2f(-1.4426950408889634f * g1[j])) * u1[j]; }
                    u32x4 w; w.x = cvt_pk_bf16(a0[0], a0[1]); w.y = cvt_pk_bf16(a0[2], a0[3]); w.z = cvt_pk_bf16(a1[0], a1[1]); w.w = cvt_pk_bf16(a1[2], a1[3]);
                    *(u32x4*)(abuf + (row0 + r) * 512 + u.pn * 128 + wc * 32 + 8 * fq) = w; } }
    }
};
struct EpiMoe2 {
    static constexpr bool PERM = true, AFTER_DRAIN = false;
    bf16_t* ybuf; const int* asg; const float* rw; const PG8_LAS int* cntL; int cap, ldy;
    __device__ __forceinline__ void operator()(const f32x4 (&acc)[2][2][4][2], const Unit& u, int wr, int wc, int fr, int fq) const {
        const int ne = cntL[u.e];
#pragma unroll
        for (int ai = 0; ai < 2; ++ai)
#pragma unroll
            for (int m = 0; m < 4; ++m) { const int p = u.pm * 256 + ai * HALF + wr * 64 + m * 16 + fr;
                if (p < ne) { const int av = asg[(size_t)u.e * cap + p]; const float wv = rw[(size_t)u.e * cap + p];
                    bf16_t* rowp = ybuf + (size_t)av * ldy + u.pn * BM + wc * 32 + 8 * fq;
#pragma unroll
                    for (int bj = 0; bj < 2; ++bj) { const f32x4 v0 = acc[ai][bj][m][0] * wv, v1 = acc[ai][bj][m][1] * wv;
                        u32x4 w; w.x = cvt_pk_bf16(v0[0], v0[1]); w.y = cvt_pk_bf16(v0[2], v0[3]); w.z = cvt_pk_bf16(v1[0], v1[1]); w.w = cvt_pk_bf16(v1[2], v1[3]);
                        *(u32x4*)(rowp + bj * HALF) = w; } } }
    }
};


template <class Epi, class Sched, bool ALIGN_EPI = false>
__device__ __forceinline__ void gemm_phase2(PG8_LAS unsigned char* lds, const Gemm g, const Sched& S, const Epi& E) {
    const int tid = threadIdx.x, wid = __builtin_amdgcn_readfirstlane(tid >> 6), lane = tid & 63, wr = wid >> 2, wc = wid & 3, fr = lane & 15, fq = lane >> 4;
    const int K = g.K, nt = K / BK;
    unsigned vC[2][2], vN[2][2], voffB[2];
#pragma unroll
    for (int i = 0; i < 2; ++i) { int R, C; stage_rc(tid * 16 + i * 8192, R, C); const int Rb = Epi::PERM ? ((R & ~31) + perm32(R & 31)) : R; voffB[i] = (unsigned)(Rb * K + C) * 2u; }
    const size_t kstep = (size_t)(BK * 2);
    const size_t hstep = (size_t)HALF * K * 2;
    const unsigned ldsw = (unsigned)wid * 1024u;
    const int aoff = lds_byte(wr * 64 + fr, fq * 8), boff = lds_byte(wc * 32 + fr, fq * 8);
#define PG8_SA(b, h) (((b) * 2 + (h)) * HTB)
#define PG8_SB(b, h) ((4 + (b) * 2 + (h)) * HTB)
#define PG8_STAGE(bufoff, gbase, voff) do { _Pragma("unroll") for (int _i = 0; _i < 2; ++_i) \
        __builtin_amdgcn_global_load_lds((const unsigned*)((const char*)(gbase) + (voff)[_i]), (PG8_LAS unsigned*)(lds + (bufoff) + ldsw + _i * 8192), 16, 0, 0); } while (0)
#define PG8_LDA(dst, b, h) do { _Pragma("unroll") for (int m = 0; m < 4; ++m) _Pragma("unroll") for (int k = 0; k < 2; ++k) dst[m][k] = *(const PG8_LAS bf16x8*)(lds + PG8_SA(b, h) + aoff + m * 2048 + k * 1024); } while (0)
#define PG8_LDB(dst, b, h) do { _Pragma("unroll") for (int n = 0; n < 2; ++n) _Pragma("unroll") for (int k = 0; k < 2; ++k) dst[n][k] = *(const PG8_LAS bf16x8*)(lds + PG8_SB(b, h) + boff + n * 2048 + k * 1024); } while (0)
#define PG8_MMA(ai, bj, At, Bt) do { __builtin_amdgcn_s_setprio(1); _Pragma("unroll") for (int m = 0; m < 4; ++m) _Pragma("unroll") for (int n = 0; n < 2; ++n) _Pragma("unroll") for (int k = 0; k < 2; ++k) \
        acc[ai][bj][m][n] = __builtin_amdgcn_mfma_f32_16x16x32_bf16(Bt[n][k], At[m][k], acc[ai][bj][m][n], 0, 0, 0); __builtin_amdgcn_s_setprio(0); } while (0)
#define PG8_WAIT_V(n) asm volatile("s_waitcnt vmcnt(" #n ")" ::: "memory")
#define PG8_WAIT_L(n) asm volatile("s_waitcnt lgkmcnt(" #n ")" ::: "memory")
#define PG8_BAR __builtin_amdgcn_s_barrier()
#define PG8_SCHED __builtin_amdgcn_sched_barrier(0)
    Unit cur, nxt; int ui = 0;
    if (!S.next(0, cur)) return;
    f32x4 acc[2][2][4][2];
#pragma unroll
    for (int a = 0; a < 2; ++a)
#pragma unroll
        for (int b = 0; b < 2; ++b)
#pragma unroll
            for (int m = 0; m < 4; ++m)
#pragma unroll
                for (int n = 0; n < 2; ++n) acc[a][b][m][n] = (f32x4){0.f, 0.f, 0.f, 0.f};
    bf16x8 At[4][2], B0[2][2], B1[2][2];
    const char* Ab = (const char*)g.A; const char* cB = S.b_base(cur);
    S.a_offs(cur, tid, vC);
    PG8_STAGE(PG8_SB(0, 0), cB, voffB); PG8_STAGE(PG8_SB(0, 1), cB + hstep, voffB); PG8_STAGE(PG8_SA(0, 0), Ab, vC[0]); PG8_STAGE(PG8_SA(0, 1), Ab, vC[1]);
    if (wr == 1) PG8_BAR;
    PG8_WAIT_V(2); PG8_BAR;
    PG8_STAGE(PG8_SB(1, 0), cB + kstep, voffB); PG8_STAGE(PG8_SA(1, 0), Ab + kstep, vC[0]); PG8_STAGE(PG8_SB(1, 1), cB + hstep + kstep, voffB);
    PG8_WAIT_V(6); PG8_BAR;
    for (;;) {
        const bool has_next = S.next(ui + 1, nxt);
        const char* nB = cB;
        if (has_next) { S.a_offs(nxt, tid, vN); nB = S.b_base(nxt); }
        else {
#pragma unroll
            for (int hh = 0; hh < 2; ++hh)
#pragma unroll
                for (int i = 0; i < 2; ++i) vN[hh][i] = vC[hh][i]; }
        for (int t = 0; t < nt; t += 2) {
            const bool last = (t == nt - 2);
            const char* a1 = Ab + (size_t)(t + 1) * kstep;
            const char* a2 = last ? Ab : Ab + (size_t)(t + 2) * kstep; const char* b2 = last ? nB : cB + (size_t)(t + 2) * kstep;
            const char* a3 = a2 + kstep; const char* b3 = b2 + kstep;
            unsigned v2[2][2];
#pragma unroll
            for (int hh = 0; hh < 2; ++hh)
#pragma unroll
                for (int i = 0; i < 2; ++i) v2[hh][i] = last ? vN[hh][i] : vC[hh][i];
            PG8_LDB(B0, 0, 0); PG8_LDB(B1, 0, 1); PG8_SCHED; PG8_LDA(At, 0, 0); PG8_STAGE(PG8_SA(1, 1), a1, vC[1]);
            PG8_WAIT_V(8); PG8_WAIT_L(0); PG8_BAR; PG8_MMA(0, 0, At, B0); PG8_MMA(0, 1, At, B1); PG8_BAR; PG8_SCHED;
            PG8_LDA(At, 0, 1); PG8_STAGE(PG8_SB(0, 0), b2, voffB); PG8_STAGE(PG8_SB(0, 1), b2 + hstep, voffB); PG8_STAGE(PG8_SA(0, 0), a2, v2[0]);
            PG8_WAIT_V(8); PG8_WAIT_L(0); PG8_BAR; PG8_MMA(1, 0, At, B0); PG8_MMA(1, 1, At, B1); PG8_BAR; PG8_SCHED;
            PG8_LDB(B0, 1, 0); PG8_LDB(B1, 1, 1); PG8_SCHED; PG8_LDA(At, 1, 0); PG8_STAGE(PG8_SA(0, 1), a2, v2[1]);
            PG8_WAIT_V(8); PG8_WAIT_L(0); PG8_BAR; PG8_MMA(0, 0, At, B0); PG8_MMA(0, 1, At, B1); PG8_BAR; PG8_SCHED;
            PG8_LDA(At, 1, 1); PG8_STAGE(PG8_SB(1, 0), b3, voffB); PG8_STAGE(PG8_SB(1, 1), b3 + hstep, voffB); PG8_STAGE(PG8_SA(1, 0), a3, v2[0]);
            PG8_WAIT_V(8); PG8_WAIT_L(0); PG8_BAR; PG8_MMA(1, 0, At, B0); PG8_MMA(1, 1, At, B1); PG8_BAR; PG8_SCHED;
        }
        if constexpr (ALIGN_EPI) { if (wr == 0) PG8_BAR; }
        E(acc, cur, wr, wc, fr, fq);
        if (!has_next) break;
#pragma unroll
        for (int a = 0; a < 2; ++a)
#pragma unroll
            for (int b = 0; b < 2; ++b)
#pragma unroll
                for (int m = 0; m < 4; ++m)
#pragma unroll
                    for (int n = 0; n < 2; ++n) acc[a][b][m][n] = (f32x4){0.f, 0.f, 0.f, 0.f};
        cur = nxt; cB = nB; ++ui;
#pragma unroll
        for (int hh = 0; hh < 2; ++hh)
#pragma unroll
            for (int i = 0; i < 2; ++i) vC[hh][i] = vN[hh][i];
        if constexpr (ALIGN_EPI) { if (wr == 1) PG8_BAR; }
    }
    PG8_WAIT_V(0);
    if constexpr (!ALIGN_EPI) { if (wr == 0) PG8_BAR; }
    PG8_BAR;
#undef PG8_SA
#undef PG8_SB
#undef PG8_STAGE
#undef PG8_LDA
#undef PG8_LDB
#undef PG8_MMA
#undef PG8_WAIT_V
#undef PG8_WAIT_L
#undef PG8_BAR
#undef PG8_SCHED
}
}

constexpr int NB = 8, T = 2048, D = 2048, M = NB * T;
constexpr int NP = 6912, PROJ = 6680;
constexpr int C_RQ = 0, C_RK = 1024, C_RV = 2048, C_RG = 3072, C_NQ = 4096, C_KC = 5120, C_VC = 5376, C_KS = 5632, C_VS = 5888, C_KW = 6144, C_VW = 6400, C_NG = 6656;
constexpr int NEXP = 64, DE = 512, CAP = 32768;
constexpr float EPS = 1e-6f;
constexpr int NWAVES = 8;

constexpr size_t MiB = 1u << 20;
constexpr size_t WS_CTL = 0, CTL_ZERO_BYTES = 1 * MiB;
constexpr size_t WS_SMALL = 1 * MiB;
constexpr size_t WS_BIAS1K = WS_SMALL, WS_BIAS1V = WS_SMALL + 1024, WS_W2KT = WS_SMALL + 4096, WS_W2VT = WS_W2KT + 65536, WS_WRT = WS_W2VT + 65536;
constexpr size_t WS_MODP = 2 * MiB;
constexpr size_t WS_MOD = WS_MODP + 4 * 8 * 12288 * 4;
constexpr size_t WS_COS = 4 * MiB, WS_SIN = 5 * MiB;
constexpr size_t WS_W1K = 6 * MiB, WS_W1V = 8 * MiB;
constexpr size_t WS_YK = 10 * MiB, WS_YV = 14 * MiB;
constexpr size_t WS_KC = 18 * MiB, WS_VCT = 19 * MiB;
constexpr size_t WS_BIAS1P = 20 * MiB;
constexpr size_t WS_ASG = 26 * MiB, WS_RW = 34 * MiB;
constexpr size_t WS_WIN = 42 * MiB;
constexpr size_t WS_WOUT = 70 * MiB;
constexpr size_t WS_WGU = 78 * MiB;
constexpr size_t WS_WD = 334 * MiB;
constexpr size_t WS_H = 462 * MiB;
constexpr size_t WS_PROJ = 526 * MiB;
constexpr size_t WS_Y = 526 * MiB;
constexpr size_t WS_A = 654 * MiB;
constexpr size_t WS_QR = 742 * MiB, WS_KR = 774 * MiB, WS_KZT = 806 * MiB, WS_VT = 838 * MiB;
constexpr size_t WS_SP = 870 * MiB;
constexpr size_t WS_KCMP = 934 * MiB, WS_VCMP = 942 * MiB, WS_VST = 950 * MiB, WS_VWT = 958 * MiB;
constexpr size_t WS_CAT = 966 * MiB;
constexpr size_t WS_END = 1030 * MiB;
constexpr int CW_BAR = 4096;
constexpr int CW_CNT = 8192;

constexpr int LDS_BYTES = 147456;
constexpr int MISC_OFF = LDS_BYTES - 256;

#define GAS __attribute__((address_space(1)))
#define LAS __attribute__((address_space(3)))
typedef unsigned short bf16;
typedef short bf16x8 __attribute__((ext_vector_type(8)));
typedef short bf16x4 __attribute__((ext_vector_type(4)));
typedef float f32x4 __attribute__((ext_vector_type(4)));
typedef float f32x16 __attribute__((ext_vector_type(16)));
typedef unsigned u32x4 __attribute__((ext_vector_type(4)));
typedef unsigned u32x2 __attribute__((ext_vector_type(2)));
#define LDS_WAIT() asm volatile("s_waitcnt lgkmcnt(0)" ::: "memory")
#define VM_WAIT() asm volatile("s_waitcnt vmcnt(0)" ::: "memory")
#define MFMA16(a, b, c) __builtin_amdgcn_mfma_f32_16x16x32_bf16((a), (b), (c), 0, 0, 0)
#define MFMA32(a, b, c) __builtin_amdgcn_mfma_f32_32x32x16_bf16((a), (b), (c), 0, 0, 0)
using pg8::cvt_pk_bf16;
__device__ __forceinline__ float bf2f(unsigned short b) { return __uint_as_float(((unsigned)b) << 16); }
__device__ __forceinline__ float bflo(unsigned w) { return __uint_as_float(w << 16); }
__device__ __forceinline__ float bfhi(unsigned w) { return __uint_as_float(w & 0xffff0000u); }
__device__ __forceinline__ float wave_sum(float v) {
#pragma unroll
    for (int o = 1; o < 64; o <<= 1) v += __shfl_xor(v, o);
    return v;
}
__device__ __forceinline__ float silu_f(float x) { return x / (1.f + __expf(-x)); }
__device__ __forceinline__ float sigmoid_f(float x) { return 1.f / (1.f + __expf(-x)); }
__device__ __forceinline__ bf16x8 cat4(bf16x4 lo, bf16x4 hi) { return __builtin_shufflevector(lo, hi, 0, 1, 2, 3, 4, 5, 6, 7); }
__device__ __forceinline__ bf16x8 pack8(const f32x4 a, const f32x4 b) { u32x4 p; p.x = cvt_pk_bf16(a[0], a[1]); p.y = cvt_pk_bf16(a[2], a[3]); p.z = cvt_pk_bf16(b[0], b[1]); p.w = cvt_pk_bf16(b[2], b[3]); return __builtin_bit_cast(bf16x8, p); }

#define XB_TMO      128
#define XB_XCNT(j)  (256  + 64 * (j))
#define XB_XSUB(j)  (1280 + 64 * (j))
#define XB_XGEN(j)  (2304 + 64 * (j))
#define XB_TOP      3328
#define XB_TOPGEN   3392
#define XCD_BAR_WORDS 3456
#define XB_SPIN_CAP (1u << 18)

__device__ __forceinline__ unsigned xb_ld(unsigned* p)              { return __hip_atomic_load(p, __ATOMIC_RELAXED, __HIP_MEMORY_SCOPE_AGENT); }
__device__ __forceinline__ unsigned xb_add(unsigned* p, unsigned v) { return __hip_atomic_fetch_add(p, v, __ATOMIC_RELAXED, __HIP_MEMORY_SCOPE_AGENT); }
__device__ __forceinline__ unsigned xb_xcc_id() { return (unsigned)__builtin_amdgcn_s_getreg((3 << 11) | 20) & 0xFu; }
#define XB_SPIN(cond, bar) do { unsigned _sp = 0; while (cond) { __builtin_amdgcn_s_sleep(1); \
    if ((++_sp & 255u) == 0u) { if (xb_ld(&(bar)[XB_TMO])) break; if (_sp > XB_SPIN_CAP) { atomicAdd(&(bar)[XB_TMO], 1u); break; } } } } while (0)

struct XcdBarrier {
    unsigned* bar; unsigned x;
    volatile LAS unsigned* st;
};

__device__ __forceinline__ XcdBarrier xcd_barrier_post(unsigned* bar, volatile LAS unsigned* st) {
    XcdBarrier b; b.bar = bar; b.x = xb_xcc_id(); b.st = st;
    if (threadIdx.x == 0) (void)xb_add(&bar[XB_XCNT(b.x)], 1u);
    return b;
}
__device__ __forceinline__ void xcd_barrier_complete(unsigned* bar, unsigned x, unsigned& nloc, unsigned& nx) {
    const unsigned G = gridDim.x * gridDim.y * gridDim.z;
    unsigned sum, cnt, mine, sp = 0u;
    for (;;) {
        sum = 0u; cnt = 0u; mine = 0u;
#pragma unroll
        for (unsigned j = 0; j < 16; ++j) { const unsigned c = xb_ld(&bar[XB_XCNT(j)]); sum += c; cnt += (c > 0u) ? 1u : 0u; mine = (j == x) ? c : mine; }
        if (sum == G) break;
        __builtin_amdgcn_s_sleep(1);
        if ((++sp & 255u) == 0u) { if (xb_ld(&bar[XB_TMO])) break; if (sp > XB_SPIN_CAP) { atomicAdd(&bar[XB_TMO], 1u); break; } }
    }
    nloc = mine > 0u ? mine : 1u; nx = cnt > 0u ? cnt : 1u;
}

__device__ __forceinline__ void xcd_barrier(const XcdBarrier& b) {
    asm volatile("s_waitcnt vmcnt(0)" ::: "memory");
    __syncthreads();
    if (threadIdx.x == 0) {
        unsigned* bar = b.bar;
        __builtin_amdgcn_s_waitcnt(0);
        unsigned nloc = b.st[0], nx = b.st[1];
        if (nloc == 0u) { xcd_barrier_complete(bar, b.x, nloc, nx); b.st[0] = nloc; b.st[1] = nx; }
        const unsigned old = xb_add(&bar[XB_XSUB(b.x)], 1u);
        const unsigned gen = old / nloc;
        if (old + 1u == (gen + 1u) * nloc) {
            __builtin_amdgcn_fence(__ATOMIC_RELEASE, "agent");
            asm volatile("s_waitcnt vmcnt(0)" ::: "memory");
            const unsigned og = xb_add(&bar[XB_TOP], 1u);
            const unsigned tg = og / nx;
            if (og + 1u == (tg + 1u) * nx) xb_add(&bar[XB_TOPGEN], 1u);
            else XB_SPIN(xb_ld(&bar[XB_TOPGEN]) == tg, bar);
            __builtin_amdgcn_fence(__ATOMIC_ACQUIRE, "agent");
            xb_add(&bar[XB_XGEN(b.x)], 1u);
            asm volatile("s_waitcnt vmcnt(0)" ::: "memory");
        } else {
            XB_SPIN(xb_ld(&bar[XB_XGEN(b.x)]) == gen, bar);
            __builtin_amdgcn_fence(__ATOMIC_ACQUIRE, "agent");
            asm volatile("s_waitcnt vmcnt(0)" ::: "memory");
        }
    }
    __syncthreads();
}

struct Args { const float* in[23]; float* out; unsigned char* ws; int ph_lo, ph_hi; };
enum { I_X = 0, I_C, I_WADA, I_BADA, I_N1G, I_N2G, I_FG, I_WIN, I_GNG, I_PK, I_W1K, I_W2K, I_PV, I_W1V, I_W2V, I_WOUT, I_WGRP, I_BGRP, I_WEXP, I_BEXP, I_WGATE, I_WUP, I_WDOWN };

__device__ __forceinline__ float ret_lg(int h) { return h == 0 ? -0.0317486983145803f : (h == 1 ? -0.015748356968139168f : (h == 2 ? -0.007843177461025893f : -0.003913899321136329f)); }

__device__ __forceinline__ void transpose_tile(const float* __restrict__ W, int ldw, int k0, int n0, int nmax, bf16* __restrict__ WT, int ldt, int drow0, int dcol0, LAS float* scr, int lane) {
    const int kr = lane >> 4, n4 = (lane & 15) * 4;
    f32x4 v[16];
    const bool ok = (n0 + n4) < nmax;
    const float* src = W + (size_t)(k0 + kr) * ldw + n0 + n4;
#pragma unroll
    for (int i = 0; i < 16; ++i) v[i] = ok ? *(const f32x4*)(src + (size_t)(4 * i) * ldw) : (f32x4){0.f, 0.f, 0.f, 0.f};
#pragma unroll
    for (int i = 0; i < 16; ++i) { LAS float* d = scr + (4 * i + kr) * 65 + n4; d[0] = v[i][0]; d[1] = v[i][1]; d[2] = v[i][2]; d[3] = v[i][3]; }
    LDS_WAIT();
    const int c = lane & 7;
#pragma unroll
    for (int j = 0; j < 8; ++j) { const int nn = 8 * j + (lane >> 3); const LAS float* s = scr + (8 * c) * 65 + nn;
        u32x4 o; o.x = cvt_pk_bf16(s[0 * 65], s[1 * 65]); o.y = cvt_pk_bf16(s[2 * 65], s[3 * 65]); o.z = cvt_pk_bf16(s[4 * 65], s[5 * 65]); o.w = cvt_pk_bf16(s[6 * 65], s[7 * 65]);
        *(u32x4*)(WT + (size_t)(drow0 + nn) * ldt + dcol0 + 8 * c) = o; }
    LDS_WAIT();
}

__device__ __forceinline__ void phase0(const Args& a, LAS unsigned char* lds) {
    const int tid = threadIdx.x, lane = tid & 63, wave = __builtin_amdgcn_readfirstlane(tid >> 6);
    unsigned char* ws = a.ws;
    {
        LAS float* cact = (LAS float*)lds;
        LAS float* red = (LAS float*)(lds + 16384);
        const float* c = a.in[I_C]; const float* wada = a.in[I_WADA];
        float* modp = (float*)(ws + WS_MODP);
        for (int it = blockIdx.x; it < 768; it += gridDim.x) {
            const int kq = it / 192, cc = it % 192;
            __syncthreads();
            for (int i = tid; i < 8 * 512; i += 512) { const int b = i >> 9, k = i & 511; cact[i] = silu_f(c[b * 2048 + kq * 512 + k]); }
            __syncthreads();
            float acc[8];
#pragma unroll
            for (int b = 0; b < 8; ++b) acc[b] = 0.f;
            const float* wp = wada + (size_t)(kq * 512 + wave * 64) * 12288 + cc * 64 + lane;
#pragma unroll 8
            for (int kk = 0; kk < 64; ++kk) { const float wv = wp[(size_t)kk * 12288];
#pragma unroll
                for (int b = 0; b < 8; ++b) acc[b] += cact[b * 512 + wave * 64 + kk] * wv; }
#pragma unroll
            for (int b = 0; b < 8; ++b) red[(wave * 8 + b) * 64 + lane] = acc[b];
            __syncthreads();
            { const int b = tid >> 6, l = tid & 63; float s = 0.f;
#pragma unroll
              for (int w = 0; w < 8; ++w) s += red[(w * 8 + b) * 64 + l];
              modp[((size_t)kq * 8 + b) * 12288 + cc * 64 + l] = s; }
        }
    }
    __syncthreads();
    {
        const int gw = blockIdx.x * NWAVES + wave, NGW = gridDim.x * NWAVES;
        float* bp = (float*)(ws + WS_BIAS1P);
        for (int it = NGW - 1 - gw; it < 128; it += NGW) { const int ten = it >> 6, kc = it & 63;
            const float* pe = a.in[ten ? I_PV : I_PK] + kc * 64; const float* w1 = a.in[ten ? I_W1V : I_W1K] + (size_t)kc * 64 * 256 + 4 * lane;
            f32x4 acc = (f32x4){0.f, 0.f, 0.f, 0.f};
#pragma unroll 16
            for (int k = 0; k < 64; ++k) acc = acc + *(const f32x4*)(w1 + (size_t)k * 256) * pe[k];
            *(f32x4*)(bp + (size_t)it * 256 + 4 * lane) = acc; }
    }
    {
        LAS float* scr = (LAS float*)(lds + wave * 16640);
        const int gw = blockIdx.x * NWAVES + wave, NGW = gridDim.x * NWAVES;
        constexpr int I_IN = 108 * 32, I_OUT = 32 * 32, I_G = 64 * 256, I_W1 = 256, I_W2 = 8;
        constexpr int NITEMS = I_IN + I_OUT + 3 * I_G + 2 * I_W1 + 2 * I_W2;
        for (int it = gw; it < NITEMS; it += NGW) {
            int r = it;
            if (r < 3 * I_G) {
                if (r < 2 * I_G) { const int up = r >= I_G ? 1 : 0; r -= up * I_G; const int e = r >> 8, rr = r & 255, kb = rr >> 3, nb = rr & 7, n0 = 64 * nb;
                    const float* W = a.in[up ? I_WUP : I_WGATE] + (size_t)e * 2048 * 512;
                    transpose_tile(W, 512, 64 * kb, n0, 512, (bf16*)(ws + WS_WGU), 2048, e * 1024 + (n0 >> 7) * 256 + up * 128 + (n0 & 127), 64 * kb, scr, lane); continue; }
                r -= 2 * I_G; { const int e = r >> 8, rr = r & 255, kb = rr >> 5, nb = rr & 31;
                    transpose_tile(a.in[I_WDOWN] + (size_t)e * 512 * 2048, 2048, 64 * kb, 64 * nb, 2048, (bf16*)(ws + WS_WD), 512, e * 2048 + 64 * nb, 64 * kb, scr, lane); continue; }
            }
            r -= 3 * I_G;
            if (r < I_IN) { const int kb = r / 108, nb = r % 108; transpose_tile(a.in[I_WIN], PROJ, 64 * kb, 64 * nb, PROJ, (bf16*)(ws + WS_WIN), 2048, 64 * nb, 64 * kb, scr, lane); continue; } r -= I_IN;
            if (r < I_OUT) { const int kb = r >> 5, nb = r & 31; transpose_tile(a.in[I_WOUT], 2048, 64 * kb, 64 * nb, 2048, (bf16*)(ws + WS_WOUT), 2048, 64 * nb, 64 * kb, scr, lane); continue; } r -= I_OUT;
            if (r < 2 * I_W1) { const int ten = r >= I_W1 ? 1 : 0; r -= ten * I_W1; const int kb = r >> 2, nb = r & 3, k0 = 64 * kb;
                transpose_tile(a.in[ten ? I_W1V : I_W1K], 256, k0, 64 * nb, 256, (bf16*)(ws + (ten ? WS_W1V : WS_W1K)), 2048, (k0 >= 2048 ? 256 : 0) + 64 * nb, k0 & 2047, scr, lane); continue; } r -= 2 * I_W1;
            { const int ten = r >= I_W2 ? 1 : 0; r -= ten * I_W2; const int kb = r >> 1, nb = r & 1;
                transpose_tile(a.in[ten ? I_W2V : I_W2K], 128, 64 * kb, 64 * nb, 128, (bf16*)(ws + (ten ? WS_W2VT : WS_W2KT)), 256, 64 * nb, 64 * kb, scr, lane); }
        }
    }
    {
        const int gt = blockIdx.x * 512 + tid, NT = gridDim.x * 512;
        bf16* wrt = (bf16*)(ws + WS_WRT); const float* wg = a.in[I_WGRP]; const float* we = a.in[I_WEXP];
        for (int idx = gt; idx < 80 * 2048; idx += NT) { const int n = idx >> 11, k = idx & 2047;
            const float v = n < 8 ? wg[k * 8 + n] : (n < 72 ? we[k * 64 + (n - 8)] : 0.f); wrt[idx] = (bf16)(cvt_pk_bf16(v, 0.f) & 0xffffu); }
        float* cosT = (float*)(ws + WS_COS); float* sinT = (float*)(ws + WS_SIN);
        for (int idx = gt; idx < 2048 * 128; idx += NT) { const int pos = idx >> 7, j = idx & 127;
            const float inv = exp2f(-(float)j * 0.10381025296523007f);
            const double rev = (double)pos * (double)inv * 0.15915494309189535;
            const float fr = (float)(rev - __builtin_floor(rev));
            cosT[idx] = __builtin_amdgcn_cosf(fr); sinT[idx] = __builtin_amdgcn_sinf(fr); }
    }
}

template <bool FROM_PART>
__device__ __forceinline__ void norm_mod_phase(const Args& a, LAS unsigned char* lds, const float* xin, const float* gvec, int sh_chunk, int sc_chunk, bf16* outp) {
    const int tid = threadIdx.x, lane = tid & 63, wave = __builtin_amdgcn_readfirstlane(tid >> 6);
    LAS float* Av = (LAS float*)lds; LAS float* Bv = Av + 2048;
    const float* modp = (const float*)(a.ws + WS_MODP); const float* mod = (const float*)(a.ws + WS_MOD); const float* bada = a.in[I_BADA];
    int prev_b = -1;
    for (int rb = blockIdx.x; rb < M / 64; rb += gridDim.x) {
        const int b = rb >> 5;
        if (b != prev_b) {
            __syncthreads();
            for (int j = tid; j < 2048; j += 512) { float sh, sc;
                if (FROM_PART) { sh = bada[sh_chunk * 2048 + j]; sc = bada[sc_chunk * 2048 + j];
#pragma unroll
                    for (int kq = 0; kq < 4; ++kq) { sh += modp[((size_t)kq * 8 + b) * 12288 + sh_chunk * 2048 + j]; sc += modp[((size_t)kq * 8 + b) * 12288 + sc_chunk * 2048 + j]; } }
                else { sh = mod[b * 12288 + sh_chunk * 2048 + j]; sc = mod[b * 12288 + sc_chunk * 2048 + j]; }
                Av[j] = gvec[j] * (1.f + sc); Bv[j] = sh; }
            __syncthreads(); prev_b = b;
        }
        for (int rr = wave; rr < 64; rr += NWAVES) { const int row = rb * 64 + rr;
            const f32x4* xr = (const f32x4*)(xin + (size_t)row * D) + lane;
            f32x4 v[8]; float ss = 0.f;
#pragma unroll
            for (int j = 0; j < 8; ++j) { v[j] = xr[64 * j]; ss += (v[j][0] * v[j][0] + v[j][1] * v[j][1]) + (v[j][2] * v[j][2] + v[j][3] * v[j][3]); }
            const float rstd = rsqrtf(wave_sum(ss) * (1.f / 2048.f) + EPS);
            u32x2* o = (u32x2*)(outp + (size_t)row * D) + lane;
#pragma unroll
            for (int j = 0; j < 8; ++j) { const int col = 4 * lane + 256 * j; const f32x4 A4 = *(const LAS f32x4*)(Av + col), B4 = *(const LAS f32x4*)(Bv + col);
                const f32x4 y = v[j] * rstd * A4 + B4; u32x2 w; w.x = cvt_pk_bf16(y[0], y[1]); w.y = cvt_pk_bf16(y[2], y[3]); o[64 * j] = w; }
        }
    }
    if (FROM_PART) {
        if (blockIdx.x == gridDim.x - 1) { const float* bp = (const float*)(a.ws + WS_BIAS1P); const int ten = tid >> 8, n = tid & 255; float sb = 0.f;
            for (int kc = 0; kc < 64; ++kc) sb += bp[(size_t)(ten * 64 + kc) * 256 + n];
            ((float*)(a.ws + (ten ? WS_BIAS1V : WS_BIAS1K)))[n] = sb; }
        float* modw = (float*)(a.ws + WS_MOD);
        for (int idx = blockIdx.x * 512 + tid; idx < 8 * 12288; idx += gridDim.x * 512) { const int b = idx / 12288, j = idx % 12288; float s = bada[j];
#pragma unroll
            for (int kq = 0; kq < 4; ++kq) s += modp[((size_t)kq * 8 + b) * 12288 + j];
            modw[idx] = s; }
    }
}

__device__ __forceinline__ void transpose_out(const LAS unsigned short* tl, int pitch, int C, bf16* dst, size_t ldT, int tid) {
    for (int idx = tid; idx < C * 8; idx += 512) { const int cc = idx >> 3, tc = (idx & 7) * 8;
        unsigned e[8];
#pragma unroll
        for (int i = 0; i < 8; ++i) e[i] = tl[(tc + i) * pitch + cc];
        u32x4 o; o.x = e[0] | (e[1] << 16); o.y = e[2] | (e[3] << 16); o.z = e[4] | (e[5] << 16); o.w = e[6] | (e[7] << 16);
        *(u32x4*)(dst + (size_t)cc * ldT + tc) = o; }
}
__device__ __forceinline__ void rot8(const u32x4 x1, const u32x4 x2, const float* cosT, const float* sinT, int t, int jc, float (&o1)[8], float (&o2)[8]) {
    const f32x4 c0 = *(const f32x4*)(cosT + t * 128 + jc), c1 = *(const f32x4*)(cosT + t * 128 + jc + 4), s0 = *(const f32x4*)(sinT + t * 128 + jc), s1 = *(const f32x4*)(sinT + t * 128 + jc + 4);
    const float a1[8] = {bflo(x1.x), bfhi(x1.x), bflo(x1.y), bfhi(x1.y), bflo(x1.z), bfhi(x1.z), bflo(x1.w), bfhi(x1.w)};
    const float a2[8] = {bflo(x2.x), bfhi(x2.x), bflo(x2.y), bfhi(x2.y), bflo(x2.z), bfhi(x2.z), bflo(x2.w), bfhi(x2.w)};
    const float cs[8] = {c0[0], c0[1], c0[2], c0[3], c1[0], c1[1], c1[2], c1[3]}, sn[8] = {s0[0], s0[1], s0[2], s0[3], s1[0], s1[1], s1[2], s1[3]};
#pragma unroll
    for (int i = 0; i < 8; ++i) { o1[i] = a1[i] * cs[i] - a2[i] * sn[i]; o2[i] = a1[i] * sn[i] + a2[i] * cs[i]; }
}
__device__ __forceinline__ u32x4 pack8f(const float (&o)[8], float sc) { u32x4 w; w.x = cvt_pk_bf16(o[0] * sc, o[1] * sc); w.y = cvt_pk_bf16(o[2] * sc, o[3] * sc); w.z = cvt_pk_bf16(o[4] * sc, o[5] * sc); w.w = cvt_pk_bf16(o[6] * sc, o[7] * sc); return w; }

__device__ __forceinline__ void phase3(const Args& a, LAS unsigned char* lds) {
    const int tid = threadIdx.x;
    unsigned char* ws = a.ws;
    const bf16* proj = (const bf16*)(ws + WS_PROJ);
    const float* cosT = (const float*)(ws + WS_COS); const float* sinT = (const float*)(ws + WS_SIN);
    bf16* Qr = (bf16*)(ws + WS_QR); bf16* Kr = (bf16*)(ws + WS_KR); bf16* KzT = (bf16*)(ws + WS_KZT); bf16* VT = (bf16*)(ws + WS_VT);
    bf16* kcmp = (bf16*)(ws + WS_KCMP); bf16* vcmp = (bf16*)(ws + WS_VCMP); bf16* vsT = (bf16*)(ws + WS_VST); bf16* vwT = (bf16*)(ws + WS_VWT);
    LAS unsigned short* tl = (LAS unsigned short*)lds; constexpr int P2 = 258;
    for (int it = blockIdx.x; it < NB * 32; it += gridDim.x) {
        const int b = it >> 5, t0 = (it & 31) * 64;
        const bf16* pr = proj + (size_t)(b * T + t0) * NP;
        for (int h = 0; h < 4; ++h) {
            const float lg = ret_lg(h);
            __syncthreads();
            for (int ch = tid; ch < 1024; ch += 512) { const int tk = ch >> 4, jc = (ch & 15) * 8, t = t0 + tk;
                const bf16* p = pr + (size_t)tk * NP + h * 256 + jc;
                float o1[8], o2[8];
                rot8(*(const u32x4*)(p + C_RK), *(const u32x4*)(p + C_RK + 128), cosT, sinT, t, jc, o1, o2);
                bf16* kd = Kr + ((size_t)(b * 4 + h) * T + t) * 256 + jc;
                *(u32x4*)kd = pack8f(o1, 0.0625f); *(u32x4*)(kd + 128) = pack8f(o2, 0.0625f);
                const float zs = 0.0625f * __expf(lg * (float)(127 - (t & 127)));
                const u32x4 z1 = pack8f(o1, zs), z2 = pack8f(o2, zs);
                LAS unsigned* d1 = (LAS unsigned*)(tl + tk * P2 + jc); d1[0] = z1.x; d1[1] = z1.y; d1[2] = z1.z; d1[3] = z1.w;
                LAS unsigned* d2 = (LAS unsigned*)(tl + tk * P2 + 128 + jc); d2[0] = z2.x; d2[1] = z2.y; d2[2] = z2.z; d2[3] = z2.w;
                rot8(*(const u32x4*)(p + C_RQ), *(const u32x4*)(p + C_RQ + 128), cosT, sinT, t, jc, o1, o2);
                bf16* qd = Qr + ((size_t)(b * 4 + h) * T + t) * 256 + jc;
                *(u32x4*)qd = pack8f(o1, 1.f); *(u32x4*)(qd + 128) = pack8f(o2, 1.f);
            }
            __syncthreads();
            transpose_out(tl, P2, 256, KzT + ((size_t)(b * 4 + h) * 256) * T + t0, T, tid);
            __syncthreads();
            for (int ch = tid; ch < 64 * 32; ch += 512) { const int tk = ch >> 5, dc = (ch & 31) * 8;
                const u32x4 v = *(const u32x4*)(pr + (size_t)tk * NP + C_RV + h * 256 + dc);
                LAS unsigned* d1 = (LAS unsigned*)(tl + tk * P2 + dc); d1[0] = v.x; d1[1] = v.y; d1[2] = v.z; d1[3] = v.w; }
            __syncthreads();
            transpose_out(tl, P2, 256, VT + ((size_t)(b * 4 + h) * 256) * T + t0, T, tid);
        }
        for (int g = 0; g < 2; ++g) {
            for (int ch = tid; ch < 1024; ch += 512) { const int tk = ch >> 4, dc = (ch & 15) * 8;
                const bf16* p = pr + (size_t)tk * NP + g * 128 + dc; const size_t o = ((size_t)(b * 2 + g) * T + t0 + tk) * 128 + dc;
                *(u32x4*)(kcmp + o) = *(const u32x4*)(p + C_KC); *(u32x4*)(vcmp + o) = *(const u32x4*)(p + C_VC); }
#pragma unroll
            for (int sel = 0; sel < 2; ++sel) {
                __syncthreads();
                for (int ch = tid; ch < 1024; ch += 512) { const int tk = ch >> 4, dc = (ch & 15) * 8;
                    const u32x4 v = *(const u32x4*)(pr + (size_t)tk * NP + (sel ? C_VW : C_VS) + g * 128 + dc);
                    LAS unsigned* d1 = (LAS unsigned*)(tl + tk * P2 + dc); d1[0] = v.x; d1[1] = v.y; d1[2] = v.z; d1[3] = v.w; }
                __syncthreads();
                transpose_out(tl, P2, 128, (sel ? vwT : vsT) + ((size_t)(b * 2 + g) * 128) * T + t0, T, tid);
            }
        }
    }
}

__device__ __forceinline__ void phase4(const Args& a, LAS unsigned char* lds) {
    const int tid = threadIdx.x, lane = tid & 63, wave = __builtin_amdgcn_readfirstlane(tid >> 6), q = lane >> 4, r = lane & 15;
    unsigned char* ws = a.ws;
    {
        const bf16* VT = (const bf16*)(ws + WS_VT); const bf16* KzT = (const bf16*)(ws + WS_KZT); bf16* SP = (bf16*)(ws + WS_SP);
        for (int it = blockIdx.x; it < 256; it += gridDim.x) {
            const int b = it >> 5, h = (it >> 3) & 3, es = it & 7;
            const float cd = __expf(ret_lg(h) * 128.f);
            const bf16* VTb = VT + ((size_t)(b * 4 + h) * 256 + es * 32) * T;
            const bf16* KzTb = KzT + ((size_t)(b * 4 + h) * 256 + wave * 32) * T;
            bf16* Sp = SP + (size_t)(b * 4 + h) * 16 * 65536;
            f32x4 S[2][2];
#pragma unroll
            for (int mt = 0; mt < 2; ++mt)
#pragma unroll
                for (int nt = 0; nt < 2; ++nt) S[mt][nt] = (f32x4){0.f, 0.f, 0.f, 0.f};
            for (int n = 0; n < 16; ++n) {
#pragma unroll
                for (int mt = 0; mt < 2; ++mt)
#pragma unroll
                    for (int nt = 0; nt < 2; ++nt) { const int e = es * 32 + 16 * mt + r, d = wave * 32 + 16 * nt + 4 * q;
                        u32x2 w; w.x = cvt_pk_bf16(S[mt][nt][0], S[mt][nt][1]); w.y = cvt_pk_bf16(S[mt][nt][2], S[mt][nt][3]);
                        *(u32x2*)(Sp + ((size_t)n * 256 + e) * 256 + d) = w; }
                if (n == 15) break;
#pragma unroll
                for (int mt = 0; mt < 2; ++mt)
#pragma unroll
                    for (int nt = 0; nt < 2; ++nt) S[mt][nt] = S[mt][nt] * cd;
#pragma unroll
                for (int k0 = 0; k0 < 128; k0 += 32) {
                    bf16x8 af[2], bfr[2];
#pragma unroll
                    for (int mt = 0; mt < 2; ++mt) af[mt] = *(const bf16x8*)(VTb + (size_t)(16 * mt + r) * T + n * 128 + k0 + 8 * q);
#pragma unroll
                    for (int nt = 0; nt < 2; ++nt) bfr[nt] = *(const bf16x8*)(KzTb + (size_t)(16 * nt + r) * T + n * 128 + k0 + 8 * q);
#pragma unroll
                    for (int mt = 0; mt < 2; ++mt)
#pragma unroll
                        for (int nt = 0; nt < 2; ++nt) S[mt][nt] = MFMA16(bfr[nt], af[mt], S[mt][nt]);
                }
            }
        }
    }
    {
        const int gw = blockIdx.x * NWAVES + wave, NGW = gridDim.x * NWAVES;
        for (int wi = gw; wi < 2048; wi += NGW) { const int ten = wi >> 10, rt = (wi >> 4) & 63, ct = wi & 15;
            const bf16* A = (const bf16*)(ws + (ten ? WS_VCMP : WS_KCMP)) + (size_t)(rt * 32) * 2048;
            const bf16* Bt = (const bf16*)(ws + (ten ? WS_W1V : WS_W1K)) + (size_t)(ct * 32) * 2048;
            f32x4 acc[2][2];
#pragma unroll
            for (int mt = 0; mt < 2; ++mt)
#pragma unroll
                for (int nt = 0; nt < 2; ++nt) acc[mt][nt] = (f32x4){0.f, 0.f, 0.f, 0.f};
#pragma unroll 2
            for (int k0 = 0; k0 < 2048; k0 += 32) {
                bf16x8 af[2], bfr[2];
#pragma unroll
                for (int mt = 0; mt < 2; ++mt) af[mt] = *(const bf16x8*)(A + (size_t)(16 * mt + r) * 2048 + k0 + 8 * q);
#pragma unroll
                for (int nt = 0; nt < 2; ++nt) bfr[nt] = *(const bf16x8*)(Bt + (size_t)(16 * nt + r) * 2048 + k0 + 8 * q);
#pragma unroll
                for (int mt = 0; mt < 2; ++mt)
#pragma unroll
                    for (int nt = 0; nt < 2; ++nt) acc[mt][nt] = MFMA16(bfr[nt], af[mt], acc[mt][nt]);
            }
            float* Y = (float*)(ws + (ten ? WS_YV : WS_YK));
#pragma unroll
            for (int mt = 0; mt < 2; ++mt)
#pragma unroll
                for (int nt = 0; nt < 2; ++nt) *(f32x4*)(Y + (size_t)(rt * 32 + 16 * mt + r) * 512 + ct * 32 + 16 * nt + 4 * q) = acc[mt][nt];
        }
    }
}

__device__ __forceinline__ void phase5(const Args& a, LAS unsigned char* lds) {
    const int tid = threadIdx.x, lane = tid & 63, wave = __builtin_amdgcn_readfirstlane(tid >> 6), q = lane >> 4, r = lane & 15;
    unsigned char* ws = a.ws;
    const int gw = blockIdx.x * NWAVES + wave, NGW = gridDim.x * NWAVES;
    for (int wi = gw; wi < 256; wi += NGW) { const int ten = wi >> 7, rt = wi & 127, row = rt * 16 + r, c = row & 127;
        const float* Y = (const float*)(ws + (ten ? WS_YV : WS_YK)); const float* bias = (const float*)(ws + (ten ? WS_BIAS1V : WS_BIAS1K));
        const bf16* W2T = (const bf16*)(ws + (ten ? WS_W2VT : WS_W2KT));
        f32x4 acc[8];
#pragma unroll
        for (int nt = 0; nt < 8; ++nt) acc[nt] = (f32x4){0.f, 0.f, 0.f, 0.f};
#pragma unroll
        for (int k0 = 0; k0 < 256; k0 += 32) { const int kk = k0 + 8 * q;
            bf16x8 af = (bf16x8){0, 0, 0, 0, 0, 0, 0, 0};
            if (c < 127) {
                const f32x4 y0 = *(const f32x4*)(Y + (size_t)row * 512 + kk), y1 = *(const f32x4*)(Y + (size_t)row * 512 + kk + 4);
                const f32x4 z0 = *(const f32x4*)(Y + (size_t)(row + 1) * 512 + 256 + kk), z1 = *(const f32x4*)(Y + (size_t)(row + 1) * 512 + 256 + kk + 4);
                const f32x4 b0 = *(const f32x4*)(bias + kk), b1 = *(const f32x4*)(bias + kk + 4);
                f32x4 h0 = y0 + z0 + b0, h1 = y1 + z1 + b1;
#pragma unroll
                for (int i = 0; i < 4; ++i) { h0[i] = silu_f(h0[i]); h1[i] = silu_f(h1[i]); }
                af = pack8(h0, h1);
            }
#pragma unroll
            for (int nt = 0; nt < 8; ++nt) { const bf16x8 bfr = *(const bf16x8*)(W2T + (size_t)(16 * nt + r) * 256 + kk); acc[nt] = MFMA16(bfr, af, acc[nt]); }
        }
        if (!ten) { bf16* kc = (bf16*)(ws + WS_KC);
#pragma unroll
            for (int nt = 0; nt < 8; ++nt) { u32x2 w; w.x = cvt_pk_bf16(acc[nt][0], acc[nt][1]); w.y = cvt_pk_bf16(acc[nt][2], acc[nt][3]); *(u32x2*)(kc + (size_t)row * 128 + 16 * nt + 4 * q) = w; }
        } else { bf16* vct = (bf16*)(ws + WS_VCT);
#pragma unroll
            for (int nt = 0; nt < 8; ++nt)
#pragma unroll
                for (int j = 0; j < 4; ++j) vct[((size_t)(row >> 7) * 128 + 16 * nt + 4 * q + j) * 128 + c] = (bf16)(cvt_pk_bf16(acc[nt][j], 0.f) & 0xffffu);
        }
    }
}

__device__ __forceinline__ void r2_item(const Args& a, int it) {
    int tid = threadIdx.x; asm volatile("" : "+v"(tid));
    const int lane = tid & 63, wave = __builtin_amdgcn_readfirstlane(tid >> 6), q = lane >> 4, r = lane & 15;
    unsigned char* ws = a.ws;
    const int b = it >> 6, h = (it >> 4) & 3, n = it & 15;
    const float lg = ret_lg(h);
    const int ti = 16 * wave + r;
    const bf16* Qrow = (const bf16*)(ws + WS_QR) + ((size_t)(b * 4 + h) * T + n * 128 + ti) * 256;
    const bf16* Kb = (const bf16*)(ws + WS_KR) + ((size_t)(b * 4 + h) * T + n * 128) * 256;
    const bf16* VTb = (const bf16*)(ws + WS_VT) + ((size_t)(b * 4 + h) * 256) * T + n * 128;
    const bf16* Sp = (const bf16*)(ws + WS_SP) + ((size_t)(b * 4 + h) * 16 + n) * 65536;
    f32x4 s[8];
#pragma unroll
    for (int nt = 0; nt < 8; ++nt) s[nt] = (f32x4){0.f, 0.f, 0.f, 0.f};
#pragma unroll 2
    for (int k0 = 0; k0 < 256; k0 += 32) { const bf16x8 af = *(const bf16x8*)(Qrow + k0 + 8 * q);
#pragma unroll
        for (int nt = 0; nt < 8; ++nt) { const bf16x8 bfr = *(const bf16x8*)(Kb + (size_t)(16 * nt + r) * 256 + k0 + 8 * q); s[nt] = MFMA16(bfr, af, s[nt]); } }
    bf16x8 pf[4];
#pragma unroll
    for (int nt = 0; nt < 8; ++nt)
#pragma unroll
        for (int j = 0; j < 4; ++j) { const int dd = ti - (16 * nt + 4 * q + j); s[nt][j] = dd >= 0 ? s[nt][j] * __expf(lg * (float)dd) : 0.f; }
#pragma unroll
    for (int ks = 0; ks < 4; ++ks) pf[ks] = pack8(s[2 * ks], s[2 * ks + 1]);
    f32x4 o[16];
#pragma unroll
    for (int nt = 0; nt < 16; ++nt) o[nt] = (f32x4){0.f, 0.f, 0.f, 0.f};
#pragma unroll 2
    for (int k0 = 0; k0 < 256; k0 += 32) { const bf16x8 af = *(const bf16x8*)(Qrow + k0 + 8 * q);
#pragma unroll
        for (int nt = 0; nt < 16; ++nt) { const bf16x8 bfr = *(const bf16x8*)(Sp + (size_t)(16 * nt + r) * 256 + k0 + 8 * q); o[nt] = MFMA16(bfr, af, o[nt]); } }
    const float qd = __expf(lg * (float)(ti + 1));
#pragma unroll
    for (int nt = 0; nt < 16; ++nt) o[nt] = o[nt] * qd;
#pragma unroll
    for (int ks = 0; ks < 4; ++ks)
#pragma unroll
        for (int nt = 0; nt < 16; ++nt) { const bf16* vp = VTb + (size_t)(16 * nt + r) * T + 32 * ks + 4 * q;
            const bf16x8 vf = cat4(*(const bf16x4*)vp, *(const bf16x4*)(vp + 16)); o[nt] = MFMA16(vf, pf[ks], o[nt]); }
    float sm = 0.f;
#pragma unroll
    for (int nt = 0; nt < 16; ++nt) sm += (o[nt][0] + o[nt][1]) + (o[nt][2] + o[nt][3]);
    sm += __shfl_xor(sm, 16); sm += __shfl_xor(sm, 32);
    const float mu = sm * (1.f / 256.f); float vs = 0.f;
#pragma unroll
    for (int nt = 0; nt < 16; ++nt) { const f32x4 d = o[nt] - mu; vs += (d[0] * d[0] + d[1] * d[1]) + (d[2] * d[2] + d[3] * d[3]); }
    vs += __shfl_xor(vs, 16); vs += __shfl_xor(vs, 32);
    const float rstd = rsqrtf(vs * (1.f / 256.f) + EPS);
    const size_t rowg = (size_t)b * T + n * 128 + ti;
    const bf16* gp = (const bf16*)(ws + WS_PROJ) + rowg * NP + C_RG + h * 256;
    const float* gn = a.in[I_GNG] + h * 256;
    bf16* op = (bf16*)(ws + WS_CAT) + rowg * 2048 + h * 256;
#pragma unroll
    for (int nt = 0; nt < 16; ++nt) { const int e = 16 * nt + 4 * q;
        const u32x2 gw2 = *(const u32x2*)(gp + e); const f32x4 g4 = *(const f32x4*)(gn + e);
        const float g0 = bflo(gw2.x), g1 = bfhi(gw2.x), g2 = bflo(gw2.y), g3 = bfhi(gw2.y);
        const float y0 = (o[nt][0] - mu) * rstd * g4[0] * silu_f(g0), y1 = (o[nt][1] - mu) * rstd * g4[1] * silu_f(g1);
        const float y2 = (o[nt][2] - mu) * rstd * g4[2] * silu_f(g2), y3 = (o[nt][3] - mu) * rstd * g4[3] * silu_f(g3);
        u32x2 w; w.x = cvt_pk_bf16(y0, y1); w.y = cvt_pk_bf16(y2, y3); *(u32x2*)(op + e) = w; }
}

constexpr float NSA_SCL = 0.08838834764831845f * 1.4426950408889634f;
constexpr int QP = 272, KP = 272, VP = 136, VCP = 264;
#ifndef NSA_NBR
#define NSA_NBR 2
#endif
constexpr int NSA_QS = 0, NSA_KS = 69632, NSA_VS = NSA_KS + 34816;

template <int S> __device__ __forceinline__ bf16x8 pack_step(const f32x16& x) {
    u32x4 p; p.x = cvt_pk_bf16(x[8 * S], x[8 * S + 1]); p.y = cvt_pk_bf16(x[8 * S + 2], x[8 * S + 3]); p.z = cvt_pk_bf16(x[8 * S + 4], x[8 * S + 5]); p.w = cvt_pk_bf16(x[8 * S + 6], x[8 * S + 7]);
    return __builtin_bit_cast(bf16x8, p);
}
__device__ __forceinline__ f32x16 zero16() { f32x16 z;
#pragma unroll
    for (int i = 0; i < 16; ++i) z[i] = 0.f;
    return z; }

__device__ __forceinline__ void attn_tile(const LAS unsigned char* qrow, const LAS unsigned char* Ks, const LAS unsigned char* Vs, int r, int h, float& m, float& l, f32x16 (&O)[4], int lo, int hi) {
    f32x16 st[2]; st[0] = zero16(); st[1] = zero16();
#pragma unroll
    for (int ks = 0; ks < 8; ++ks) { const bf16x8 qf = *(const LAS bf16x8*)(qrow + (16 * ks + 8 * h) * 2);
#pragma unroll
        for (int kb = 0; kb < 2; ++kb) { const bf16x8 kf = *(const LAS bf16x8*)(Ks + (32 * kb + r) * KP + (16 * ks + 8 * h) * 2); st[kb] = MFMA32(kf, qf, st[kb]); }
        if (ks & 1) asm volatile("" ::: "memory"); }
    float tmax = -1e30f;
#pragma unroll
    for (int kb = 0; kb < 2; ++kb)
#pragma unroll
        for (int reg = 0; reg < 16; ++reg) { constexpr int dummy = 0; (void)dummy; const int KC = 32 * kb + (reg & 3) + 8 * (reg >> 2); const float v = (KC > lo && KC <= hi) ? st[kb][reg] * NSA_SCL : -1e30f; st[kb][reg] = v; tmax = fmaxf(tmax, v); }
    tmax = fmaxf(tmax, __shfl_xor(tmax, 32));
    const float mn = fmaxf(m, tmax), alpha = __builtin_amdgcn_exp2f(m - mn);
    float rs = 0.f;
#pragma unroll
    for (int kb = 0; kb < 2; ++kb)
#pragma unroll
        for (int reg = 0; reg < 16; ++reg) { const float v = st[kb][reg]; const float p = v > -1e29f ? __builtin_amdgcn_exp2f(v - mn) : 0.f; st[kb][reg] = p; rs += p; }
    rs += __shfl_xor(rs, 32);
    l = l * alpha + rs; m = mn;
#pragma unroll
    for (int eb = 0; eb < 4; ++eb) O[eb] = O[eb] * alpha;
#pragma unroll
    for (int kb = 0; kb < 2; ++kb) {
        { const bf16x8 pf = pack_step<0>(st[kb]);
#pragma unroll
          for (int eb = 0; eb < 4; ++eb) { const LAS unsigned char* vp = Vs + (32 * eb + r) * VP + (32 * kb + 4 * h) * 2; const bf16x8 vf = cat4(*(const LAS bf16x4*)vp, *(const LAS bf16x4*)(vp + 16)); O[eb] = MFMA32(vf, pf, O[eb]); } }
        asm volatile("" ::: "memory");
        { const bf16x8 pf = pack_step<1>(st[kb]);
#pragma unroll
          for (int eb = 0; eb < 4; ++eb) { const LAS unsigned char* vp = Vs + (32 * eb + r) * VP + (32 * kb + 16 + 4 * h) * 2; const bf16x8 vf = cat4(*(const LAS bf16x4*)vp, *(const LAS bf16x4*)(vp + 16)); O[eb] = MFMA32(vf, pf, O[eb]); } }
        asm volatile("" ::: "memory");
    }
}

__device__ __forceinline__ void nsa_item(const Args& a, LAS unsigned char* lds, int item) {
    int tid = threadIdx.x; asm volatile("" : "+v"(tid));
    const int lane = tid & 63, w = __builtin_amdgcn_readfirstlane(tid >> 6), h = lane >> 5, r = lane & 31;
    unsigned char* ws = a.ws;
    const int bg = item & 15, qt = 31 - (item >> 4), b = bg >> 1, g = bg & 1, t0 = qt * 64, cur = qt;
    const bf16* proj = (const bf16*)(ws + WS_PROJ);
    LAS unsigned char* Qs = lds + NSA_QS; LAS unsigned char* Ks = lds + NSA_KS; LAS unsigned char* Vs = lds + NSA_VS;
    LAS unsigned* bmask = (LAS unsigned*)(lds + MISC_OFF + 64);
    const int tok = t0 + 8 * w + (r >> 2), head = r & 3;
    const LAS unsigned char* qrow = Qs + (32 * w + r) * QP;
    __syncthreads();
    if (tid == 0) *bmask = 0u;
    for (int ch = tid; ch < 4096; ch += 512) { const int row = ch >> 4, dc = (ch & 15) * 8;
        *(LAS u32x4*)(Qs + row * QP + dc * 2) = *(const u32x4*)(proj + (size_t)(b * T + t0 + (row >> 2)) * NP + C_NQ + (g * 4 + (row & 3)) * 128 + dc); }
    { const bf16* kc = (const bf16*)(ws + WS_KC) + (size_t)bg * 16384; const bf16* vct = (const bf16*)(ws + WS_VCT) + (size_t)bg * 16384;
      for (int ch = tid; ch < 2048; ch += 512) { const int row = ch >> 4, dc = (ch & 15) * 8;
          *(LAS u32x4*)(Ks + row * KP + dc * 2) = *(const u32x4*)(kc + row * 128 + dc);
          const u32x4 v = *(const u32x4*)(vct + row * 128 + dc); LAS u32x2* d = (LAS u32x2*)(Vs + row * VCP + dc * 2); d[0] = (u32x2){v.x, v.y}; d[1] = (u32x2){v.z, v.w}; } }
    __syncthreads();
    float gt0, gt1, gt2;
    { const bf16* gp = proj + (size_t)(b * T + tok) * NP + C_NG + (g * 4 + head) * 3; gt0 = sigmoid_f(bf2f(gp[0])); gt1 = sigmoid_f(bf2f(gp[1])); gt2 = sigmoid_f(bf2f(gp[2])); }
    unsigned selmask;
    bf16* op = (bf16*)(ws + WS_CAT) + (size_t)(b * T + tok) * 2048 + 1024 + (g * 4 + head) * 128;
    {
        f32x16 st[4]; f32x16 Ot[4];
#pragma unroll
        for (int kb = 0; kb < 4; ++kb) st[kb] = zero16();
#pragma unroll
        for (int ks = 0; ks < 8; ++ks) { const bf16x8 qf = *(const LAS bf16x8*)(qrow + (16 * ks + 8 * h) * 2);
#pragma unroll
            for (int kb = 0; kb < 4; ++kb) { const bf16x8 kf = *(const LAS bf16x8*)(Ks + (32 * kb + r) * KP + (16 * ks + 8 * h) * 2); st[kb] = MFMA32(kf, qf, st[kb]); }
            asm volatile("" ::: "memory"); }
        float mx = -1e30f;
        const int clim = (tok - 31) >> 4;
        const int climh = (clim < 126 ? clim : 126) - 4 * h;
#pragma unroll
        for (int kb = 0; kb < 4; ++kb)
#pragma unroll
            for (int reg = 0; reg < 16; ++reg) { const int KC = 32 * kb + (reg & 3) + 8 * (reg >> 2);
                const float v = (KC <= climh) ? st[kb][reg] * NSA_SCL : -1e30f; st[kb][reg] = v; mx = fmaxf(mx, v); }
        mx = fmaxf(mx, __shfl_xor(mx, 32));
        float sm = 0.f;
#pragma unroll
        for (int kb = 0; kb < 4; ++kb)
#pragma unroll
            for (int reg = 0; reg < 16; ++reg) { const float v = st[kb][reg]; const float p = v > -1e29f ? __builtin_amdgcn_exp2f(v - mx) : 0.f; st[kb][reg] = p; sm += p; }
        sm += __shfl_xor(sm, 32);
        const float inv = sm > 0.f ? 1.f / sm : 0.f;
#pragma unroll
        for (int kb = 0; kb < 4; ++kb) st[kb] = st[kb] * inv;
        float imp[16], lastv[16];
#pragma unroll
        for (int i = 0; i < 16; ++i) { const int kb = i >> 2, rq = i & 3; imp[i] = (st[kb][4 * rq] + st[kb][4 * rq + 1]) + (st[kb][4 * rq + 2] + st[kb][4 * rq + 3]); lastv[i] = __shfl_xor(st[kb][4 * rq + 3], 32); }
#pragma unroll
        for (int i = 0; i < 16; ++i) { const float prev = h ? lastv[i] : (i > 0 ? lastv[i > 0 ? i - 1 : 0] : 0.f); imp[i] += prev; }
#pragma unroll
        for (int i = 0; i < 16; ++i) { imp[i] += __shfl_xor(imp[i], 1); imp[i] += __shfl_xor(imp[i], 2); }
        float sc[16], so[16];
#pragma unroll
        for (int i = 0; i < 16; ++i) { const int s = 2 * i + h; const bool forced = (s == 0) || (s == cur) || (s == cur - 1); sc[i] = s <= cur ? imp[i] + (forced ? 1e4f : 0.f) : -1.f; }
#pragma unroll
        for (int i = 0; i < 16; ++i) so[i] = __shfl_xor(sc[i], 32);
        unsigned mine = 0u;
#pragma unroll
        for (int i = 0; i < 16; ++i) { int rank = 0;
#pragma unroll
            for (int i2 = 0; i2 < 16; ++i2) {
                rank += (sc[i2] > sc[i] || (sc[i2] == sc[i] && i2 < i)) ? 1 : 0;
                const bool lower = h ? (i2 <= i) : (i2 < i);
                rank += (so[i2] > sc[i] || (so[i2] == sc[i] && lower)) ? 1 : 0; }
            if (rank < 16 && (2 * i + h) <= cur) mine |= 1u << (2 * i + h); }
        selmask = mine | __shfl_xor(mine, 32);
        if ((lane & 35) == 0) __hip_atomic_fetch_or(bmask, selmask, __ATOMIC_RELAXED, __HIP_MEMORY_SCOPE_WORKGROUP);
#pragma unroll
        for (int eb = 0; eb < 4; ++eb) Ot[eb] = zero16();
#pragma unroll
        for (int kb = 0; kb < 4; ++kb) {
            { const bf16x8 pf = pack_step<0>(st[kb]);
#pragma unroll
              for (int eb = 0; eb < 4; ++eb) { const LAS unsigned char* vp = Vs + (32 * eb + r) * VCP + (32 * kb + 4 * h) * 2; const bf16x8 vf = cat4(*(const LAS bf16x4*)vp, *(const LAS bf16x4*)(vp + 16)); Ot[eb] = MFMA32(vf, pf, Ot[eb]); } }
            asm volatile("" ::: "memory");
            { const bf16x8 pf = pack_step<1>(st[kb]);
#pragma unroll
              for (int eb = 0; eb < 4; ++eb) { const LAS unsigned char* vp = Vs + (32 * eb + r) * VCP + (32 * kb + 16 + 4 * h) * 2; const bf16x8 vf = cat4(*(const LAS bf16x4*)vp, *(const LAS bf16x4*)(vp + 16)); Ot[eb] = MFMA32(vf, pf, Ot[eb]); } }
            asm volatile("" ::: "memory");
        }
#pragma unroll
        for (int eb = 0; eb < 4; ++eb)
#pragma unroll
            for (int rq = 0; rq < 4; ++rq) { u32x2 wv; wv.x = cvt_pk_bf16(Ot[eb][4 * rq] * gt0, Ot[eb][4 * rq + 1] * gt0); wv.y = cvt_pk_bf16(Ot[eb][4 * rq + 2] * gt0, Ot[eb][4 * rq + 3] * gt0);
                *(u32x2*)(op + 32 * eb + 8 * rq + 4 * h) = wv; }
    }
    __syncthreads();
    const unsigned blockmask = *bmask;
#pragma unroll 1
    for (int br = 0; br < NSA_NBR; ++br) {
        f32x16 O[4];
#pragma unroll
        for (int eb = 0; eb < 4; ++eb) O[eb] = zero16();
        float m = -1e30f, l = 0.f;
        const int kcol = (br ? C_KW : C_KS) + g * 128;
        const bf16* vT = (const bf16*)(ws + (br ? WS_VWT : WS_VST)) + (size_t)bg * 128 * T;
        const int jlo = br ? (cur > 8 ? cur - 8 : 0) : 0;
#pragma unroll 1
        for (int j = jlo; j <= cur; ++j) {
            if (!br && !((blockmask >> j) & 1u)) continue;
            __syncthreads();
            for (int ch = tid; ch < 1024; ch += 512) { const int kk = ch >> 4, dc = (ch & 15) * 8;
                *(LAS u32x4*)(Ks + kk * KP + dc * 2) = *(const u32x4*)(proj + (size_t)(b * T + 64 * j + kk) * NP + kcol + dc); }
            for (int ch = tid; ch < 1024; ch += 512) { const int e = ch >> 3, k8 = (ch & 7) * 8;
                const u32x4 v = *(const u32x4*)(vT + (size_t)e * T + 64 * j + k8); LAS u32x2* d = (LAS u32x2*)(Vs + e * VP + k8 * 2); d[0] = (u32x2){v.x, v.y}; d[1] = (u32x2){v.z, v.w}; }
            __syncthreads();
            const int kbase = 64 * j;
            if (!br) {
                const bool mysel = (selmask >> j) & 1u;
                if (__ballot(mysel) != 0ull) attn_tile(qrow, Ks, Vs, r, h, m, l, O, -1000000, mysel ? (tok - kbase - 4 * h) : -1000000);
            } else {
                attn_tile(qrow, Ks, Vs, r, h, m, l, O, tok - kbase - 4 * h - 512, tok - kbase - 4 * h);
            }
        }
        const float sc = (l > 0.f ? 1.f / l : 0.f) * (br ? gt2 : gt1);
        VM_WAIT();
#pragma unroll
        for (int eb = 0; eb < 4; ++eb)
#pragma unroll
            for (int rq = 0; rq < 4; ++rq) { u32x2* p = (u32x2*)(op + 32 * eb + 8 * rq + 4 * h); const u32x2 old = *p;
                u32x2 wv; wv.x = cvt_pk_bf16(bflo(old.x) + O[eb][4 * rq] * sc, bfhi(old.x) + O[eb][4 * rq + 1] * sc); wv.y = cvt_pk_bf16(bflo(old.y) + O[eb][4 * rq + 2] * sc, bfhi(old.y) + O[eb][4 * rq + 3] * sc);
                *p = wv; }
    }
}

__device__ __forceinline__ void phase6(const Args& a, LAS unsigned char* lds) {
    for (int it = blockIdx.x; it < 1024; it += gridDim.x) {
#if defined(P6_ONLY_NSA)
        if (it < 512) nsa_item(a, lds, it);
#elif defined(P6_ONLY_R2)
        if (it >= 512) r2_item(a, it - 512);
#else
        if (it < 512) nsa_item(a, lds, it); else r2_item(a, it - 512);
#endif
    }
}

__device__ __forceinline__ void phase9(const Args& a, LAS unsigned char* lds) {
    const int tid = threadIdx.x, lane = tid & 63, wave = __builtin_amdgcn_readfirstlane(tid >> 6), q = lane >> 4, r = lane & 15;
    unsigned char* ws = a.ws;
    const bf16* h2 = (const bf16*)(ws + WS_H); const bf16* wrt = (const bf16*)(ws + WS_WRT);
    const float* bgrp = a.in[I_BGRP]; const float* bexp = a.in[I_BEXP];
    unsigned* cnt = (unsigned*)(ws + WS_CTL) + CW_CNT; int* asg = (int*)(ws + WS_ASG); float* rw = (float*)(ws + WS_RW);
    LAS float* lg = (LAS float*)(lds + wave * 8192);
    const int gw = blockIdx.x * NWAVES + wave, NGW = gridDim.x * NWAVES;
    for (int wi = gw; wi < M / 16; wi += NGW) {
        const bf16* A = h2 + (size_t)(wi * 16 + r) * D;
        f32x4 acc[5];
#pragma unroll
        for (int nt = 0; nt < 5; ++nt) acc[nt] = (f32x4){0.f, 0.f, 0.f, 0.f};
#pragma unroll 2
        for (int k0 = 0; k0 < D; k0 += 32) { const bf16x8 af = *(const bf16x8*)(A + k0 + 8 * q);
#pragma unroll
            for (int nt = 0; nt < 5; ++nt) { const bf16x8 bfr = *(const bf16x8*)(wrt + (size_t)(16 * nt + r) * D + k0 + 8 * q); acc[nt] = MFMA16(bfr, af, acc[nt]); } }
#pragma unroll
        for (int nt = 0; nt < 5; ++nt) *(LAS f32x4*)(lg + r * 84 + 16 * nt + 4 * q) = acc[nt];
        LDS_WAIT();
        if (lane < 16) {
            const int tok = wi * 16 + lane; const LAS float* L = lg + lane * 84;
            float gl[8]; float gmax = -3.0e38f; int gi = 0;
#pragma unroll
            for (int i = 0; i < 8; ++i) { gl[i] = L[i] + bgrp[i]; if (gl[i] > gmax) { gmax = gl[i]; gi = i; } }
            float gs = 0.f;
#pragma unroll
            for (int i = 0; i < 8; ++i) gs += __expf(gl[i] - gmax);
            const float pg = 1.f / gs;
            float el[8]; float m1 = -3.0e38f; int i1 = 0;
#pragma unroll
            for (int i = 0; i < 8; ++i) { el[i] = L[8 + gi * 8 + i] + bexp[gi * 8 + i]; if (el[i] > m1) { m1 = el[i]; i1 = i; } }
            float m2 = -3.0e38f; int i2 = 0;
#pragma unroll
            for (int i = 0; i < 8; ++i) { if (i != i1 && el[i] > m2) { m2 = el[i]; i2 = i; } }
            const float e2 = __expf(m2 - m1); const float w1 = pg / (1.f + e2), w2 = pg * e2 / (1.f + e2);
            const int ea = gi * 8 + i1, eb = gi * 8 + i2;
            const unsigned pa = atomicAdd(cnt + ea, 1u); asg[(size_t)ea * CAP + pa] = tok * 2;     rw[(size_t)ea * CAP + pa] = w1;
            const unsigned pb = atomicAdd(cnt + eb, 1u); asg[(size_t)eb * CAP + pb] = tok * 2 + 1; rw[(size_t)eb * CAP + pb] = w2;
        }
        LDS_WAIT();
    }
}

constexpr int MOE_TAB_OFF = 131072;
__device__ __forceinline__ void moe_tables(const Args& a, LAS unsigned char* lds) {
    const int tid = threadIdx.x;
    LAS int* cntL = (LAS int*)(lds + MOE_TAB_OFF); LAS int* tst = cntL + 64;
    const unsigned* cnt = (const unsigned*)(a.ws + WS_CTL) + CW_CNT;
    __syncthreads();
    if (tid < 64) cntL[tid] = (int)__hip_atomic_load(cnt + tid, __ATOMIC_RELAXED, __HIP_MEMORY_SCOPE_AGENT);
    __syncthreads();
    if (tid == 0) { int ts = 0; for (int e = 0; e < 64; ++e) { tst[e] = ts; ts += (cntL[e] + 255) >> 8; } tst[64] = ts; }
    __syncthreads();
}
__device__ __forceinline__ void phase10(const Args& a, LAS unsigned char* lds) {
    const int tid = threadIdx.x;
    unsigned char* ws = a.ws;
    moe_tables(a, lds);
    const LAS int* cntL = (const LAS int*)(lds + MOE_TAB_OFF); const LAS int* tst = cntL + 64; LAS int* tab = (LAS int*)(lds + MOE_TAB_OFF + 1024);
    pg8::MoeOrder1 S; S.cntL = cntL; S.tst = tst; S.npn = 4; S.G = (int)gridDim.x; S.c = (int)blockIdx.x; S.tab = tab; S.Bt = (const bf16*)(ws + WS_WGU); S.K = D;
    { const int* asg = (const int*)(ws + WS_ASG); pg8::Unit u;
      for (int i = 0; i < 12 && S.next(i, u); ++i) if (tid < 256) { const int p = u.pm * 256 + tid; tab[i * 256 + tid] = p < cntL[u.e] ? (asg[(size_t)u.e * CAP + p] >> 1) : 0; } }
    __syncthreads();
    pg8::Gemm g{(const bf16*)(ws + WS_H), (const bf16*)(ws + WS_WGU), 0, 0, D};
    pg8::EpiMoe1 E{(bf16*)(ws + WS_A), cntL, tst};
    pg8::gemm_phase2<pg8::EpiMoe1, pg8::MoeOrder1, true>(lds, g, S, E);
}
__device__ __forceinline__ void phase11(const Args& a, LAS unsigned char* lds) {
    unsigned char* ws = a.ws;
    moe_tables(a, lds);
    const LAS int* cntL = (const LAS int*)(lds + MOE_TAB_OFF); const LAS int* tst = cntL + 64;
    pg8::MoeOrder2 S; S.cntL = cntL; S.tst = tst; S.npn = 8; S.G = (int)gridDim.x; S.c = (int)blockIdx.x; S.Bt = (const bf16*)(ws + WS_WD); S.K = DE;
    pg8::Gemm g{(const bf16*)(ws + WS_A), (const bf16*)(ws + WS_WD), 0, 0, DE};
    pg8::EpiMoe2 E{(bf16*)(ws + WS_Y), (const int*)(ws + WS_ASG), (const float*)(ws + WS_RW), cntL, CAP, D};
    pg8::gemm_phase2<pg8::EpiMoe2, pg8::MoeOrder2, true>(lds, g, S, E);
}

template <bool WITH_MOE>
__device__ __forceinline__ void phase12(const Args& a) {
    const int tid = threadIdx.x, lane = tid & 63, wave = __builtin_amdgcn_readfirstlane(tid >> 6);
    const float* mod = (const float*)(a.ws + WS_MOD); const bf16* ybuf = (const bf16*)(a.ws + WS_Y); const float* fg = a.in[I_FG];
    const int gw = blockIdx.x * NWAVES + wave, NGW = gridDim.x * NWAVES;
    for (int row = gw; row < M; row += NGW) {
        const int b = row >> 11;
        f32x4* xr = (f32x4*)(a.out + (size_t)row * D) + lane;
        const u32x2* y0 = (const u32x2*)(ybuf + (size_t)(2 * row) * D) + lane; const u32x2* y1 = (const u32x2*)(ybuf + (size_t)(2 * row + 1) * D) + lane;
        const f32x4* g2 = (const f32x4*)(mod + (size_t)b * 12288 + 5 * 2048) + lane;
        f32x4 v[8]; float ss = 0.f;
#pragma unroll
        for (int j = 0; j < 8; ++j) { v[j] = xr[64 * j];
            if (WITH_MOE) { const u32x2 p0 = y0[64 * j], p1 = y1[64 * j]; const f32x4 gg = g2[64 * j];
                v[j][0] += gg[0] * (bflo(p0.x) + bflo(p1.x)); v[j][1] += gg[1] * (bfhi(p0.x) + bfhi(p1.x)); v[j][2] += gg[2] * (bflo(p0.y) + bflo(p1.y)); v[j][3] += gg[3] * (bfhi(p0.y) + bfhi(p1.y)); }
            ss += (v[j][0] * v[j][0] + v[j][1] * v[j][1]) + (v[j][2] * v[j][2] + v[j][3] * v[j][3]); }
        const float rstd = rsqrtf(wave_sum(ss) * (1.f / 2048.f) + EPS);
#pragma unroll
        for (int j = 0; j < 8; ++j) { const f32x4 f4 = *((const f32x4*)fg + lane + 64 * j); xr[64 * j] = v[j] * rstd * f4; }
    }
}

constexpr int NPHASES = 13;
#ifndef MK_N_LAUNCHES
#define MK_N_LAUNCHES 1
#endif
__global__ void __launch_bounds__(NWAVES * 64, 2) fwd(Args a) {
    extern __shared__ __attribute__((aligned(16))) unsigned char lds_raw[];
    LAS unsigned char* lds = (LAS unsigned char*)lds_raw;
    const int tid = threadIdx.x;
    if (tid < 64) ((LAS unsigned*)(lds + MISC_OFF))[tid] = 0u;
    __syncthreads();
    XcdBarrier bar; bar.bar = (unsigned*)(a.ws + WS_CTL) + CW_BAR; bar.x = 0; bar.st = nullptr;
    if (a.ph_hi - a.ph_lo > 1) bar = xcd_barrier_post((unsigned*)(a.ws + WS_CTL) + CW_BAR, (volatile LAS unsigned*)(lds + MISC_OFF) + 8);
    unsigned char* ws = a.ws;
#ifndef ONLY_PHASE
#define ONLY_PHASE -1
#endif
#define IN(k) ((ONLY_PHASE < 0 || ONLY_PHASE == (k)) && a.ph_lo <= (k) && (k) < a.ph_hi)
#define SEAM(k) do { if (IN(k) && IN((k) + 1)) xcd_barrier(bar); } while (0)
#ifndef REP0
#define REP0 1
#endif
#ifndef REP3
#define REP3 1
#endif
#ifndef REP6
#define REP6 1
#endif
#ifndef REP10
#define REP10 1
#endif
    if (IN(0)) for (int rep = 0; rep < REP0; ++rep) { phase0(a, lds); if (rep + 1 < REP0) xcd_barrier(bar); }
    SEAM(0);
    if (IN(1)) norm_mod_phase<true>(a, lds, a.in[I_X], a.in[I_N1G], 0, 1, (bf16*)(ws + WS_H));
    SEAM(1);
    if (IN(2)) { pg8::Gemm g{(const bf16*)(ws + WS_H), (const bf16*)(ws + WS_WIN), M, NP, D}; pg8::PlainOrder S; S.init(M, NP, (int)gridDim.x, (int)blockIdx.x); S.Bt = g.Bt; S.K = D;
        pg8::EpiBf16 E{(bf16*)(ws + WS_PROJ), NP};
        pg8::gemm_phase2<pg8::EpiBf16, pg8::PlainOrder, true>(lds, g, S, E); }
    SEAM(2);
    if (IN(3)) for (int rep = 0; rep < REP3; ++rep) { phase3(a, lds); if (rep + 1 < REP3) xcd_barrier(bar); }
    SEAM(3);
    if (IN(4)) phase4(a, lds);
    SEAM(4);
    if (IN(5)) phase5(a, lds);
    SEAM(5);
    if (IN(6)) for (int rep = 0; rep < REP6; ++rep) { phase6(a, lds); if (rep + 1 < REP6) xcd_barrier(bar); }
    SEAM(6);
    if (IN(7)) { pg8::Gemm g{(const bf16*)(ws + WS_CAT), (const bf16*)(ws + WS_WOUT), M, D, D}; pg8::PlainOrder S; S.init(M, D, (int)gridDim.x, (int)blockIdx.x); S.Bt = g.Bt; S.K = D;
        pg8::EpiResGate E{a.in[I_X], a.out, D, (const float*)(ws + WS_MOD) + 2 * 2048, 12288, T};
        pg8::gemm_phase2<pg8::EpiResGate, pg8::PlainOrder, true>(lds, g, S, E); }
    SEAM(7);
    if (IN(8)) norm_mod_phase<false>(a, lds, a.out, a.in[I_N2G], 3, 4, (bf16*)(ws + WS_H));
    SEAM(8);
    if (IN(9)) phase9(a, lds);
    SEAM(9);
    for (int rep = 0; rep < REP10; ++rep) {
    if (IN(10)) phase10(a, lds);
    SEAM(10);
    if (IN(11)) phase11(a, lds);
    if (rep + 1 < REP10) xcd_barrier(bar); }
    SEAM(11);
    if (IN(12)) phase12<true>(a);
#undef IN
#undef SEAM
}

extern "C" void kernel_launch(void* const* d_in, const int* in_sizes, int n_in, void* d_out, int out_size, void* d_ws, size_t ws_size, hipStream_t stream) {
    static int grid = 0;
    if (grid == 0) {
        if (n_in != 23 || out_size != M * D || ws_size < WS_END) { fprintf(stderr, "kernel_launch: unexpected shapes (n_in %d, out %d, ws %zu < %zu); nothing launched\n", n_in, out_size, ws_size, (size_t)WS_END); grid = -1; return; }
        int dev = 0, cus = 0, per_cu = 0;
        if (hipGetDevice(&dev) != hipSuccess || hipDeviceGetAttribute(&cus, hipDeviceAttributeMultiprocessorCount, dev) != hipSuccess) { grid = -1; return; }
        if (hipFuncSetAttribute((const void*)fwd, hipFuncAttributeMaxDynamicSharedMemorySize, LDS_BYTES) != hipSuccess) { fprintf(stderr, "kernel_launch: hipFuncSetAttribute failed\n"); grid = -1; return; }
        if (hipOccupancyMaxActiveBlocksPerMultiprocessor(&per_cu, (const void*)fwd, NWAVES * 64, LDS_BYTES) != hipSuccess || per_cu < 1) fprintf(stderr, "kernel_launch: occupancy query reports %d\n", per_cu);
        (void)hipGetLastError();
        grid = cus;
    }
    if (grid < 0) return;
    if (hipMemsetAsync((char*)d_ws + WS_CTL, 0, CTL_ZERO_BYTES, stream) != hipSuccess) return;
    Args a{};
    for (int i = 0; i < 23; ++i) a.in[i] = (const float*)d_in[i];
    a.out = (float*)d_out; a.ws = (unsigned char*)d_ws;
    constexpr int NL = MK_N_LAUNCHES;
    for (int li = 0; li < NL; ++li) {
        a.ph_lo = (NL == 1) ? 0 : li; a.ph_hi = (NL == 1) ? NPHASES : li + 1;
        hipLaunchKernelGGL(fwd, dim3(grid), dim3(NWAVES * 64), LDS_BYTES, stream, a);
        const hipError_t le = hipPeekAtLastError();
        if (le != hipSuccess) { fprintf(stderr, "kernel_launch: launch %d failed: %s\n", li, hipGetErrorName(le)); break; }
    }
}
```

```cpp
#include <hip/hip_runtime.h>
#include <cstdio>
#include <cstdint>
namespace pg8 {
#define PG8_LAS __attribute__((address_space(3)))
typedef unsigned short bf16_t;
typedef short bf16x8 __attribute__((ext_vector_type(8)));
typedef float f32x4 __attribute__((ext_vector_type(4)));
typedef unsigned u32x4 __attribute__((ext_vector_type(4)));
constexpr int BM = 256, BK = 64, HALF = 128, HTB = HALF * BK * 2  , STAGE_BYTES = 8 * HTB, NXCD = 8, WGM = 8;

__host__ __device__ __forceinline__ int lds_byte(int r, int c) { const int st = (r >> 4) * 2 + (c >> 5), rr = r & 15, cc = c & 31, ob = rr * 64 + cc * 2; return st * 1024 + (ob ^ (((ob >> 9) & 1) << 5)); }
__host__ __device__ __forceinline__ void stage_rc(int b, int& R, int& C) { const int st = b / 1024, sb = b % 1024, swz = sb ^ (((sb >> 9) & 1) << 5); R = (st >> 1) * 16 + swz / 64; C = (st & 1) * 32 + (swz % 64) / 2; }
__host__ __device__ __forceinline__ int perm32(int rho) { const int n = rho >> 4, i = rho & 15; return 8 * (i >> 2) + 4 * n + (i & 3); }

struct Unit { int pm, pn, e, ord; };
struct Gemm { const bf16_t* A; const bf16_t* Bt; int M, N, K; };

struct StaticOrder {
    int nM, nN, nwg, G, c;
    __host__ __device__ void init(int M, int N, int G_, int c_) { nM = M / BM; nN = N / BM; nwg = nM * nN; G = G_; c = c_; }
    __host__ __device__ bool next(int i, Unit& u) const {
        const long L = (long)i * G + c; if (L >= nwg) return false;
        int wgid = (int)L; { const int q = nwg / NXCD, r = nwg % NXCD, xcd = wgid % NXCD, off = wgid / NXCD; wgid = (xcd < r ? xcd * (q + 1) : r * (q + 1) + (xcd - r) * q) + off; }
        const int nig = WGM * nN, gid = wgid / nig, fm = gid * WGM, gsz = (nM - fm) < WGM ? (nM - fm) : WGM;
        u.pm = fm + ((wgid % nig) % gsz); u.pn = (wgid % nig) / gsz; return true;
    }
    __device__ __forceinline__ void a_ready(const Unit&) const {}
    __device__ __forceinline__ void done(const Unit&) const {}
};


typedef float f32x2 __attribute__((ext_vector_type(2)));
typedef __bf16 bf16x2_t __attribute__((ext_vector_type(2)));
__device__ __forceinline__ unsigned cvt_pk_bf16(float lo, float hi) { f32x2 v = {lo, hi}; bf16x2_t r = __builtin_convertvector(v, bf16x2_t); return __builtin_bit_cast(unsigned, r); }

struct EpiBf16 {
    static constexpr bool PERM = true, AFTER_DRAIN = false;
    bf16_t* O; int ldc;
    __device__ __forceinline__ void operator()(const f32x4 (&acc)[2][2][4][2], const Unit& u, int wr, int wc, int fr, int fq) const {
        const int row0 = u.pm * BM + wr * 64 + fr; const int col0 = u.pn * BM + wc * 32 + 8 * fq;
#pragma unroll
        for (int ai = 0; ai < 2; ++ai)
#pragma unroll
            for (int m = 0; m < 4; ++m) { bf16_t* rowp = O + (size_t)(row0 + ai * HALF + m * 16) * ldc + col0;
#pragma unroll
                for (int bj = 0; bj < 2; ++bj) { const f32x4 v0 = acc[ai][bj][m][0], v1 = acc[ai][bj][m][1];
                    u32x4 w; w.x = cvt_pk_bf16(v0[0], v0[1]); w.y = cvt_pk_bf16(v0[2], v0[3]); w.z = cvt_pk_bf16(v1[0], v1[1]); w.w = cvt_pk_bf16(v1[2], v1[3]);
                    *(u32x4*)(rowp + bj * HALF) = w; } }
    }
};
struct EpiResGate {
    static constexpr bool PERM = false, AFTER_DRAIN = false;
    const float* base; float* out; int ldc; const float* gate; int gstride; int rows_per_batch;
    __device__ __forceinline__ void operator()(const f32x4 (&acc)[2][2][4][2], const Unit& u, int wr, int wc, int fr, int fq) const {
        const int row0 = u.pm * BM + wr * 64 + fr, col0 = u.pn * BM + wc * 32 + 4 * fq;
        const float* gp = gate + (size_t)((u.pm * BM) / rows_per_batch) * gstride + col0;
        f32x4 gv[2][2];
#pragma unroll
        for (int bj = 0; bj < 2; ++bj)
#pragma unroll
            for (int n = 0; n < 2; ++n) gv[bj][n] = *(const f32x4*)(gp + bj * HALF + n * 16);
#pragma unroll
        for (int ai = 0; ai < 2; ++ai)
#pragma unroll
            for (int m = 0; m < 4; ++m) { const size_t off = (size_t)(row0 + ai * HALF + m * 16) * ldc + col0;
#pragma unroll
                for (int bj = 0; bj < 2; ++bj)
#pragma unroll
                    for (int n = 0; n < 2; ++n) { const f32x4 bs = *(const f32x4*)(base + off + bj * HALF + n * 16);
                        *(f32x4*)(out + off + bj * HALF + n * 16) = bs + gv[bj][n] * acc[ai][bj][m][n]; } }
    }
};


struct PlainOrder : StaticOrder {
    const bf16_t* Bt; int K;
    __device__ __forceinline__ void a_offs(const Unit& u, int tid, unsigned (&v)[2][2]) const {
#pragma unroll
        for (int h = 0; h < 2; ++h)
#pragma unroll
            for (int i = 0; i < 2; ++i) { int R, C; stage_rc(tid * 16 + i * 8192, R, C); v[h][i] = (unsigned)((u.pm * BM + h * HALF + R) * K + C) * 2u; }
    }
    __device__ __forceinline__ const char* b_base(const Unit& u) const { return (const char*)Bt + (size_t)u.pn * ((size_t)BM * K * 2); }
};
struct MoeOrder {
    const PG8_LAS int* cntL; const PG8_LAS int* tst; int npn, G, c;
    __device__ __forceinline__ bool next(int i, Unit& u) const {
        const int L = i * G + c; if (L >= tst[64] * npn) return false;
        const int tile = L / npn; u.pn = L - tile * npn; int e = 0; while (tst[e + 1] <= tile) ++e; u.e = e; u.pm = tile - tst[e]; u.ord = i; return true; }
};
struct MoeOrder1 : MoeOrder {
    const PG8_LAS int* tab; const bf16_t* Bt; int K;
    __device__ __forceinline__ void a_offs(const Unit& u, int tid, unsigned (&v)[2][2]) const {
#pragma unroll
        for (int h = 0; h < 2; ++h)
#pragma unroll
            for (int i = 0; i < 2; ++i) { int R, C; stage_rc(tid * 16 + i * 8192, R, C); v[h][i] = (unsigned)(tab[u.ord * 256 + h * HALF + R] * K + C) * 2u; }
    }
    __device__ __forceinline__ const char* b_base(const Unit& u) const { return (const char*)Bt + ((size_t)u.e * 1024 + (size_t)u.pn * 256) * ((size_t)K * 2); }
};
struct MoeOrder2 : MoeOrder {
    const bf16_t* Bt; int K;
    __device__ __forceinline__ void a_offs(const Unit& u, int tid, unsigned (&v)[2][2]) const {
        const int row0 = 256 * (tst[u.e] + u.pm);
#pragma unroll
        for (int h = 0; h < 2; ++h)
#pragma unroll
            for (int i = 0; i < 2; ++i) { int R, C; stage_rc(tid * 16 + i * 8192, R, C); v[h][i] = (unsigned)((row0 + h * HALF + R) * K + C) * 2u; }
    }
    __device__ __forceinline__ const char* b_base(const Unit& u) const { return (const char*)Bt + ((size_t)u.e * 2048 + (size_t)u.pn * 256) * ((size_t)K * 2); }
};
struct EpiMoe1 {
    static constexpr bool PERM = true, AFTER_DRAIN = false;
    bf16_t* abuf; const PG8_LAS int* cntL; const PG8_LAS int* tst;
    __device__ __forceinline__ void operator()(const f32x4 (&acc)[2][2][4][2], const Unit& u, int wr, int wc, int fr, int fq) const {
        const int ne = cntL[u.e]; const size_t row0 = (size_t)256 * (tst[u.e] + u.pm);
        asm volatile("" : "+v"(fr), "+v"(fq));
#pragma unroll
        for (int ai = 0; ai < 2; ++ai)
#pragma unroll
            for (int m = 0; m < 4; ++m) { const int r = ai * HALF + wr * 64 + m * 16 + fr;
                if (u.pm * 256 + r < ne) { const f32x4 g0 = acc[ai][0][m][0], g1 = acc[ai][0][m][1], u0 = acc[ai][1][m][0], u1 = acc[ai][1][m][1];
                    f32x4 a0, a1;
#pragma unroll
                    for (int j = 0; j < 4; ++j) { a0[j] = g0[j] * __builtin_amdgcn_rcpf(1.f + __builtin_amdgcn_exp2f(-1.4426950408889634f * g0[j])) * u0[j]; a1[j] = g1[j] * __builtin_amdgcn_rcpf(1.f + __builtin_amdgcn_exp2f(-1.4426950408889634f * g1[j])) * u1[j]; }
                    u32x4 w; w.x = cvt_pk_bf16(a0[0], a0[1]); w.y = cvt_pk_bf16(a0[2], a0[3]); w.z = cvt_pk_bf16(a1[0], a1[1]); w.w = cvt_pk_bf16(a1[2], a1[3]);
                    *(u32x4*)(abuf + (row0 + r) * 512 + u.pn * 128 + wc * 32 + 8 * fq) = w; } }
    }
};
struct EpiMoe2 {
    static constexpr bool PERM = true, AFTER_DRAIN = false;
    bf16_t* ybuf; const int* asg; const float* rw; const PG8_LAS int* cntL; int cap, ldy;
    __device__ __forceinline__ void operator()(const f32x4 (&acc)[2][2][4][2], const Unit& u, int wr, int wc, int fr, int fq) const {
        const int ne = cntL[u.e];
#pragma unroll
        for (int ai = 0; ai < 2; ++ai)
#pragma unroll
            for (int m = 0; m < 4; ++m) { const int p = u.pm * 256 + ai * HALF + wr * 64 + m * 16 + fr;
                if (p < ne) { const int av = asg[(size_t)u.e * cap + p]; const float wv = rw[(size_t)u.e * cap + p];
                    bf16_t* rowp = ybuf + (size_t)av * ldy + u.pn * BM + wc * 32 + 8 * fq;
#pragma unroll
                    for (int bj = 0; bj < 2; ++bj) { const f32x4 v0 = acc[ai][bj][m][0] * wv, v1 = acc[ai][bj][m][1] * wv;
                        u32x4 w; w.x = cvt_pk_bf16(v0[0], v0[1]); w.y = cvt_pk_bf16(v0[2], v0[3]); w.z = cvt_pk_bf16(v1[0], v1[1]); w.w = cvt_pk_bf16(v1[2], v1[3]);
                        *(u32x4*)(rowp + bj * HALF) = w; } } }
    }
};


template <class Epi, class Sched, bool ALIGN_EPI = false>
__device__ __forceinline__ void gemm_phase2(PG8_LAS unsigned char* lds, const Gemm g, const Sched& S, const Epi& E) {
    const int tid = threadIdx.x, wid = __builtin_amdgcn_readfirstlane(tid >> 6), lane = tid & 63, wr = wid >> 2, wc = wid & 3, fr = lane & 15, fq = lane >> 4;
    const int K = g.K, nt = K / BK;
    unsigned vC[2][2], vN[2][2], voffB[2];
#pragma unroll
    for (int i = 0; i < 2; ++i) { int R, C; stage_rc(tid * 16 + i * 8192, R, C); const int Rb = Epi::PERM ? ((R & ~31) + perm32(R & 31)) : R; voffB[i] = (unsigned)(Rb * K + C) * 2u; }
    const size_t kstep = (size_t)(BK * 2);
    const size_t hstep = (size_t)HALF * K * 2;
    const unsigned ldsw = (unsigned)wid * 1024u;
    const int aoff = lds_byte(wr * 64 + fr, fq * 8), boff = lds_byte(wc * 32 + fr, fq * 8);
#define PG8_SA(b, h) (((b) * 2 + (h)) * HTB)
#define PG8_SB(b, h) ((4 + (b) * 2 + (h)) * HTB)
#define PG8_STAGE(bufoff, gbase, voff) do { _Pragma("unroll") for (int _i = 0; _i < 2; ++_i) \
        __builtin_amdgcn_global_load_lds((const unsigned*)((const char*)(gbase) + (voff)[_i]), (PG8_LAS unsigned*)(lds + (bufoff) + ldsw + _i * 8192), 16, 0, 0); } while (0)
#define PG8_LDA(dst, b, h) do { _Pragma("unroll") for (int m = 0; m < 4; ++m) _Pragma("unroll") for (int k = 0; k < 2; ++k) dst[m][k] = *(const PG8_LAS bf16x8*)(lds + PG8_SA(b, h) + aoff + m * 2048 + k * 1024); } while (0)
#define PG8_LDB(dst, b, h) do { _Pragma("unroll") for (int n = 0; n < 2; ++n) _Pragma("unroll") for (int k = 0; k < 2; ++k) dst[n][k] = *(const PG8_LAS bf16x8*)(lds + PG8_SB(b, h) + boff + n * 2048 + k * 1024); } while (0)
#define PG8_MMA(ai, bj, At, Bt) do { __builtin_amdgcn_s_setprio(1); _Pragma("unroll") for (int m = 0; m < 4; ++m) _Pragma("unroll") for (int n = 0; n < 2; ++n) _Pragma("unroll") for (int k = 0; k < 2; ++k) \
        acc[ai][bj][m][n] = __builtin_amdgcn_mfma_f32_16x16x32_bf16(Bt[n][k], At[m][k], acc[ai][bj][m][n], 0, 0, 0); __builtin_amdgcn_s_setprio(0); } while (0)
#define PG8_WAIT_V(n) asm volatile("s_waitcnt vmcnt(" #n ")" ::: "memory")
#define PG8_WAIT_L(n) asm volatile("s_waitcnt lgkmcnt(" #n ")" ::: "memory")
#define PG8_BAR __builtin_amdgcn_s_barrier()
#define PG8_SCHED __builtin_amdgcn_sched_barrier(0)
    Unit cur, nxt; int ui = 0;
    if (!S.next(0, cur)) return;
    f32x4 acc[2][2][4][2];
#pragma unroll
    for (int a = 0; a < 2; ++a)
#pragma unroll
        for (int b = 0; b < 2; ++b)
#pragma unroll
            for (int m = 0; m < 4; ++m)
#pragma unroll
                for (int n = 0; n < 2; ++n) acc[a][b][m][n] = (f32x4){0.f, 0.f, 0.f, 0.f};
    bf16x8 At[4][2], B0[2][2], B1[2][2];
    const char* Ab = (const char*)g.A; const char* cB = S.b_base(cur);
    S.a_offs(cur, tid, vC);
    PG8_STAGE(PG8_SB(0, 0), cB, voffB); PG8_STAGE(PG8_SB(0, 1), cB + hstep, voffB); PG8_STAGE(PG8_SA(0, 0), Ab, vC[0]); PG8_STAGE(PG8_SA(0, 1), Ab, vC[1]);
    if (wr == 1) PG8_BAR;
    PG8_WAIT_V(2); PG8_BAR;
    PG8_STAGE(PG8_SB(1, 0), cB + kstep, voffB); PG8_STAGE(PG8_SA(1, 0), Ab + kstep, vC[0]); PG8_STAGE(PG8_SB(1, 1), cB + hstep + kstep, voffB);
    PG8_WAIT_V(6); PG8_BAR;
    for (;;) {
        const bool has_next = S.next(ui + 1, nxt);
        const char* nB = cB;
        if (has_next) { S.a_offs(nxt, tid, vN); nB = S.b_base(nxt); }
        else {
#pragma unroll
            for (int hh = 0; hh < 2; ++hh)
#pragma unroll
                for (int i = 0; i < 2; ++i) vN[hh][i] = vC[hh][i]; }
        for (int t = 0; t < nt; t += 2) {
            const bool last = (t == nt - 2);
            const char* a1 = Ab + (size_t)(t + 1) * kstep;
            const char* a2 = last ? Ab : Ab + (size_t)(t + 2) * kstep; const char* b2 = last ? nB : cB + (size_t)(t + 2) * kstep;
            const char* a3 = a2 + kstep; const char* b3 = b2 + kstep;
            unsigned v2[2][2];
#pragma unroll
            for (int hh = 0; hh < 2; ++hh)
#pragma unroll
                for (int i = 0; i < 2; ++i) v2[hh][i] = last ? vN[hh][i] : vC[hh][i];
            PG8_LDB(B0, 0, 0); PG8_LDB(B1, 0, 1); PG8_SCHED; PG8_LDA(At, 0, 0); PG8_STAGE(PG8_SA(1, 1), a1, vC[1]);
            PG8_WAIT_V(8); PG8_WAIT_L(0); PG8_BAR; PG8_MMA(0, 0, At, B0); PG8_MMA(0, 1, At, B1); PG8_BAR; PG8_SCHED;
            PG8_LDA(At, 0, 1); PG8_STAGE(PG8_SB(0, 0), b2, voffB); PG8_STAGE(PG8_SB(0, 1), b2 + hstep, voffB); PG8_STAGE(PG8_SA(0, 0), a2, v2[0]);
            PG8_WAIT_V(8); PG8_WAIT_L(0); PG8_BAR; PG8_MMA(1, 0, At, B0); PG8_MMA(1, 1, At, B1); PG8_BAR; PG8_SCHED;
            PG8_LDB(B0, 1, 0); PG8_LDB(B1, 1, 1); PG8_SCHED; PG8_LDA(At, 1, 0); PG8_STAGE(PG8_SA(0, 1), a2, v2[1]);
            PG8_WAIT_V(8); PG8_WAIT_L(0); PG8_BAR; PG8_MMA(0, 0, At, B0); PG8_MMA(0, 1, At, B1); PG8_BAR; PG8_SCHED;
            PG8_LDA(At, 1, 1); PG8_STAGE(PG8_SB(1, 0), b3, voffB); PG8_STAGE(PG8_SB(1, 1), b3 + hstep, voffB); PG8_STAGE(PG8_SA(1, 0), a3, v2[0]);
            PG8_WAIT_V(8); PG8_WAIT_L(0); PG8_BAR; PG8_MMA(1, 0, At, B0); PG8_MMA(1, 1, At, B1); PG8_BAR; PG8_SCHED;
        }
        if constexpr (ALIGN_EPI) { if (wr == 0) PG8_BAR; }
        E(acc, cur, wr, wc, fr, fq);
        if (!has_next) break;
#pragma unroll
        for (int a = 0; a < 2; ++a)
#pragma unroll
            for (int b = 0; b < 2; ++b)
#pragma unroll
                for (int m = 0; m < 4; ++m)
#pragma unroll
                    for (int n = 0; n < 2; ++n) acc[a][b][m][n] = (f32x4){0.f, 0.f, 0.f, 0.f};
        cur = nxt; cB = nB; ++ui;
#pragma unroll
        for (int hh = 0; hh < 2; ++hh)
#pragma unroll
            for (int i = 0; i < 2; ++i) vC[hh][i] = vN[hh][i];
        if constexpr (ALIGN_EPI) { if (wr == 1) PG8_BAR; }
    }
    PG8_WAIT_V(0);
    if constexpr (!ALIGN_EPI) { if (wr == 0) PG8_BAR; }
    PG8_BAR;
#undef PG8_SA
#undef PG8_SB
#undef PG8_STAGE
#undef PG8_LDA
#undef PG8_LDB
#undef PG8_MMA
#undef PG8_WAIT_V
#undef PG8_WAIT_L
#undef PG8_BAR
#undef PG8_SCHED
}
}

constexpr int NB = 8, T = 2048, D = 2048, M = NB * T;
constexpr int NP = 6912, PROJ = 6680;
constexpr int C_RQ = 0, C_RK = 1024, C_RV = 2048, C_RG = 3072, C_NQ = 4096, C_KC = 5120, C_VC = 5376, C_KS = 5632, C_VS = 5888, C_KW = 6144, C_VW = 6400, C_NG = 6656;
constexpr int NEXP = 64, DE = 512, CAP = 32768;
constexpr float EPS = 1e-6f;
constexpr int NWAVES = 8;

constexpr size_t MiB = 1u << 20;
constexpr size_t WS_CTL = 0, CTL_ZERO_BYTES = 1 * MiB;
constexpr size_t WS_SMALL = 1 * MiB;
constexpr size_t WS_BIAS1K = WS_SMALL, WS_BIAS1V = WS_SMALL + 1024, WS_W2KT = WS_SMALL + 4096, WS_W2VT = WS_W2KT + 65536, WS_WRT = WS_W2VT + 65536;
constexpr size_t WS_MODP = 2 * MiB;
constexpr size_t WS_MOD = WS_MODP + 4 * 8 * 12288 * 4;
constexpr size_t WS_COS = 4 * MiB, WS_SIN = 5 * MiB;
constexpr size_t WS_W1K = 6 * MiB, WS_W1V = 8 * MiB;
constexpr size_t WS_YK = 10 * MiB, WS_YV = 14 * MiB;
constexpr size_t WS_KC = 18 * MiB, WS_VCT = 19 * MiB;
constexpr size_t WS_BIAS1P = 20 * MiB;
constexpr size_t WS_ASG = 26 * MiB, WS_RW = 34 * MiB;
constexpr size_t WS_WIN = 42 * MiB;
constexpr size_t WS_WOUT = 70 * MiB;
constexpr size_t WS_WGU = 78 * MiB;
constexpr size_t WS_WD = 334 * MiB;
constexpr size_t WS_H = 462 * MiB;
constexpr size_t WS_PROJ = 526 * MiB;
constexpr size_t WS_Y = 526 * MiB;
constexpr size_t WS_A = 654 * MiB;
constexpr size_t WS_QR = 742 * MiB, WS_KR = 774 * MiB, WS_KZT = 806 * MiB, WS_VT = 838 * MiB;
constexpr size_t WS_SP = 870 * MiB;
constexpr size_t WS_KCMP = 934 * MiB, WS_VCMP = 942 * MiB, WS_VST = 950 * MiB, WS_VWT = 958 * MiB;
constexpr size_t WS_CAT = 966 * MiB;
constexpr size_t WS_END = 1030 * MiB;
constexpr int CW_BAR = 4096;
constexpr int CW_Q = 8448;
constexpr int CW_CNT = 8192;

constexpr int LDS_BYTES = 147456;
constexpr int MISC_OFF = LDS_BYTES - 256;

#define GAS __attribute__((address_space(1)))
#define LAS __attribute__((address_space(3)))
typedef unsigned short bf16;
typedef short bf16x8 __attribute__((ext_vector_type(8)));
typedef short bf16x4 __attribute__((ext_vector_type(4)));
typedef float f32x4 __attribute__((ext_vector_type(4)));
typedef float f32x16 __attribute__((ext_vector_type(16)));
typedef unsigned u32x4 __attribute__((ext_vector_type(4)));
typedef unsigned u32x2 __attribute__((ext_vector_type(2)));
#define LDS_WAIT() asm volatile("s_waitcnt lgkmcnt(0)" ::: "memory")
#define VM_WAIT() asm volatile("s_waitcnt vmcnt(0)" ::: "memory")
#define MFMA16(a, b, c) __builtin_amdgcn_mfma_f32_16x16x32_bf16((a), (b), (c), 0, 0, 0)
#define MFMA32(a, b, c) __builtin_amdgcn_mfma_f32_32x32x16_bf16((a), (b), (c), 0, 0, 0)
using pg8::cvt_pk_bf16;
__device__ __forceinline__ float bf2f(unsigned short b) { return __uint_as_float(((unsigned)b) << 16); }
__device__ __forceinline__ float bflo(unsigned w) { return __uint_as_float(w << 16); }
__device__ __forceinline__ float bfhi(unsigned w) { return __uint_as_float(w & 0xffff0000u); }
__device__ __forceinline__ float wave_sum(float v) {
#pragma unroll
    for (int o = 1; o < 64; o <<= 1) v += __shfl_xor(v, o);
    return v;
}
__device__ __forceinline__ float silu_f(float x) { return x / (1.f + __expf(-x)); }
__device__ __forceinline__ float sigmoid_f(float x) { return 1.f / (1.f + __expf(-x)); }
__device__ __forceinline__ bf16x8 cat4(bf16x4 lo, bf16x4 hi) { return __builtin_shufflevector(lo, hi, 0, 1, 2, 3, 4, 5, 6, 7); }
__device__ __forceinline__ bf16x8 pack8(const f32x4 a, const f32x4 b) { u32x4 p; p.x = cvt_pk_bf16(a[0], a[1]); p.y = cvt_pk_bf16(a[2], a[3]); p.z = cvt_pk_bf16(b[0], b[1]); p.w = cvt_pk_bf16(b[2], b[3]); return __builtin_bit_cast(bf16x8, p); }

#define XB_TMO      128
#define XB_XCNT(j)  (256  + 64 * (j))
#define XB_XSUB(j)  (1280 + 64 * (j))
#define XB_XGEN(j)  (2304 + 64 * (j))
#define XB_TOP      3328
#define XB_TOPGEN   3392
#define XCD_BAR_WORDS 3456
#define XB_SPIN_CAP (1u << 18)

__device__ __forceinline__ unsigned xb_ld(unsigned* p)              { return __hip_atomic_load(p, __ATOMIC_RELAXED, __HIP_MEMORY_SCOPE_AGENT); }
__device__ __forceinline__ unsigned xb_add(unsigned* p, unsigned v) { return __hip_atomic_fetch_add(p, v, __ATOMIC_RELAXED, __HIP_MEMORY_SCOPE_AGENT); }
__device__ __forceinline__ unsigned xb_xcc_id() { return (unsigned)__builtin_amdgcn_s_getreg((3 << 11) | 20) & 0xFu; }
#define XB_SPIN(cond, bar) do { unsigned _sp = 0; while (cond) { __builtin_amdgcn_s_sleep(1); \
    if ((++_sp & 255u) == 0u) { if (xb_ld(&(bar)[XB_TMO])) break; if (_sp > XB_SPIN_CAP) { atomicAdd(&(bar)[XB_TMO], 1u); break; } } } } while (0)

struct XcdBarrier {
    unsigned* bar; unsigned x;
    volatile LAS unsigned* st;
};

__device__ __forceinline__ XcdBarrier xcd_barrier_post(unsigned* bar, volatile LAS unsigned* st) {
    XcdBarrier b; b.bar = bar; b.x = xb_xcc_id(); b.st = st;
    if (threadIdx.x == 0) (void)xb_add(&bar[XB_XCNT(b.x)], 1u);
    return b;
}
__device__ __forceinline__ void xcd_barrier_complete(unsigned* bar, unsigned x, unsigned& nloc, unsigned& nx) {
    const unsigned G = gridDim.x * gridDim.y * gridDim.z;
    unsigned sum, cnt, mine, sp = 0u;
    for (;;) {
        sum = 0u; cnt = 0u; mine = 0u;
#pragma unroll
        for (unsigned j = 0; j < 16; ++j) { const unsigned c = xb_ld(&bar[XB_XCNT(j)]); sum += c; cnt += (c > 0u) ? 1u : 0u; mine = (j == x) ? c : mine; }
        if (sum == G) break;
        __builtin_amdgcn_s_sleep(1);
        if ((++sp & 255u) == 0u) { if (xb_ld(&bar[XB_TMO])) break; if (sp > XB_SPIN_CAP) { atomicAdd(&bar[XB_TMO], 1u); break; } }
    }
    nloc = mine > 0u ? mine : 1u; nx = cnt > 0u ? cnt : 1u;
}

__device__ __forceinline__ void xcd_barrier(const XcdBarrier& b) {
    asm volatile("s_waitcnt vmcnt(0)" ::: "memory");
    __syncthreads();
    if (threadIdx.x == 0) {
        unsigned* bar = b.bar;
        __builtin_amdgcn_s_waitcnt(0);
        unsigned nloc = b.st[0], nx = b.st[1];
        if (nloc == 0u) { xcd_barrier_complete(bar, b.x, nloc, nx); b.st[0] = nloc; b.st[1] = nx; }
        const unsigned old = xb_add(&bar[XB_XSUB(b.x)], 1u);
        const unsigned gen = old / nloc;
        if (old + 1u == (gen + 1u) * nloc) {
            __builtin_amdgcn_fence(__ATOMIC_RELEASE, "agent");
            asm volatile("s_waitcnt vmcnt(0)" ::: "memory");
            const unsigned og = xb_add(&bar[XB_TOP], 1u);
            const unsigned tg = og / nx;
            if (og + 1u == (tg + 1u) * nx) xb_add(&bar[XB_TOPGEN], 1u);
            else XB_SPIN(xb_ld(&bar[XB_TOPGEN]) == tg, bar);
            __builtin_amdgcn_fence(__ATOMIC_ACQUIRE, "agent");
            xb_add(&bar[XB_XGEN(b.x)], 1u);
            asm volatile("s_waitcnt vmcnt(0)" ::: "memory");
        } else {
            XB_SPIN(xb_ld(&bar[XB_XGEN(b.x)]) == gen, bar);
            __builtin_amdgcn_fence(__ATOMIC_ACQUIRE, "agent");
            asm volatile("s_waitcnt vmcnt(0)" ::: "memory");
        }
    }
    __syncthreads();
}

struct Args { const float* in[23]; float* out; unsigned char* ws; int ph_lo, ph_hi; };
enum { I_X = 0, I_C, I_WADA, I_BADA, I_N1G, I_N2G, I_FG, I_WIN, I_GNG, I_PK, I_W1K, I_W2K, I_PV, I_W1V, I_W2V, I_WOUT, I_WGRP, I_BGRP, I_WEXP, I_BEXP, I_WGATE, I_WUP, I_WDOWN };

__device__ __forceinline__ float ret_lg(int h) { return h == 0 ? -0.0317486983145803f : (h == 1 ? -0.015748356968139168f : (h == 2 ? -0.007843177461025893f : -0.003913899321136329f)); }

__device__ __forceinline__ void transpose_tile(const float* __restrict__ W, int ldw, int k0, int n0, int nmax, bf16* __restrict__ WT, int ldt, int drow0, int dcol0, LAS float* scr, int lane) {
    const int kr = lane >> 4, n4 = (lane & 15) * 4;
    f32x4 v[16];
    const bool ok = (n0 + n4) < nmax;
    const float* src = W + (size_t)(k0 + kr) * ldw + n0 + n4;
#pragma unroll
    for (int i = 0; i < 16; ++i) v[i] = ok ? *(const f32x4*)(src + (size_t)(4 * i) * ldw) : (f32x4){0.f, 0.f, 0.f, 0.f};
#pragma unroll
    for (int i = 0; i < 16; ++i) { LAS float* d = scr + (4 * i + kr) * 65 + n4; d[0] = v[i][0]; d[1] = v[i][1]; d[2] = v[i][2]; d[3] = v[i][3]; }
    LDS_WAIT();
    const int c = lane & 7;
#pragma unroll
    for (int j = 0; j < 8; ++j) { const int nn = 8 * j + (lane >> 3); const LAS float* s = scr + (8 * c) * 65 + nn;
        u32x4 o; o.x = cvt_pk_bf16(s[0 * 65], s[1 * 65]); o.y = cvt_pk_bf16(s[2 * 65], s[3 * 65]); o.z = cvt_pk_bf16(s[4 * 65], s[5 * 65]); o.w = cvt_pk_bf16(s[6 * 65], s[7 * 65]);
        *(u32x4*)(WT + (size_t)(drow0 + nn) * ldt + dcol0 + 8 * c) = o; }
    LDS_WAIT();
}

__device__ __forceinline__ void phase0(const Args& a, LAS unsigned char* lds) {
    const int tid = threadIdx.x, lane = tid & 63, wave = __builtin_amdgcn_readfirstlane(tid >> 6);
    unsigned char* ws = a.ws;
    {
        LAS float* cact = (LAS float*)lds;
        LAS float* red = (LAS float*)(lds + 16384);
        const float* c = a.in[I_C]; const float* wada = a.in[I_WADA];
        float* modp = (float*)(ws + WS_MODP);
        for (int it = blockIdx.x; it < 768; it += gridDim.x) {
            const int kq = it / 192, cc = it % 192;
            __syncthreads();
            for (int i = tid; i < 8 * 512; i += 512) { const int b = i >> 9, k = i & 511; cact[i] = silu_f(c[b * 2048 + kq * 512 + k]); }
            __syncthreads();
            float acc[8];
#pragma unroll
            for (int b = 0; b < 8; ++b) acc[b] = 0.f;
            const float* wp = wada + (size_t)(kq * 512 + wave * 64) * 12288 + cc * 64 + lane;
#pragma unroll 8
            for (int kk = 0; kk < 64; ++kk) { const float wv = wp[(size_t)kk * 12288];
#pragma unroll
                for (int b = 0; b < 8; ++b) acc[b] += cact[b * 512 + wave * 64 + kk] * wv; }
#pragma unroll
            for (int b = 0; b < 8; ++b) red[(wave * 8 + b) * 64 + lane] = acc[b];
            __syncthreads();
            { const int b = tid >> 6, l = tid & 63; float s = 0.f;
#pragma unroll
              for (int w = 0; w < 8; ++w) s += red[(w * 8 + b) * 64 + l];
              modp[((size_t)kq * 8 + b) * 12288 + cc * 64 + l] = s; }
        }
    }
    __syncthreads();
    {
        const int gw = blockIdx.x * NWAVES + wave, NGW = gridDim.x * NWAVES;
        float* bp = (float*)(ws + WS_BIAS1P);
        for (int it = NGW - 1 - gw; it < 128; it += NGW) { const int ten = it >> 6, kc = it & 63;
            const float* pe = a.in[ten ? I_PV : I_PK] + kc * 64; const float* w1 = a.in[ten ? I_W1V : I_W1K] + (size_t)kc * 64 * 256 + 4 * lane;
            f32x4 acc = (f32x4){0.f, 0.f, 0.f, 0.f};
#pragma unroll 16
            for (int k = 0; k < 64; ++k) acc = acc + *(const f32x4*)(w1 + (size_t)k * 256) * pe[k];
            *(f32x4*)(bp + (size_t)it * 256 + 4 * lane) = acc; }
    }
    {
        LAS float* scr = (LAS float*)(lds + wave * 16640);
        const int gw = blockIdx.x * NWAVES + wave, NGW = gridDim.x * NWAVES;
        constexpr int I_IN = 108 * 32, I_OUT = 32 * 32, I_W1 = 256, I_W2 = 8;
        constexpr int NITEMS = I_IN + I_OUT + 2 * I_W1 + 2 * I_W2;
        for (int it = gw; it < NITEMS; it += NGW) {
            int r = it;
            if (r < I_IN) { const int kb = r / 108, nb = r % 108; transpose_tile(a.in[I_WIN], PROJ, 64 * kb, 64 * nb, PROJ, (bf16*)(ws + WS_WIN), 2048, 64 * nb, 64 * kb, scr, lane); continue; } r -= I_IN;
            if (r < I_OUT) { const int kb = r >> 5, nb = r & 31; transpose_tile(a.in[I_WOUT], 2048, 64 * kb, 64 * nb, 2048, (bf16*)(ws + WS_WOUT), 2048, 64 * nb, 64 * kb, scr, lane); continue; } r -= I_OUT;
            if (r < 2 * I_W1) { const int ten = r >= I_W1 ? 1 : 0; r -= ten * I_W1; const int kb = r >> 2, nb = r & 3, k0 = 64 * kb;
                transpose_tile(a.in[ten ? I_W1V : I_W1K], 256, k0, 64 * nb, 256, (bf16*)(ws + (ten ? WS_W1V : WS_W1K)), 2048, (k0 >= 2048 ? 256 : 0) + 64 * nb, k0 & 2047, scr, lane); continue; } r -= 2 * I_W1;
            { const int ten = r >= I_W2 ? 1 : 0; r -= ten * I_W2; const int kb = r >> 1, nb = r & 1;
                transpose_tile(a.in[ten ? I_W2V : I_W2K], 128, 64 * kb, 64 * nb, 128, (bf16*)(ws + (ten ? WS_W2VT : WS_W2KT)), 256, 64 * nb, 64 * kb, scr, lane); }
        }
    }
    {
        const int gt = blockIdx.x * 512 + tid, NT = gridDim.x * 512;
        bf16* wrt = (bf16*)(ws + WS_WRT); const float* wg = a.in[I_WGRP]; const float* we = a.in[I_WEXP];
        for (int idx = gt; idx < 80 * 2048; idx += NT) { const int n = idx >> 11, k = idx & 2047;
            const float v = n < 8 ? wg[k * 8 + n] : (n < 72 ? we[k * 64 + (n - 8)] : 0.f); wrt[idx] = (bf16)(cvt_pk_bf16(v, 0.f) & 0xffffu); }
        float* cosT = (float*)(ws + WS_COS); float* sinT = (float*)(ws + WS_SIN);
        for (int idx = gt; idx < 2048 * 128; idx += NT) { const int pos = idx >> 7, j = idx & 127;
            const float inv = exp2f(-(float)j * 0.10381025296523007f);
            const double rev = (double)pos * (double)inv * 0.15915494309189535;
            const float fr = (float)(rev - __builtin_floor(rev));
            cosT[idx] = __builtin_amdgcn_cosf(fr); sinT[idx] = __builtin_amdgcn_sinf(fr); }
    }
}

struct TTItem { const float* src; bf16* dst; int ldw, ldt; };
__device__ __forceinline__ void moe_item(const Args& a, int it, int lane, TTItem& t) {
    constexpr int I_G = 64 * 256; unsigned char* ws = a.ws; const int kr = lane >> 4, n4 = (lane & 15) * 4;
    int r = it;
    if (r < 2 * I_G) { const int up = r >= I_G ? 1 : 0; r -= up * I_G; const int e = r >> 8, rr = r & 255, kb = rr >> 3, nb = rr & 7, n0 = 64 * nb;
        t.src = a.in[up ? I_WUP : I_WGATE] + (size_t)e * 2048 * 512 + (size_t)(64 * kb + kr) * 512 + n0 + n4; t.ldw = 512;
        t.dst = (bf16*)(ws + WS_WGU) + (size_t)(e * 1024 + (n0 >> 7) * 256 + up * 128 + (n0 & 127)) * 2048 + 64 * kb; t.ldt = 2048; }
    else { r -= 2 * I_G; const int e = r >> 8, rr = r & 255, kb = rr >> 5, nb = rr & 31;
        t.src = a.in[I_WDOWN] + (size_t)e * 512 * 2048 + (size_t)(64 * kb + kr) * 2048 + 64 * nb + n4; t.ldw = 2048;
        t.dst = (bf16*)(ws + WS_WD) + (size_t)(e * 2048 + 64 * nb) * 512 + 64 * kb; t.ldt = 512; }
}
__device__ __forceinline__ void tt_lds_in(const f32x4 (&v)[16], LAS float* scr, int kr, int n4) {
#pragma unroll
    for (int i = 0; i < 16; ++i) { LAS float* d = scr + (4 * i + kr) * 65 + n4; d[0] = v[i][0]; d[1] = v[i][1]; d[2] = v[i][2]; d[3] = v[i][3]; }
    LDS_WAIT();
}
__device__ __forceinline__ void tt_lds_out(const TTItem& t, const LAS float* scr, int lane) {
    const int c = lane & 7;
#pragma unroll
    for (int j = 0; j < 8; ++j) { const int nn = 8 * j + (lane >> 3); const LAS float* s = scr + (8 * c) * 65 + nn;
        u32x4 o; o.x = cvt_pk_bf16(s[0 * 65], s[1 * 65]); o.y = cvt_pk_bf16(s[2 * 65], s[3 * 65]); o.z = cvt_pk_bf16(s[4 * 65], s[5 * 65]); o.w = cvt_pk_bf16(s[6 * 65], s[7 * 65]);
        *(u32x4*)(t.dst + (size_t)nn * t.ldt + 8 * c) = o; }
    LDS_WAIT();
}
__device__ __forceinline__ void tt_load(f32x4 (&v)[16], const TTItem& t) {
#pragma unroll
    for (int i = 0; i < 16; ++i) v[i] = *(const f32x4*)(t.src + (size_t)(4 * i) * t.ldw);
}
__device__ __forceinline__ void moe_convert(const Args& a, LAS unsigned char* lds) {
    const int tid = threadIdx.x, lane = tid & 63, wave = __builtin_amdgcn_readfirstlane(tid >> 6);
    LAS float* scr = (LAS float*)(lds + wave * 16640);
    unsigned* q = (unsigned*)(a.ws + WS_CTL) + CW_Q;
    constexpr int NIT = 3 * 64 * 256, CH = 8;
    const int kr = lane >> 4, n4 = (lane & 15) * 4;
    f32x4 v[16]; TTItem cur, nxt;
    for (;;) {
        unsigned base = 0u;
        if (lane == 0) base = __hip_atomic_fetch_add(q, (unsigned)CH, __ATOMIC_RELAXED, __HIP_MEMORY_SCOPE_AGENT);
        const int i0 = (int)__builtin_amdgcn_readfirstlane(base);
        if (i0 >= NIT) break;
        moe_item(a, i0, lane, cur); tt_load(v, cur);
#pragma unroll 1
        for (int k = 0; k < CH; ++k) {
            tt_lds_in(v, scr, kr, n4);
            if (k + 1 < CH) { moe_item(a, i0 + k + 1, lane, nxt); tt_load(v, nxt); }
            tt_lds_out(cur, scr, lane);
            cur = nxt;
        }
    }
}

template <bool FROM_PART>
__device__ __forceinline__ void norm_mod_phase(const Args& a, LAS unsigned char* lds, const float* xin, const float* gvec, int sh_chunk, int sc_chunk, bf16* outp) {
    const int tid = threadIdx.x, lane = tid & 63, wave = __builtin_amdgcn_readfirstlane(tid >> 6);
    LAS float* Av = (LAS float*)lds; LAS float* Bv = Av + 2048;
    const float* modp = (const float*)(a.ws + WS_MODP); const float* mod = (const float*)(a.ws + WS_MOD); const float* bada = a.in[I_BADA];
    int prev_b = -1;
    for (int rb = blockIdx.x; rb < M / 64; rb += gridDim.x) {
        const int b = rb >> 5;
        if (b != prev_b) {
            __syncthreads();
            for (int j = tid; j < 2048; j += 512) { float sh, sc;
                if (FROM_PART) { sh = bada[sh_chunk * 2048 + j]; sc = bada[sc_chunk * 2048 + j];
#pragma unroll
                    for (int kq = 0; kq < 4; ++kq) { sh += modp[((size_t)kq * 8 + b) * 12288 + sh_chunk * 2048 + j]; sc += modp[((size_t)kq * 8 + b) * 12288 + sc_chunk * 2048 + j]; } }
                else { sh = mod[b * 12288 + sh_chunk * 2048 + j]; sc = mod[b * 12288 + sc_chunk * 2048 + j]; }
                Av[j] = gvec[j] * (1.f + sc); Bv[j] = sh; }
            __syncthreads(); prev_b = b;
        }
        for (int rr = wave; rr < 64; rr += 2 * NWAVES) {
            const int row0 = rb * 64 + rr, row1 = row0 + NWAVES;
            const f32x4* xr0 = (const f32x4*)(xin + (size_t)row0 * D) + lane; const f32x4* xr1 = (const f32x4*)(xin + (size_t)row1 * D) + lane;
            f32x4 v0[8], v1[8]; float s0 = 0.f, s1 = 0.f;
#pragma unroll
            for (int j = 0; j < 8; ++j) { v0[j] = xr0[64 * j]; v1[j] = xr1[64 * j]; }
#pragma unroll
            for (int j = 0; j < 8; ++j) { s0 += (v0[j][0] * v0[j][0] + v0[j][1] * v0[j][1]) + (v0[j][2] * v0[j][2] + v0[j][3] * v0[j][3]); s1 += (v1[j][0] * v1[j][0] + v1[j][1] * v1[j][1]) + (v1[j][2] * v1[j][2] + v1[j][3] * v1[j][3]); }
#pragma unroll
            for (int o = 1; o < 64; o <<= 1) { s0 += __shfl_xor(s0, o); s1 += __shfl_xor(s1, o); }
            const float r0 = rsqrtf(s0 * (1.f / 2048.f) + EPS), r1 = rsqrtf(s1 * (1.f / 2048.f) + EPS);
            u32x2* o0 = (u32x2*)(outp + (size_t)row0 * D) + lane; u32x2* o1 = (u32x2*)(outp + (size_t)row1 * D) + lane;
#pragma unroll
            for (int j = 0; j < 8; ++j) { const int col = 4 * lane + 256 * j; const f32x4 A4 = *(const LAS f32x4*)(Av + col), B4 = *(const LAS f32x4*)(Bv + col);
                const f32x4 y0 = v0[j] * r0 * A4 + B4, y1 = v1[j] * r1 * A4 + B4; u32x2 w0, w1; w0.x = cvt_pk_bf16(y0[0], y0[1]); w0.y = cvt_pk_bf16(y0[2], y0[3]); w1.x = cvt_pk_bf16(y1[0], y1[1]); w1.y = cvt_pk_bf16(y1[2], y1[3]);
                o0[64 * j] = w0; o1[64 * j] = w1; }
        }
    }
    if (FROM_PART) {
        { const float* bp = (const float*)(a.ws + WS_BIAS1P);
          for (int o = blockIdx.x * NWAVES + wave; o < 512; o += gridDim.x * NWAVES) { const int ten = o >> 8, n = o & 255;
              const float sb = wave_sum(bp[(size_t)(ten * 64 + lane) * 256 + n]);
              if (lane == 0) ((float*)(a.ws + (ten ? WS_BIAS1V : WS_BIAS1K)))[n] = sb; } }
        float* modw = (float*)(a.ws + WS_MOD);
        for (int idx = blockIdx.x * 512 + tid; idx < 8 * 12288; idx += gridDim.x * 512) { const int b = idx / 12288, j = idx % 12288; float s = bada[j];
#pragma unroll
            for (int kq = 0; kq < 4; ++kq) s += modp[((size_t)kq * 8 + b) * 12288 + j];
            modw[idx] = s; }
    }
}

__device__ __forceinline__ void transpose_out(const LAS unsigned short* tl, int pitch, int C, bf16* dst, size_t ldT, int tid) {
    for (int idx = tid; idx < C * 8; idx += 512) { const int cc = idx >> 3, tc = (idx & 7) * 8;
        unsigned e[8];
#pragma unroll
        for (int i = 0; i < 8; ++i) e[i] = tl[(tc + i) * pitch + cc];
        u32x4 o; o.x = e[0] | (e[1] << 16); o.y = e[2] | (e[3] << 16); o.z = e[4] | (e[5] << 16); o.w = e[6] | (e[7] << 16);
        *(u32x4*)(dst + (size_t)cc * ldT + tc) = o; }
}
__device__ __forceinline__ void rot8(const u32x4 x1, const u32x4 x2, const float* cosT, const float* sinT, int t, int jc, float (&o1)[8], float (&o2)[8]) {
    const f32x4 c0 = *(const f32x4*)(cosT + t * 128 + jc), c1 = *(const f32x4*)(cosT + t * 128 + jc + 4), s0 = *(const f32x4*)(sinT + t * 128 + jc), s1 = *(const f32x4*)(sinT + t * 128 + jc + 4);
    const float a1[8] = {bflo(x1.x), bfhi(x1.x), bflo(x1.y), bfhi(x1.y), bflo(x1.z), bfhi(x1.z), bflo(x1.w), bfhi(x1.w)};
    const float a2[8] = {bflo(x2.x), bfhi(x2.x), bflo(x2.y), bfhi(x2.y), bflo(x2.z), bfhi(x2.z), bflo(x2.w), bfhi(x2.w)};
    const float cs[8] = {c0[0], c0[1], c0[2], c0[3], c1[0], c1[1], c1[2], c1[3]}, sn[8] = {s0[0], s0[1], s0[2], s0[3], s1[0], s1[1], s1[2], s1[3]};
#pragma unroll
    for (int i = 0; i < 8; ++i) { o1[i] = a1[i] * cs[i] - a2[i] * sn[i]; o2[i] = a1[i] * sn[i] + a2[i] * cs[i]; }
}
__device__ __forceinline__ u32x4 pack8f(const float (&o)[8], float sc) { u32x4 w; w.x = cvt_pk_bf16(o[0] * sc, o[1] * sc); w.y = cvt_pk_bf16(o[2] * sc, o[3] * sc); w.z = cvt_pk_bf16(o[4] * sc, o[5] * sc); w.w = cvt_pk_bf16(o[6] * sc, o[7] * sc); return w; }

template <class DR>
__device__ __forceinline__ void transpose_out_w(const LAS unsigned short* tl, bf16* dst, size_t ldT, int lane, DR drow) {
#pragma unroll
    for (int i = 0; i < 8; ++i) { const int idx = lane + 64 * i, cc = idx >> 3, tc = (idx & 7) * 8;
        unsigned e[8];
#pragma unroll
        for (int k = 0; k < 8; ++k) e[k] = tl[(tc + k) * 66 + cc];
        u32x4 o; o.x = e[0] | (e[1] << 16); o.y = e[2] | (e[3] << 16); o.z = e[4] | (e[5] << 16); o.w = e[6] | (e[7] << 16);
        *(u32x4*)(dst + (size_t)drow(cc) * ldT + tc) = o; }
}
__device__ __forceinline__ void lds_put8(LAS unsigned short* p, const u32x4 v) { LAS unsigned* d = (LAS unsigned*)p; d[0] = v.x; d[1] = v.y; d[2] = v.z; d[3] = v.w; }

__device__ __forceinline__ void phase3(const Args& a, LAS unsigned char* lds) {
    const int tid = threadIdx.x, lane = tid & 63, wave = __builtin_amdgcn_readfirstlane(tid >> 6);
    unsigned char* ws = a.ws;
    const bf16* proj = (const bf16*)(ws + WS_PROJ);
    const float* cosT = (const float*)(ws + WS_COS); const float* sinT = (const float*)(ws + WS_SIN);
    LAS unsigned short* tl = (LAS unsigned short*)(lds + wave * 16640);
    const int gw = blockIdx.x * NWAVES + wave, NGW = gridDim.x * NWAVES;
    for (int wi = gw; wi < NB * 32 * 64; wi += NGW) {
        const int tile = wi >> 6, sub = wi & 63, b = tile >> 5, t0 = (tile & 31) * 64;
        const bf16* pr = proj + (size_t)(b * T + t0) * NP;
        if (sub < 32) {
            const bool isk = sub < 16; const int h = (sub >> 2) & 3, jg = sub & 3;
            const float zl = ret_lg(h);
            bf16* dstrow = (bf16*)(ws + (isk ? WS_KR : WS_QR)) + ((size_t)(b * 4 + h) * T + t0) * 256;
#pragma unroll
            for (int i = 0; i < 4; ++i) { const int idx = lane + 64 * i, tk = idx >> 2, jc = jg * 32 + (idx & 3) * 8, t = t0 + tk;
                const bf16* p = pr + (size_t)tk * NP + (isk ? C_RK : C_RQ) + h * 256 + jc;
                float o1[8], o2[8];
                rot8(*(const u32x4*)p, *(const u32x4*)(p + 128), cosT, sinT, t, jc, o1, o2);
                const float sc = isk ? 0.0625f : 1.f;
                bf16* d = dstrow + (size_t)tk * 256 + jc;
                *(u32x4*)d = pack8f(o1, sc); *(u32x4*)(d + 128) = pack8f(o2, sc);
                if (isk) { const float zs = 0.0625f * __expf(zl * (float)(127 - (t & 127)));
                    lds_put8(tl + tk * 66 + (idx & 3) * 8, pack8f(o1, zs)); lds_put8(tl + tk * 66 + 32 + (idx & 3) * 8, pack8f(o2, zs)); } }
            if (isk) { LDS_WAIT();
                transpose_out_w(tl, (bf16*)(ws + WS_KZT) + ((size_t)(b * 4 + h) * 256) * T + t0, T, lane, [=](int cc) { return cc < 32 ? jg * 32 + cc : 128 + jg * 32 + (cc - 32); });
                LDS_WAIT(); }
        } else if (sub < 48 || sub >= 56) {
            int scol; bf16* dst;
            if (sub < 48) { const int h = (sub >> 2) & 3, cg = sub & 3; scol = C_RV + h * 256 + cg * 64; dst = (bf16*)(ws + WS_VT) + ((size_t)(b * 4 + h) * 256 + cg * 64) * T + t0; }
            else { const int g = (sub >> 2) & 1, sel = (sub >> 1) & 1, cg = sub & 1; scol = (sel ? C_VW : C_VS) + g * 128 + cg * 64; dst = (bf16*)(ws + (sel ? WS_VWT : WS_VST)) + ((size_t)(b * 2 + g) * 128 + cg * 64) * T + t0; }
#pragma unroll
            for (int i = 0; i < 8; ++i) { const int idx = lane + 64 * i, tk = idx >> 3, dc = (idx & 7) * 8;
                lds_put8(tl + tk * 66 + dc, *(const u32x4*)(pr + (size_t)tk * NP + scol + dc)); }
            LDS_WAIT();
            transpose_out_w(tl, dst, T, lane, [](int cc) { return cc; });
            LDS_WAIT();
        } else {
            const int g = (sub >> 2) & 1, ten = (sub >> 1) & 1, cg = sub & 1;
            bf16* dst = (bf16*)(ws + (ten ? WS_VCMP : WS_KCMP)) + ((size_t)(b * 2 + g) * T + t0) * 128 + cg * 64;
#pragma unroll
            for (int i = 0; i < 8; ++i) { const int idx = lane + 64 * i, tk = idx >> 3, dc = (idx & 7) * 8;
                *(u32x4*)(dst + (size_t)tk * 128 + dc) = *(const u32x4*)(pr + (size_t)tk * NP + (ten ? C_VC : C_KC) + g * 128 + cg * 64 + dc); }
        }
    }
}

__device__ __forceinline__ void phase4(const Args& a, LAS unsigned char* lds) {
    const int tid = threadIdx.x, lane = tid & 63, wave = __builtin_amdgcn_readfirstlane(tid >> 6), q = lane >> 4, r = lane & 15;
    unsigned char* ws = a.ws;
    {
        const bf16* VT = (const bf16*)(ws + WS_VT); const bf16* KzT = (const bf16*)(ws + WS_KZT); bf16* SP = (bf16*)(ws + WS_SP);
        for (int it = blockIdx.x; it < 256; it += gridDim.x) {
            const int b = it >> 5, h = (it >> 3) & 3, es = it & 7;
            const float cd = __expf(ret_lg(h) * 128.f);
            const bf16* VTb = VT + ((size_t)(b * 4 + h) * 256 + es * 32) * T;
            const bf16* KzTb = KzT + ((size_t)(b * 4 + h) * 256 + wave * 32) * T;
            bf16* Sp = SP + (size_t)(b * 4 + h) * 16 * 65536;
            f32x4 S[2][2];
#pragma unroll
            for (int mt = 0; mt < 2; ++mt)
#pragma unroll
                for (int nt = 0; nt < 2; ++nt) S[mt][nt] = (f32x4){0.f, 0.f, 0.f, 0.f};
            for (int n = 0; n < 16; ++n) {
#pragma unroll
                for (int mt = 0; mt < 2; ++mt)
#pragma unroll
                    for (int nt = 0; nt < 2; ++nt) { const int e = es * 32 + 16 * mt + r, d = wave * 32 + 16 * nt + 4 * q;
                        u32x2 w; w.x = cvt_pk_bf16(S[mt][nt][0], S[mt][nt][1]); w.y = cvt_pk_bf16(S[mt][nt][2], S[mt][nt][3]);
                        *(u32x2*)(Sp + ((size_t)n * 256 + e) * 256 + d) = w; }
                if (n == 15) break;
#pragma unroll
                for (int mt = 0; mt < 2; ++mt)
#pragma unroll
                    for (int nt = 0; nt < 2; ++nt) S[mt][nt] = S[mt][nt] * cd;
#pragma unroll
                for (int k0 = 0; k0 < 128; k0 += 32) {
                    bf16x8 af[2], bfr[2];
#pragma unroll
                    for (int mt = 0; mt < 2; ++mt) af[mt] = *(const bf16x8*)(VTb + (size_t)(16 * mt + r) * T + n * 128 + k0 + 8 * q);
#pragma unroll
                    for (int nt = 0; nt < 2; ++nt) bfr[nt] = *(const bf16x8*)(KzTb + (size_t)(16 * nt + r) * T + n * 128 + k0 + 8 * q);
#pragma unroll
                    for (int mt = 0; mt < 2; ++mt)
#pragma unroll
                        for (int nt = 0; nt < 2; ++nt) S[mt][nt] = MFMA16(bfr[nt], af[mt], S[mt][nt]);
                }
            }
        }
    }
    {
        const int gw = blockIdx.x * NWAVES + wave, NGW = gridDim.x * NWAVES;
        for (int wi = gw; wi < 2048; wi += NGW) { const int ten = wi >> 10, rt = (wi >> 4) & 63, ct = wi & 15;
            const bf16* A = (const bf16*)(ws + (ten ? WS_VCMP : WS_KCMP)) + (size_t)(rt * 32) * 2048;
            const bf16* Bt = (const bf16*)(ws + (ten ? WS_W1V : WS_W1K)) + (size_t)(ct * 32) * 2048;
            f32x4 acc[2][2];
#pragma unroll
            for (int mt = 0; mt < 2; ++mt)
#pragma unroll
                for (int nt = 0; nt < 2; ++nt) acc[mt][nt] = (f32x4){0.f, 0.f, 0.f, 0.f};
#pragma unroll 2
            for (int k0 = 0; k0 < 2048; k0 += 32) {
                bf16x8 af[2], bfr[2];
#pragma unroll
                for (int mt = 0; mt < 2; ++mt) af[mt] = *(const bf16x8*)(A + (size_t)(16 * mt + r) * 2048 + k0 + 8 * q);
#pragma unroll
                for (int nt = 0; nt < 2; ++nt) bfr[nt] = *(const bf16x8*)(Bt + (size_t)(16 * nt + r) * 2048 + k0 + 8 * q);
#pragma unroll
                for (int mt = 0; mt < 2; ++mt)
#pragma unroll
                    for (int nt = 0; nt < 2; ++nt) acc[mt][nt] = MFMA16(bfr[nt], af[mt], acc[mt][nt]);
            }
            float* Y = (float*)(ws + (ten ? WS_YV : WS_YK));
#pragma unroll
            for (int mt = 0; mt < 2; ++mt)
#pragma unroll
                for (int nt = 0; nt < 2; ++nt) *(f32x4*)(Y + (size_t)(rt * 32 + 16 * mt + r) * 512 + ct * 32 + 16 * nt + 4 * q) = acc[mt][nt];
        }
    }
}

__device__ __forceinline__ void phase5(const Args& a, LAS unsigned char* lds) {
    const int tid = threadIdx.x, lane = tid & 63, wave = __builtin_amdgcn_readfirstlane(tid >> 6), q = lane >> 4, r = lane & 15;
    unsigned char* ws = a.ws;
    const int gw = blockIdx.x * NWAVES + wave, NGW = gridDim.x * NWAVES;
    for (int wi = gw; wi < 256; wi += NGW) { const int ten = wi >> 7, rt = wi & 127, row = rt * 16 + r, c = row & 127;
        const float* Y = (const float*)(ws + (ten ? WS_YV : WS_YK)); const float* bias = (const float*)(ws + (ten ? WS_BIAS1V : WS_BIAS1K));
        const bf16* W2T = (const bf16*)(ws + (ten ? WS_W2VT : WS_W2KT));
        f32x4 acc[8];
#pragma unroll
        for (int nt = 0; nt < 8; ++nt) acc[nt] = (f32x4){0.f, 0.f, 0.f, 0.f};
#pragma unroll
        for (int k0 = 0; k0 < 256; k0 += 32) { const int kk = k0 + 8 * q;
            bf16x8 af = (bf16x8){0, 0, 0, 0, 0, 0, 0, 0};
            if (c < 127) {
                const f32x4 y0 = *(const f32x4*)(Y + (size_t)row * 512 + kk), y1 = *(const f32x4*)(Y + (size_t)row * 512 + kk + 4);
                const f32x4 z0 = *(const f32x4*)(Y + (size_t)(row + 1) * 512 + 256 + kk), z1 = *(const f32x4*)(Y + (size_t)(row + 1) * 512 + 256 + kk + 4);
                const f32x4 b0 = *(const f32x4*)(bias + kk), b1 = *(const f32x4*)(bias + kk + 4);
                f32x4 h0 = y0 + z0 + b0, h1 = y1 + z1 + b1;
#pragma unroll
                for (int i = 0; i < 4; ++i) { h0[i] = silu_f(h0[i]); h1[i] = silu_f(h1[i]); }
                af = pack8(h0, h1);
            }
#pragma unroll
            for (int nt = 0; nt < 8; ++nt) { const bf16x8 bfr = *(const bf16x8*)(W2T + (size_t)(16 * nt + r) * 256 + kk); acc[nt] = MFMA16(bfr, af, acc[nt]); }
        }
        if (!ten) { bf16* kc = (bf16*)(ws + WS_KC);
#pragma unroll
            for (int nt = 0; nt < 8; ++nt) { u32x2 w; w.x = cvt_pk_bf16(acc[nt][0], acc[nt][1]); w.y = cvt_pk_bf16(acc[nt][2], acc[nt][3]); *(u32x2*)(kc + (size_t)row * 128 + 16 * nt + 4 * q) = w; }
        } else { bf16* vct = (bf16*)(ws + WS_VCT);
#pragma unroll
            for (int nt = 0; nt < 8; ++nt)
#pragma unroll
                for (int j = 0; j < 4; ++j) vct[((size_t)(row >> 7) * 128 + 16 * nt + 4 * q + j) * 128 + c] = (bf16)(cvt_pk_bf16(acc[nt][j], 0.f) & 0xffffu);
        }
    }
}

__device__ __forceinline__ void r2_item(const Args& a, int it) {
    int tid = threadIdx.x; asm volatile("" : "+v"(tid));
    const int lane = tid & 63, wave = __builtin_amdgcn_readfirstlane(tid >> 6), q = lane >> 4, r = lane & 15;
    unsigned char* ws = a.ws;
    const int b = it >> 6, h = (it >> 4) & 3, n = it & 15;
    const float lg = ret_lg(h);
    const int ti = 16 * wave + r;
    const bf16* Qrow = (const bf16*)(ws + WS_QR) + ((size_t)(b * 4 + h) * T + n * 128 + ti) * 256;
    const bf16* Kb = (const bf16*)(ws + WS_KR) + ((size_t)(b * 4 + h) * T + n * 128) * 256;
    const bf16* VTb = (const bf16*)(ws + WS_VT) + ((size_t)(b * 4 + h) * 256) * T + n * 128;
    const bf16* Sp = (const bf16*)(ws + WS_SP) + ((size_t)(b * 4 + h) * 16 + n) * 65536;
    f32x4 s[8];
#pragma unroll
    for (int nt = 0; nt < 8; ++nt) s[nt] = (f32x4){0.f, 0.f, 0.f, 0.f};
#pragma unroll 2
    for (int k0 = 0; k0 < 256; k0 += 32) { const bf16x8 af = *(const bf16x8*)(Qrow + k0 + 8 * q);
#pragma unroll
        for (int nt = 0; nt < 8; ++nt) { const bf16x8 bfr = *(const bf16x8*)(Kb + (size_t)(16 * nt + r) * 256 + k0 + 8 * q); s[nt] = MFMA16(bfr, af, s[nt]); } }
    bf16x8 pf[4];
#pragma unroll
    for (int nt = 0; nt < 8; ++nt)
#pragma unroll
        for (int j = 0; j < 4; ++j) { const int dd = ti - (16 * nt + 4 * q + j); s[nt][j] = dd >= 0 ? s[nt][j] * __expf(lg * (float)dd) : 0.f; }
#pragma unroll
    for (int ks = 0; ks < 4; ++ks) pf[ks] = pack8(s[2 * ks], s[2 * ks + 1]);
    f32x4 o[16];
#pragma unroll
    for (int nt = 0; nt < 16; ++nt) o[nt] = (f32x4){0.f, 0.f, 0.f, 0.f};
#pragma unroll 2
    for (int k0 = 0; k0 < 256; k0 += 32) { const bf16x8 af = *(const bf16x8*)(Qrow + k0 + 8 * q);
#pragma unroll
        for (int nt = 0; nt < 16; ++nt) { const bf16x8 bfr = *(const bf16x8*)(Sp + (size_t)(16 * nt + r) * 256 + k0 + 8 * q); o[nt] = MFMA16(bfr, af, o[nt]); } }
    const float qd = __expf(lg * (float)(ti + 1));
#pragma unroll
    for (int nt = 0; nt < 16; ++nt) o[nt] = o[nt] * qd;
#pragma unroll
    for (int ks = 0; ks < 4; ++ks)
#pragma unroll
        for (int nt = 0; nt < 16; ++nt) { const bf16* vp = VTb + (size_t)(16 * nt + r) * T + 32 * ks + 4 * q;
            const bf16x8 vf = cat4(*(const bf16x4*)vp, *(const bf16x4*)(vp + 16)); o[nt] = MFMA16(vf, pf[ks], o[nt]); }
    float sm = 0.f;
#pragma unroll
    for (int nt = 0; nt < 16; ++nt) sm += (o[nt][0] + o[nt][1]) + (o[nt][2] + o[nt][3]);
    sm += __shfl_xor(sm, 16); sm += __shfl_xor(sm, 32);
    const float mu = sm * (1.f / 256.f); float vs = 0.f;
#pragma unroll
    for (int nt = 0; nt < 16; ++nt) { const f32x4 d = o[nt] - mu; vs += (d[0] * d[0] + d[1] * d[1]) + (d[2] * d[2] + d[3] * d[3]); }
    vs += __shfl_xor(vs, 16); vs += __shfl_xor(vs, 32);
    const float rstd = rsqrtf(vs * (1.f / 256.f) + EPS);
    const size_t rowg = (size_t)b * T + n * 128 + ti;
    const bf16* gp = (const bf16*)(ws + WS_PROJ) + rowg * NP + C_RG + h * 256;
    const float* gn = a.in[I_GNG] + h * 256;
    bf16* op = (bf16*)(ws + WS_CAT) + rowg * 2048 + h * 256;
#pragma unroll
    for (int nt = 0; nt < 16; ++nt) { const int e = 16 * nt + 4 * q;
        const u32x2 gw2 = *(const u32x2*)(gp + e); const f32x4 g4 = *(const f32x4*)(gn + e);
        const float g0 = bflo(gw2.x), g1 = bfhi(gw2.x), g2 = bflo(gw2.y), g3 = bfhi(gw2.y);
        const float y0 = (o[nt][0] - mu) * rstd * g4[0] * silu_f(g0), y1 = (o[nt][1] - mu) * rstd * g4[1] * silu_f(g1);
        const float y2 = (o[nt][2] - mu) * rstd * g4[2] * silu_f(g2), y3 = (o[nt][3] - mu) * rstd * g4[3] * silu_f(g3);
        u32x2 w; w.x = cvt_pk_bf16(y0, y1); w.y = cvt_pk_bf16(y2, y3); *(u32x2*)(op + e) = w; }
}

constexpr float NSA_SCL = 0.08838834764831845f * 1.4426950408889634f;
constexpr int QP = 272, KP = 272, VP = 136, VCP = 264;
#ifndef NSA_NBR
#define NSA_NBR 2
#endif
constexpr int NSA_QS = 0, NSA_KS = 69632, NSA_VS = NSA_KS + 34816;

template <int S> __device__ __forceinline__ bf16x8 pack_step(const f32x16& x) {
    u32x4 p; p.x = cvt_pk_bf16(x[8 * S], x[8 * S + 1]); p.y = cvt_pk_bf16(x[8 * S + 2], x[8 * S + 3]); p.z = cvt_pk_bf16(x[8 * S + 4], x[8 * S + 5]); p.w = cvt_pk_bf16(x[8 * S + 6], x[8 * S + 7]);
    return __builtin_bit_cast(bf16x8, p);
}
__device__ __forceinline__ f32x16 zero16() { f32x16 z;
#pragma unroll
    for (int i = 0; i < 16; ++i) z[i] = 0.f;
    return z; }

__device__ __forceinline__ void attn_tile(const LAS unsigned char* qrow, const LAS unsigned char* Ks, const LAS unsigned char* Vs, int r, int h, float& m, float& l, f32x16 (&O)[4], int lo, int hi) {
    f32x16 st[2]; st[0] = zero16(); st[1] = zero16();
#pragma unroll
    for (int ks = 0; ks < 8; ++ks) { const bf16x8 qf = *(const LAS bf16x8*)(qrow + (16 * ks + 8 * h) * 2);
#pragma unroll
        for (int kb = 0; kb < 2; ++kb) { const bf16x8 kf = *(const LAS bf16x8*)(Ks + (32 * kb + r) * KP + (16 * ks + 8 * h) * 2); st[kb] = MFMA32(kf, qf, st[kb]); }
        if (ks & 1) asm volatile("" ::: "memory"); }
    float tmax = -1e30f;
#pragma unroll
    for (int kb = 0; kb < 2; ++kb)
#pragma unroll
        for (int reg = 0; reg < 16; ++reg) { constexpr int dummy = 0; (void)dummy; const int KC = 32 * kb + (reg & 3) + 8 * (reg >> 2); const float v = (KC > lo && KC <= hi) ? st[kb][reg] * NSA_SCL : -1e30f; st[kb][reg] = v; tmax = fmaxf(tmax, v); }
    tmax = fmaxf(tmax, __shfl_xor(tmax, 32));
    const float mn = fmaxf(m, tmax), alpha = __builtin_amdgcn_exp2f(m - mn);
    float rs = 0.f;
#pragma unroll
    for (int kb = 0; kb < 2; ++kb)
#pragma unroll
        for (int reg = 0; reg < 16; ++reg) { const float v = st[kb][reg]; const float p = v > -1e29f ? __builtin_amdgcn_exp2f(v - mn) : 0.f; st[kb][reg] = p; rs += p; }
    rs += __shfl_xor(rs, 32);
    l = l * alpha + rs; m = mn;
#pragma unroll
    for (int eb = 0; eb < 4; ++eb) O[eb] = O[eb] * alpha;
#pragma unroll
    for (int kb = 0; kb < 2; ++kb) {
        { const bf16x8 pf = pack_step<0>(st[kb]);
#pragma unroll
          for (int eb = 0; eb < 4; ++eb) { const LAS unsigned char* vp = Vs + (32 * eb + r) * VP + (32 * kb + 4 * h) * 2; const bf16x8 vf = cat4(*(const LAS bf16x4*)vp, *(const LAS bf16x4*)(vp + 16)); O[eb] = MFMA32(vf, pf, O[eb]); } }
        asm volatile("" ::: "memory");
        { const bf16x8 pf = pack_step<1>(st[kb]);
#pragma unroll
          for (int eb = 0; eb < 4; ++eb) { const LAS unsigned char* vp = Vs + (32 * eb + r) * VP + (32 * kb + 16 + 4 * h) * 2; const bf16x8 vf = cat4(*(const LAS bf16x4*)vp, *(const LAS bf16x4*)(vp + 16)); O[eb] = MFMA32(vf, pf, O[eb]); } }
        asm volatile("" ::: "memory");
    }
}

__device__ __forceinline__ void nsa_item(const Args& a, LAS unsigned char* lds, int item) {
    int tid = threadIdx.x; asm volatile("" : "+v"(tid));
    const int lane = tid & 63, w = __builtin_amdgcn_readfirstlane(tid >> 6), h = lane >> 5, r = lane & 31;
    unsigned char* ws = a.ws;
    const int bg = item & 15, qk = item >> 4, qt = qk < 16 ? 31 - qk : qk - 16, b = bg >> 1, g = bg & 1, t0 = qt * 64, cur = qt;
    const bf16* proj = (const bf16*)(ws + WS_PROJ);
    LAS unsigned char* Qs = lds + NSA_QS; LAS unsigned char* Ks = lds + NSA_KS; LAS unsigned char* Vs = lds + NSA_VS;
    LAS unsigned* bmask = (LAS unsigned*)(lds + MISC_OFF + 64);
    const int tok = t0 + 8 * w + (r >> 2), head = r & 3;
    const LAS unsigned char* qrow = Qs + (32 * w + r) * QP;
    __syncthreads();
    if (tid == 0) *bmask = 0u;
    for (int ch = tid; ch < 4096; ch += 512) { const int row = ch >> 4, dc = (ch & 15) * 8;
        *(LAS u32x4*)(Qs + row * QP + dc * 2) = *(const u32x4*)(proj + (size_t)(b * T + t0 + (row >> 2)) * NP + C_NQ + (g * 4 + (row & 3)) * 128 + dc); }
    { const bf16* kc = (const bf16*)(ws + WS_KC) + (size_t)bg * 16384; const bf16* vct = (const bf16*)(ws + WS_VCT) + (size_t)bg * 16384;
      for (int ch = tid; ch < 2048; ch += 512) { const int row = ch >> 4, dc = (ch & 15) * 8;
          *(LAS u32x4*)(Ks + row * KP + dc * 2) = *(const u32x4*)(kc + row * 128 + dc);
          const u32x4 v = *(const u32x4*)(vct + row * 128 + dc); LAS u32x2* d = (LAS u32x2*)(Vs + row * VCP + dc * 2); d[0] = (u32x2){v.x, v.y}; d[1] = (u32x2){v.z, v.w}; } }
    __syncthreads();
    float gt0, gt1, gt2;
    { const bf16* gp = proj + (size_t)(b * T + tok) * NP + C_NG + (g * 4 + head) * 3; gt0 = sigmoid_f(bf2f(gp[0])); gt1 = sigmoid_f(bf2f(gp[1])); gt2 = sigmoid_f(bf2f(gp[2])); }
    unsigned selmask;
    bf16* op = (bf16*)(ws + WS_CAT) + (size_t)(b * T + tok) * 2048 + 1024 + (g * 4 + head) * 128;
    {
        f32x16 st[4]; f32x16 Ot[4];
#pragma unroll
        for (int kb = 0; kb < 4; ++kb) st[kb] = zero16();
#pragma unroll
        for (int ks = 0; ks < 8; ++ks) { const bf16x8 qf = *(const LAS bf16x8*)(qrow + (16 * ks + 8 * h) * 2);
#pragma unroll
            for (int kb = 0; kb < 4; ++kb) { const bf16x8 kf = *(const LAS bf16x8*)(Ks + (32 * kb + r) * KP + (16 * ks + 8 * h) * 2); st[kb] = MFMA32(kf, qf, st[kb]); }
            asm volatile("" ::: "memory"); }
        float mx = -1e30f;
        const int clim = (tok - 31) >> 4;
        const int climh = (clim < 126 ? clim : 126) - 4 * h;
#pragma unroll
        for (int kb = 0; kb < 4; ++kb)
#pragma unroll
            for (int reg = 0; reg < 16; ++reg) { const int KC = 32 * kb + (reg & 3) + 8 * (reg >> 2);
                const float v = (KC <= climh) ? st[kb][reg] * NSA_SCL : -1e30f; st[kb][reg] = v; mx = fmaxf(mx, v); }
        mx = fmaxf(mx, __shfl_xor(mx, 32));
        float sm = 0.f;
#pragma unroll
        for (int kb = 0; kb < 4; ++kb)
#pragma unroll
            for (int reg = 0; reg < 16; ++reg) { const float v = st[kb][reg]; const float p = v > -1e29f ? __builtin_amdgcn_exp2f(v - mx) : 0.f; st[kb][reg] = p; sm += p; }
        sm += __shfl_xor(sm, 32);
        const float inv = sm > 0.f ? 1.f / sm : 0.f;
#pragma unroll
        for (int kb = 0; kb < 4; ++kb) st[kb] = st[kb] * inv;
        float imp[16], lastv[16];
#pragma unroll
        for (int i = 0; i < 16; ++i) { const int kb = i >> 2, rq = i & 3; imp[i] = (st[kb][4 * rq] + st[kb][4 * rq + 1]) + (st[kb][4 * rq + 2] + st[kb][4 * rq + 3]); lastv[i] = __shfl_xor(st[kb][4 * rq + 3], 32); }
#pragma unroll
        for (int i = 0; i < 16; ++i) { const float prev = h ? lastv[i] : (i > 0 ? lastv[i > 0 ? i - 1 : 0] : 0.f); imp[i] += prev; }
#pragma unroll
        for (int i = 0; i < 16; ++i) { imp[i] += __shfl_xor(imp[i], 1); imp[i] += __shfl_xor(imp[i], 2); }
        float sc[16], so[16];
#pragma unroll
        for (int i = 0; i < 16; ++i) { const int s = 2 * i + h; const bool forced = (s == 0) || (s == cur) || (s == cur - 1); sc[i] = s <= cur ? imp[i] + (forced ? 1e4f : 0.f) : -1.f; }
#pragma unroll
        for (int i = 0; i < 16; ++i) so[i] = __shfl_xor(sc[i], 32);
        unsigned mine = 0u;
#pragma unroll
        for (int i = 0; i < 16; ++i) { int rank = 0;
#pragma unroll
            for (int i2 = 0; i2 < 16; ++i2) {
                rank += (sc[i2] > sc[i] || (sc[i2] == sc[i] && i2 < i)) ? 1 : 0;
                const bool lower = h ? (i2 <= i) : (i2 < i);
                rank += (so[i2] > sc[i] || (so[i2] == sc[i] && lower)) ? 1 : 0; }
            if (rank < 16 && (2 * i + h) <= cur) mine |= 1u << (2 * i + h); }
        selmask = mine | __shfl_xor(mine, 32);
        if ((lane & 35) == 0) __hip_atomic_fetch_or(bmask, selmask, __ATOMIC_RELAXED, __HIP_MEMORY_SCOPE_WORKGROUP);
#pragma unroll
        for (int eb = 0; eb < 4; ++eb) Ot[eb] = zero16();
#pragma unroll
        for (int kb = 0; kb < 4; ++kb) {
            { const bf16x8 pf = pack_step<0>(st[kb]);
#pragma unroll
              for (int eb = 0; eb < 4; ++eb) { const LAS unsigned char* vp = Vs + (32 * eb + r) * VCP + (32 * kb + 4 * h) * 2; const bf16x8 vf = cat4(*(const LAS bf16x4*)vp, *(const LAS bf16x4*)(vp + 16)); Ot[eb] = MFMA32(vf, pf, Ot[eb]); } }
            asm volatile("" ::: "memory");
            { const bf16x8 pf = pack_step<1>(st[kb]);
#pragma unroll
              for (int eb = 0; eb < 4; ++eb) { const LAS unsigned char* vp = Vs + (32 * eb + r) * VCP + (32 * kb + 16 + 4 * h) * 2; const bf16x8 vf = cat4(*(const LAS bf16x4*)vp, *(const LAS bf16x4*)(vp + 16)); Ot[eb] = MFMA32(vf, pf, Ot[eb]); } }
            asm volatile("" ::: "memory");
        }
#pragma unroll
        for (int eb = 0; eb < 4; ++eb)
#pragma unroll
            for (int rq = 0; rq < 4; ++rq) { u32x2 wv; wv.x = cvt_pk_bf16(Ot[eb][4 * rq] * gt0, Ot[eb][4 * rq + 1] * gt0); wv.y = cvt_pk_bf16(Ot[eb][4 * rq + 2] * gt0, Ot[eb][4 * rq + 3] * gt0);
                *(u32x2*)(op + 32 * eb + 8 * rq + 4 * h) = wv; }
    }
    __syncthreads();
    const unsigned blockmask = *bmask;
#pragma unroll 1
    for (int br = 0; br < NSA_NBR; ++br) {
        f32x16 O[4];
#pragma unroll
        for (int eb = 0; eb < 4; ++eb) O[eb] = zero16();
        float m = -1e30f, l = 0.f;
        const int kcol = (br ? C_KW : C_KS) + g * 128;
        const bf16* vT = (const bf16*)(ws + (br ? WS_VWT : WS_VST)) + (size_t)bg * 128 * T;
        const int jlo = br ? (cur > 8 ? cur - 8 : 0) : 0;
        unsigned todo = br ? ((cur >= 31 ? 0xffffffffu : ((2u << cur) - 1u)) & ~((1u << jlo) - 1u)) : blockmask;
        const bf16* kg = proj + (size_t)(b * T + (tid >> 4)) * NP + kcol + (tid & 15) * 8;
        const bf16* vg = vT + (size_t)(tid >> 3) * T + (tid & 7) * 8;
        LAS unsigned char* kd = Ks + (tid >> 4) * KP + (tid & 15) * 16; LAS unsigned char* vd = Vs + (tid >> 3) * VP + (tid & 7) * 16;
        u32x4 pk0, pk1, pv0, pv1;
#define NSA_LOAD(jj) do { const bf16* kp_ = kg + (size_t)(64 * (jj)) * NP; pk0 = *(const u32x4*)kp_; pk1 = *(const u32x4*)(kp_ + (size_t)32 * NP); \
                          const bf16* vp_ = vg + 64 * (jj); pv0 = *(const u32x4*)vp_; pv1 = *(const u32x4*)(vp_ + (size_t)64 * T); } while (0)
        if (todo) NSA_LOAD(__builtin_ctz(todo));
#pragma unroll 1
        while (todo) {
            const int j = __builtin_ctz(todo); todo &= todo - 1u;
            __syncthreads();
            *(LAS u32x4*)kd = pk0; *(LAS u32x4*)(kd + 32 * KP) = pk1;
            { LAS u32x2* d = (LAS u32x2*)vd; d[0] = (u32x2){pv0.x, pv0.y}; d[1] = (u32x2){pv0.z, pv0.w}; d = (LAS u32x2*)(vd + 64 * VP); d[0] = (u32x2){pv1.x, pv1.y}; d[1] = (u32x2){pv1.z, pv1.w}; }
            __syncthreads();
            if (todo) NSA_LOAD(__builtin_ctz(todo));
            const int kbase = 64 * j;
            if (!br) {
                const bool mysel = (selmask >> j) & 1u;
                if (__ballot(mysel) != 0ull) attn_tile(qrow, Ks, Vs, r, h, m, l, O, -1000000, mysel ? (tok - kbase - 4 * h) : -1000000);
            } else {
                attn_tile(qrow, Ks, Vs, r, h, m, l, O, tok - kbase - 4 * h - 512, tok - kbase - 4 * h);
            }
        }
#undef NSA_LOAD
        const float sc = (l > 0.f ? 1.f / l : 0.f) * (br ? gt2 : gt1);
        VM_WAIT();
#pragma unroll
        for (int eb = 0; eb < 4; ++eb)
#pragma unroll
            for (int rq = 0; rq < 4; ++rq) { u32x2* p = (u32x2*)(op + 32 * eb + 8 * rq + 4 * h); const u32x2 old = *p;
                u32x2 wv; wv.x = cvt_pk_bf16(bflo(old.x) + O[eb][4 * rq] * sc, bfhi(old.x) + O[eb][4 * rq + 1] * sc); wv.y = cvt_pk_bf16(bflo(old.y) + O[eb][4 * rq + 2] * sc, bfhi(old.y) + O[eb][4 * rq + 3] * sc);
                *p = wv; }
    }
}

#ifndef P6_REP_NSA
#define P6_REP_NSA 1
#endif
#ifndef P6_REP_R2
#define P6_REP_R2 1
#endif
__device__ __forceinline__ void phase6(const Args& a, LAS unsigned char* lds) {
    for (int it = blockIdx.x; it < 1024; it += gridDim.x) {
        if (it < 512) { for (int rep = 0; rep < P6_REP_NSA; ++rep) nsa_item(a, lds, it); }
        else { for (int rep = 0; rep < P6_REP_R2; ++rep) r2_item(a, it - 512); }
    }
}

__device__ __forceinline__ void phase9(const Args& a, LAS unsigned char* lds) {
    const int tid = threadIdx.x, lane = tid & 63, wave = __builtin_amdgcn_readfirstlane(tid >> 6), q = lane >> 4, r = lane & 15;
    unsigned char* ws = a.ws;
    const bf16* h2 = (const bf16*)(ws + WS_H); const bf16* wrt = (const bf16*)(ws + WS_WRT);
    const float* bgrp = a.in[I_BGRP]; const float* bexp = a.in[I_BEXP];
    unsigned* cnt = (unsigned*)(ws + WS_CTL) + CW_CNT; int* asg = (int*)(ws + WS_ASG); float* rw = (float*)(ws + WS_RW);
    LAS float* lg = (LAS float*)(lds + wave * 8192);
    const int gw = blockIdx.x * NWAVES + wave, NGW = gridDim.x * NWAVES;
    for (int wi = gw; wi < M / 16; wi += NGW) {
        const bf16* A = h2 + (size_t)(wi * 16 + r) * D;
        f32x4 acc[5];
#pragma unroll
        for (int nt = 0; nt < 5; ++nt) acc[nt] = (f32x4){0.f, 0.f, 0.f, 0.f};
#pragma unroll 2
        for (int k0 = 0; k0 < D; k0 += 32) { const bf16x8 af = *(const bf16x8*)(A + k0 + 8 * q);
#pragma unroll
            for (int nt = 0; nt < 5; ++nt) { const bf16x8 bfr = *(const bf16x8*)(wrt + (size_t)(16 * nt + r) * D + k0 + 8 * q); acc[nt] = MFMA16(bfr, af, acc[nt]); } }
#pragma unroll
        for (int nt = 0; nt < 5; ++nt) *(LAS f32x4*)(lg + r * 84 + 16 * nt + 4 * q) = acc[nt];
        LDS_WAIT();
        if (lane < 16) {
            const int tok = wi * 16 + lane; const LAS float* L = lg + lane * 84;
            float gl[8]; float gmax = -3.0e38f; int gi = 0;
#pragma unroll
            for (int i = 0; i < 8; ++i) { gl[i] = L[i] + bgrp[i]; if (gl[i] > gmax) { gmax = gl[i]; gi = i; } }
            float gs = 0.f;
#pragma unroll
            for (int i = 0; i < 8; ++i) gs += __expf(gl[i] - gmax);
            const float pg = 1.f / gs;
            float el[8]; float m1 = -3.0e38f; int i1 = 0;
#pragma unroll
            for (int i = 0; i < 8; ++i) { el[i] = L[8 + gi * 8 + i] + bexp[gi * 8 + i]; if (el[i] > m1) { m1 = el[i]; i1 = i; } }
            float m2 = -3.0e38f; int i2 = 0;
#pragma unroll
            for (int i = 0; i < 8; ++i) { if (i != i1 && el[i] > m2) { m2 = el[i]; i2 = i; } }
            const float e2 = __expf(m2 - m1); const float w1 = pg / (1.f + e2), w2 = pg * e2 / (1.f + e2);
            const int ea = gi * 8 + i1, eb = gi * 8 + i2;
            const unsigned pa = atomicAdd(cnt + ea, 1u); asg[(size_t)ea * CAP + pa] = tok * 2;     rw[(size_t)ea * CAP + pa] = w1;
            const unsigned pb = atomicAdd(cnt + eb, 1u); asg[(size_t)eb * CAP + pb] = tok * 2 + 1; rw[(size_t)eb * CAP + pb] = w2;
        }
        LDS_WAIT();
    }
}

constexpr int MOE_TAB_OFF = 131072;
__device__ __forceinline__ void moe_tables(const Args& a, LAS unsigned char* lds) {
    const int tid = threadIdx.x;
    LAS int* cntL = (LAS int*)(lds + MOE_TAB_OFF); LAS int* tst = cntL + 64;
    const unsigned* cnt = (const unsigned*)(a.ws + WS_CTL) + CW_CNT;
    __syncthreads();
    if (tid < 64) cntL[tid] = (int)__hip_atomic_load(cnt + tid, __ATOMIC_RELAXED, __HIP_MEMORY_SCOPE_AGENT);
    __syncthreads();
    if (tid == 0) { int ts = 0; for (int e = 0; e < 64; ++e) { tst[e] = ts; ts += (cntL[e] + 255) >> 8; } tst[64] = ts; }
    __syncthreads();
}
__device__ __forceinline__ void phase10(const Args& a, LAS unsigned char* lds) {
    const int tid = threadIdx.x;
    unsigned char* ws = a.ws;
    moe_tables(a, lds);
    const LAS int* cntL = (const LAS int*)(lds + MOE_TAB_OFF); const LAS int* tst = cntL + 64; LAS int* tab = (LAS int*)(lds + MOE_TAB_OFF + 1024);
    pg8::MoeOrder1 S; S.cntL = cntL; S.tst = tst; S.npn = 4; S.G = (int)gridDim.x; S.c = (int)blockIdx.x; S.tab = tab; S.Bt = (const bf16*)(ws + WS_WGU); S.K = D;
    { const int* asg = (const int*)(ws + WS_ASG); pg8::Unit u;
      for (int i = 0; i < 12 && S.next(i, u); ++i) if (tid < 256) { const int p = u.pm * 256 + tid; tab[i * 256 + tid] = p < cntL[u.e] ? (asg[(size_t)u.e * CAP + p] >> 1) : 0; } }
    __syncthreads();
    pg8::Gemm g{(const bf16*)(ws + WS_H), (const bf16*)(ws + WS_WGU), 0, 0, D};
    pg8::EpiMoe1 E{(bf16*)(ws + WS_A), cntL, tst};
    pg8::gemm_phase2<pg8::EpiMoe1, pg8::MoeOrder1, true>(lds, g, S, E);
}
__device__ __forceinline__ void phase11(const Args& a, LAS unsigned char* lds) {
    unsigned char* ws = a.ws;
    moe_tables(a, lds);
    const LAS int* cntL = (const LAS int*)(lds + MOE_TAB_OFF); const LAS int* tst = cntL + 64;
    pg8::MoeOrder2 S; S.cntL = cntL; S.tst = tst; S.npn = 8; S.G = (int)gridDim.x; S.c = (int)blockIdx.x; S.Bt = (const bf16*)(ws + WS_WD); S.K = DE;
    pg8::Gemm g{(const bf16*)(ws + WS_A), (const bf16*)(ws + WS_WD), 0, 0, DE};
    pg8::EpiMoe2 E{(bf16*)(ws + WS_Y), (const int*)(ws + WS_ASG), (const float*)(ws + WS_RW), cntL, CAP, D};
    pg8::gemm_phase2<pg8::EpiMoe2, pg8::MoeOrder2, true>(lds, g, S, E);
}

template <bool WITH_MOE>
__device__ __forceinline__ void phase12(const Args& a) {
    const int tid = threadIdx.x, lane = tid & 63, wave = __builtin_amdgcn_readfirstlane(tid >> 6);
    const float* mod = (const float*)(a.ws + WS_MOD); const bf16* ybuf = (const bf16*)(a.ws + WS_Y); const float* fg = a.in[I_FG];
    const int gw = blockIdx.x * NWAVES + wave, NGW = gridDim.x * NWAVES;
    for (int row = gw; row < M; row += NGW) {
        const int b = row >> 11;
        f32x4* xr = (f32x4*)(a.out + (size_t)row * D) + lane;
        const u32x2* y0 = (const u32x2*)(ybuf + (size_t)(2 * row) * D) + lane; const u32x2* y1 = (const u32x2*)(ybuf + (size_t)(2 * row + 1) * D) + lane;
        const f32x4* g2 = (const f32x4*)(mod + (size_t)b * 12288 + 5 * 2048) + lane;
        f32x4 v[8]; float ss = 0.f;
#pragma unroll
        for (int j = 0; j < 8; ++j) { v[j] = xr[64 * j];
            if (WITH_MOE) { const u32x2 p0 = y0[64 * j], p1 = y1[64 * j]; const f32x4 gg = g2[64 * j];
                v[j][0] += gg[0] * (bflo(p0.x) + bflo(p1.x)); v[j][1] += gg[1] * (bfhi(p0.x) + bfhi(p1.x)); v[j][2] += gg[2] * (bflo(p0.y) + bflo(p1.y)); v[j][3] += gg[3] * (bfhi(p0.y) + bfhi(p1.y)); }
            ss += (v[j][0] * v[j][0] + v[j][1] * v[j][1]) + (v[j][2] * v[j][2] + v[j][3] * v[j][3]); }
        const float rstd = rsqrtf(wave_sum(ss) * (1.f / 2048.f) + EPS);
#pragma unroll
        for (int j = 0; j < 8; ++j) { const f32x4 f4 = *((const f32x4*)fg + lane + 64 * j); xr[64 * j] = v[j] * rstd * f4; }
    }
}

constexpr int NPHASES = 13;
#ifndef MK_N_LAUNCHES
#define MK_N_LAUNCHES 1
#endif
__global__ void __launch_bounds__(NWAVES * 64, 2) fwd(Args a) {
    extern __shared__ __attribute__((aligned(16))) unsigned char lds_raw[];
    LAS unsigned char* lds = (LAS unsigned char*)lds_raw;
    const int tid = threadIdx.x;
    if (tid < 64) ((LAS unsigned*)(lds + MISC_OFF))[tid] = 0u;
    __syncthreads();
    XcdBarrier bar; bar.bar = (unsigned*)(a.ws + WS_CTL) + CW_BAR; bar.x = 0; bar.st = nullptr;
    if (a.ph_hi - a.ph_lo > 1) bar = xcd_barrier_post((unsigned*)(a.ws + WS_CTL) + CW_BAR, (volatile LAS unsigned*)(lds + MISC_OFF) + 8);
    unsigned char* ws = a.ws;
#ifndef ONLY_PHASE
#define ONLY_PHASE -1
#endif
#define IN(k) ((ONLY_PHASE < 0 || ONLY_PHASE == (k)) && a.ph_lo <= (k) && (k) < a.ph_hi)
#define SEAM(k) do { if (IN(k) && IN((k) + 1)) xcd_barrier(bar); } while (0)
#ifndef REP0
#define REP0 1
#endif
#ifndef REP3
#define REP3 1
#endif
#ifndef REP1
#define REP1 1
#endif
#ifndef REP2
#define REP2 1
#endif
#ifndef XBAR
#define XBAR 0
#endif
#ifndef REP4
#define REP4 1
#endif
#ifndef REP6
#define REP6 1
#endif
#ifndef REP10
#define REP10 1
#endif
    if (IN(0)) for (int rep = 0; rep < REP0; ++rep) { phase0(a, lds); if (rep + 1 < REP0) xcd_barrier(bar); }
    SEAM(0);
    if (IN(1)) for (int rep = 0; rep < REP1; ++rep) { norm_mod_phase<true>(a, lds, a.in[I_X], a.in[I_N1G], 0, 1, (bf16*)(ws + WS_H)); if (rep + 1 < REP1) xcd_barrier(bar); }
    SEAM(1);
    if (IN(2)) {
        constexpr int GEMM_WG = 160;
        const int ngemm = (int)gridDim.x > GEMM_WG ? GEMM_WG : (int)gridDim.x;
        if ((int)blockIdx.x < ngemm) { pg8::Gemm g{(const bf16*)(ws + WS_H), (const bf16*)(ws + WS_WIN), M, NP, D}; pg8::PlainOrder S; S.init(M, NP, ngemm, (int)blockIdx.x); S.Bt = g.Bt; S.K = D;
            pg8::EpiBf16 E{(bf16*)(ws + WS_PROJ), NP};
            pg8::gemm_phase2<pg8::EpiBf16, pg8::PlainOrder, true>(lds, g, S, E); }
        moe_convert(a, lds);
    }
    SEAM(2);
    for (int xb = 0; xb < XBAR; ++xb) xcd_barrier(bar);
    if (IN(3)) for (int rep = 0; rep < REP3; ++rep) { phase3(a, lds); if (rep + 1 < REP3) xcd_barrier(bar); }
    SEAM(3);
    for (int rep = 0; rep < REP4; ++rep) {
    if (IN(4)) phase4(a, lds);
    SEAM(4);
    if (IN(5)) phase5(a, lds);
    if (rep + 1 < REP4) xcd_barrier(bar); }
    SEAM(5);
    if (IN(6)) for (int rep = 0; rep < REP6; ++rep) { phase6(a, lds); if (rep + 1 < REP6) xcd_barrier(bar); }
    SEAM(6);
    if (IN(7)) { pg8::Gemm g{(const bf16*)(ws + WS_CAT), (const bf16*)(ws + WS_WOUT), M, D, D}; pg8::PlainOrder S; S.init(M, D, (int)gridDim.x, (int)blockIdx.x); S.Bt = g.Bt; S.K = D;
        pg8::EpiResGate E{a.in[I_X], a.out, D, (const float*)(ws + WS_MOD) + 2 * 2048, 12288, T};
        pg8::gemm_phase2<pg8::EpiResGate, pg8::PlainOrder, true>(lds, g, S, E); }
    SEAM(7);
    if (IN(8)) norm_mod_phase<false>(a, lds, a.out, a.in[I_N2G], 3, 4, (bf16*)(ws + WS_H));
    SEAM(8);
    if (IN(9)) phase9(a, lds);
    SEAM(9);
    for (int rep = 0; rep < REP10; ++rep) {
    if (IN(10)) phase10(a, lds);
    SEAM(10);
    if (IN(11)) phase11(a, lds);
    if (rep + 1 < REP10) xcd_barrier(bar); }
    SEAM(11);
    if (IN(12)) phase12<true>(a);
#undef IN
#undef SEAM
}

extern "C" void kernel_launch(void* const* d_in, const int* in_sizes, int n_in, void* d_out, int out_size, void* d_ws, size_t ws_size, hipStream_t stream) {
    static int grid = 0;
    if (grid == 0) {
        if (n_in != 23 || out_size != M * D || ws_size < WS_END) { fprintf(stderr, "kernel_launch: unexpected shapes (n_in %d, out %d, ws %zu < %zu); nothing launched\n", n_in, out_size, ws_size, (size_t)WS_END); grid = -1; return; }
        int dev = 0, cus = 0, per_cu = 0;
        if (hipGetDevice(&dev) != hipSuccess || hipDeviceGetAttribute(&cus, hipDeviceAttributeMultiprocessorCount, dev) != hipSuccess) { grid = -1; return; }
        if (hipFuncSetAttribute((const void*)fwd, hipFuncAttributeMaxDynamicSharedMemorySize, LDS_BYTES) != hipSuccess) { fprintf(stderr, "kernel_launch: hipFuncSetAttribute failed\n"); grid = -1; return; }
        if (hipOccupancyMaxActiveBlocksPerMultiprocessor(&per_cu, (const void*)fwd, NWAVES * 64, LDS_BYTES) != hipSuccess || per_cu < 1) fprintf(stderr, "kernel_launch: occupancy query reports %d\n", per_cu);
        (void)hipGetLastError();
        grid = cus;
    }
    if (grid < 0) return;
    if (hipMemsetAsync((char*)d_ws + WS_CTL, 0, CTL_ZERO_BYTES, stream) != hipSuccess) return;
    Args a{};
    for (int i = 0; i < 23; ++i) a.in[i] = (const float*)d_in[i];
    a.out = (float*)d_out; a.ws = (unsigned char*)d_ws;
    constexpr int NL = MK_N_LAUNCHES;
    for (int li = 0; li < NL; ++li) {
        a.ph_lo = (NL == 1) ? 0 : li; a.ph_hi = (NL == 1) ? NPHASES : li + 1;
        hipLaunchKernelGGL(fwd, dim3(grid), dim3(NWAVES * 64), LDS_BYTES, stream, a);
        const hipError_t le = hipPeekAtLastError();
        if (le != hipSuccess) { fprintf(stderr, "kernel_launch: launch %d failed: %s\n", li, hipGetErrorName(le)); break; }
    }
}
```

```cpp
#include <hip/hip_runtime.h>
#include <cstdio>
#include <cstdint>
namespace pg8 {
#define PG8_LAS __attribute__((address_space(3)))
typedef unsigned short bf16_t;
typedef short bf16x8 __attribute__((ext_vector_type(8)));
typedef float f32x4 __attribute__((ext_vector_type(4)));
typedef unsigned u32x4 __attribute__((ext_vector_type(4)));
constexpr int BM = 256, BK = 64, HALF = 128, HTB = HALF * BK * 2  , STAGE_BYTES = 8 * HTB, NXCD = 8, WGM = 8;

__host__ __device__ __forceinline__ int lds_byte(int r, int c) { const int st = (r >> 4) * 2 + (c >> 5), rr = r & 15, cc = c & 31, ob = rr * 64 + cc * 2; return st * 1024 + (ob ^ (((ob >> 9) & 1) << 5)); }
__host__ __device__ __forceinline__ void stage_rc(int b, int& R, int& C) { const int st = b / 1024, sb = b % 1024, swz = sb ^ (((sb >> 9) & 1) << 5); R = (st >> 1) * 16 + swz / 64; C = (st & 1) * 32 + (swz % 64) / 2; }
__host__ __device__ __forceinline__ int perm32(int rho) { const int n = rho >> 4, i = rho & 15; return 8 * (i >> 2) + 4 * n + (i & 3); }

struct Unit { int pm, pn, e, ord; };
struct Gemm { const bf16_t* A; const bf16_t* Bt; int M, N, K; };

struct StaticOrder {
    int nM, nN, nwg, G, c;
    __host__ __device__ void init(int M, int N, int G_, int c_) { nM = M / BM; nN = N / BM; nwg = nM * nN; G = G_; c = c_; }
    __host__ __device__ bool next(int i, Unit& u) const {
        const long L = (long)i * G + c; if (L >= nwg) return false;
        int wgid = (int)L; { const int q = nwg / NXCD, r = nwg % NXCD, xcd = wgid % NXCD, off = wgid / NXCD; wgid = (xcd < r ? xcd * (q + 1) : r * (q + 1) + (xcd - r) * q) + off; }
        const int nig = WGM * nN, gid = wgid / nig, fm = gid * WGM, gsz = (nM - fm) < WGM ? (nM - fm) : WGM;
        u.pm = fm + ((wgid % nig) % gsz); u.pn = (wgid % nig) / gsz; return true;
    }
    __device__ __forceinline__ void a_ready(const Unit&) const {}
    __device__ __forceinline__ void done(const Unit&) const {}
};


typedef float f32x2 __attribute__((ext_vector_type(2)));
typedef __bf16 bf16x2_t __attribute__((ext_vector_type(2)));
__device__ __forceinline__ unsigned cvt_pk_bf16(float lo, float hi) { f32x2 v = {lo, hi}; bf16x2_t r = __builtin_convertvector(v, bf16x2_t); return __builtin_bit_cast(unsigned, r); }

struct EpiBf16 {
    static constexpr bool PERM = true, AFTER_DRAIN = false;
    bf16_t* O; int ldc;
    __device__ __forceinline__ void operator()(const f32x4 (&acc)[2][2][4][2], const Unit& u, int wr, int wc, int fr, int fq) const {
        const int row0 = u.pm * BM + wr * 64 + fr; const int col0 = u.pn * BM + wc * 32 + 8 * fq;
#pragma unroll
        for (int ai = 0; ai < 2; ++ai)
#pragma unroll
            for (int m = 0; m < 4; ++m) { bf16_t* rowp = O + (size_t)(row0 + ai * HALF + m * 16) * ldc + col0;
#pragma unroll
                for (int bj = 0; bj < 2; ++bj) { const f32x4 v0 = acc[ai][bj][m][0], v1 = acc[ai][bj][m][1];
                    u32x4 w; w.x = cvt_pk_bf16(v0[0], v0[1]); w.y = cvt_pk_bf16(v0[2], v0[3]); w.z = cvt_pk_bf16(v1[0], v1[1]); w.w = cvt_pk_bf16(v1[2], v1[3]);
                    *(u32x4*)(rowp + bj * HALF) = w; } }
    }
};
struct EpiProj {
    static constexpr bool PERM = true, AFTER_DRAIN = false;
    bf16_t* proj; int ldc; int Tn;
    bf16_t *Qr, *Kr, *KzT, *VT, *kcmp, *vcmp, *vsT, *vwT; const float *cosT, *sinT;
    static __device__ __forceinline__ bf16_t b16(float x) { return (bf16_t)(cvt_pk_bf16(x, 0.f) & 0xffffu); }
    __device__ __forceinline__ void operator()(const f32x4 (&acc)[2][2][4][2], const Unit& u, int wr, int wc, int fr, int fq) const {
        asm volatile("" : "+v"(fr), "+v"(fq));
        const int pn = u.pn, b = u.pm >> 3, tb = (u.pm & 7) * 256, c8 = wc * 32 + 8 * fq;
        if (pn < 8) {
            const bool isk = pn >= 4; const int h = pn & 3; const float sc = isk ? 0.0625f : 1.f;
            const float lg = h == 0 ? -0.0317486983145803f : (h == 1 ? -0.015748356968139168f : (h == 2 ? -0.007843177461025893f : -0.003913899321136329f));
            bf16_t* dst = (isk ? Kr : Qr) + (size_t)(b * 4 + h) * Tn * 256;
            bf16_t* dT = KzT + (size_t)(b * 4 + h) * 256 * Tn;
#pragma unroll
            for (int ai = 0; ai < 2; ++ai)
#pragma unroll
                for (int m = 0; m < 4; ++m) { const int t = tb + ai * HALF + wr * 64 + m * 16 + fr;
                    const f32x4 c0 = *(const f32x4*)(cosT + t * 128 + c8), c1 = *(const f32x4*)(cosT + t * 128 + c8 + 4), s0 = *(const f32x4*)(sinT + t * 128 + c8), s1 = *(const f32x4*)(sinT + t * 128 + c8 + 4);
                    const f32x4 xa = acc[ai][0][m][0], xb = acc[ai][0][m][1], ya = acc[ai][1][m][0], yb = acc[ai][1][m][1];
                    const f32x4 o1a = (xa * c0 - ya * s0) * sc, o1b = (xb * c1 - yb * s1) * sc, o2a = (xa * s0 + ya * c0) * sc, o2b = (xb * s1 + yb * c1) * sc;
                    u32x4 w1, w2; w1.x = cvt_pk_bf16(o1a[0], o1a[1]); w1.y = cvt_pk_bf16(o1a[2], o1a[3]); w1.z = cvt_pk_bf16(o1b[0], o1b[1]); w1.w = cvt_pk_bf16(o1b[2], o1b[3]);
                    w2.x = cvt_pk_bf16(o2a[0], o2a[1]); w2.y = cvt_pk_bf16(o2a[2], o2a[3]); w2.z = cvt_pk_bf16(o2b[0], o2b[1]); w2.w = cvt_pk_bf16(o2b[2], o2b[3]);
                    bf16_t* rowp = dst + (size_t)t * 256 + c8; *(u32x4*)rowp = w1; *(u32x4*)(rowp + 128) = w2;
                    if (isk) { const float zs = __expf(lg * (float)(127 - (t & 127)));
#pragma unroll
                        for (int j = 0; j < 4; ++j) { dT[(size_t)(c8 + j) * Tn + t] = b16(o1a[j] * zs); dT[(size_t)(c8 + 4 + j) * Tn + t] = b16(o1b[j] * zs);
                            dT[(size_t)(128 + c8 + j) * Tn + t] = b16(o2a[j] * zs); dT[(size_t)(128 + c8 + 4 + j) * Tn + t] = b16(o2b[j] * zs); } } }
        } else if (pn < 12 || pn == 23 || pn == 25) {
            const bool ret = pn < 12;
#pragma unroll
            for (int bj = 0; bj < 2; ++bj) {
                bf16_t* dT = ret ? VT + ((size_t)(b * 4 + (pn - 8)) * 256 + bj * HALF + c8) * Tn : (pn == 23 ? vsT : vwT) + ((size_t)(b * 2 + bj) * 128 + c8) * Tn;
#pragma unroll
                for (int ai = 0; ai < 2; ++ai)
#pragma unroll
                    for (int m = 0; m < 4; ++m) { const int t = tb + ai * HALF + wr * 64 + m * 16 + fr; const f32x4 va = acc[ai][bj][m][0], vb = acc[ai][bj][m][1];
#pragma unroll
                        for (int j = 0; j < 4; ++j) { dT[(size_t)j * Tn + t] = b16(va[j]); dT[(size_t)(4 + j) * Tn + t] = b16(vb[j]); } } }
        } else if (pn == 20 || pn == 21) {
            bf16_t* dst = pn == 20 ? kcmp : vcmp;
#pragma unroll
            for (int bj = 0; bj < 2; ++bj)
#pragma unroll
                for (int ai = 0; ai < 2; ++ai)
#pragma unroll
                    for (int m = 0; m < 4; ++m) { const int t = tb + ai * HALF + wr * 64 + m * 16 + fr; const f32x4 v0 = acc[ai][bj][m][0], v1 = acc[ai][bj][m][1];
                        u32x4 w; w.x = cvt_pk_bf16(v0[0], v0[1]); w.y = cvt_pk_bf16(v0[2], v0[3]); w.z = cvt_pk_bf16(v1[0], v1[1]); w.w = cvt_pk_bf16(v1[2], v1[3]);
                        *(u32x4*)(dst + ((size_t)(b * 2 + bj) * Tn + t) * 128 + c8) = w; }
        } else {
            const int row0 = u.pm * BM + wr * 64 + fr; const int col0 = pn * BM + c8;
#pragma unroll
            for (int ai = 0; ai < 2; ++ai)
#pragma unroll
                for (int m = 0; m < 4; ++m) { bf16_t* rowp = proj + (size_t)(row0 + ai * HALF + m * 16) * ldc + col0;
#pragma unroll
                    for (int bj = 0; bj < 2; ++bj) { const f32x4 v0 = acc[ai][bj][m][0], v1 = acc[ai][bj][m][1];
                        u32x4 w; w.x = cvt_pk_bf16(v0[0], v0[1]); w.y = cvt_pk_bf16(v0[2], v0[3]); w.z = cvt_pk_bf16(v1[0], v1[1]); w.w = cvt_pk_bf16(v1[2], v1[3]);
                        *(u32x4*)(rowp + bj * HALF) = w; } }
        }
    }
};
struct EpiResGate {
    static constexpr bool PERM = false, AFTER_DRAIN = false;
    const float* base; float* out; int ldc; const float* gate; int gstride; int rows_per_batch;
    __device__ __forceinline__ void operator()(const f32x4 (&acc)[2][2][4][2], const Unit& u, int wr, int wc, int fr, int fq) const {
        const int row0 = u.pm * BM + wr * 64 + fr, col0 = u.pn * BM + wc * 32 + 4 * fq;
        const float* gp = gate + (size_t)((u.pm * BM) / rows_per_batch) * gstride + col0;
        f32x4 gv[2][2];
#pragma unroll
        for (int bj = 0; bj < 2; ++bj)
#pragma unroll
            for (int n = 0; n < 2; ++n) gv[bj][n] = *(const f32x4*)(gp + bj * HALF + n * 16);
#pragma unroll
        for (int ai = 0; ai < 2; ++ai)
#pragma unroll
            for (int m = 0; m < 4; ++m) { const size_t off = (size_t)(row0 + ai * HALF + m * 16) * ldc + col0;
#pragma unroll
                for (int bj = 0; bj < 2; ++bj)
#pragma unroll
                    for (int n = 0; n < 2; ++n) { const f32x4 bs = *(const f32x4*)(base + off + bj * HALF + n * 16);
                        *(f32x4*)(out + off + bj * HALF + n * 16) = bs + gv[bj][n] * acc[ai][bj][m][n]; } }
    }
};


struct PlainOrder : StaticOrder {
    const bf16_t* Bt; int K;
    __device__ __forceinline__ void a_offs(const Unit& u, int tid, unsigned (&v)[2][2]) const {
#pragma unroll
        for (int h = 0; h < 2; ++h)
#pragma unroll
            for (int i = 0; i < 2; ++i) { int R, C; stage_rc(tid * 16 + i * 8192, R, C); v[h][i] = (unsigned)((u.pm * BM + h * HALF + R) * K + C) * 2u; }
    }
    __device__ __forceinline__ const char* b_base(const Unit& u) const { return (const char*)Bt + (size_t)u.pn * ((size_t)BM * K * 2); }
};
struct MoeOrder {
    const PG8_LAS int* cntL; const PG8_LAS int* tst; int npn, G, c;
    __device__ __forceinline__ bool next(int i, Unit& u) const {
        const int L = i * G + c; if (L >= tst[64] * npn) return false;
        const int tile = L / npn; u.pn = L - tile * npn; int e = 0; while (tst[e + 1] <= tile) ++e; u.e = e; u.pm = tile - tst[e]; u.ord = i; return true; }
};
struct MoeOrder1 : MoeOrder {
    const PG8_LAS int* tab; const bf16_t* Bt; int K;
    __device__ __forceinline__ void a_offs(const Unit& u, int tid, unsigned (&v)[2][2]) const {
#pragma unroll
        for (int h = 0; h < 2; ++h)
#pragma unroll
            for (int i = 0; i < 2; ++i) { int R, C; stage_rc(tid * 16 + i * 8192, R, C); v[h][i] = (unsigned)(tab[u.ord * 256 + h * HALF + R] * K + C) * 2u; }
    }
    __device__ __forceinline__ const char* b_base(const Unit& u) const { return (const char*)Bt + ((size_t)u.e * 1024 + (size_t)u.pn * 256) * ((size_t)K * 2); }
};
struct MoeOrder2 : MoeOrder {
    const bf16_t* Bt; int K;
    __device__ __forceinline__ void a_offs(const Unit& u, int tid, unsigned (&v)[2][2]) const {
        const int row0 = 256 * (tst[u.e] + u.pm);
#pragma unroll
        for (int h = 0; h < 2; ++h)
#pragma unroll
            for (int i = 0; i < 2; ++i) { int R, C; stage_rc(tid * 16 + i * 8192, R, C); v[h][i] = (unsigned)((row0 + h * HALF + R) * K + C) * 2u; }
    }
    __device__ __forceinline__ const char* b_base(const Unit& u) const { return (const char*)Bt + ((size_t)u.e * 2048 + (size_t)u.pn * 256) * ((size_t)K * 2); }
};
struct EpiMoe1 {
    static constexpr bool PERM = true, AFTER_DRAIN = false;
    bf16_t* abuf; const PG8_LAS int* cntL; const PG8_LAS int* tst;
    __device__ __forceinline__ void operator()(const f32x4 (&acc)[2][2][4][2], const Unit& u, int wr, int wc, int fr, int fq) const {
        const int ne = cntL[u.e]; const size_t row0 = (size_t)256 * (tst[u.e] + u.pm);
        asm volatile("" : "+v"(fr), "+v"(fq));
#pragma unroll
        for (int ai = 0; ai < 2; ++ai)
#pragma unroll
            for (int m = 0; m < 4; ++m) { const int r = ai * HALF + wr * 64 + m * 16 + fr;
                if (u.pm * 256 + r < ne) { const f32x4 g0 = acc[ai][0][m][0], g1 = acc[ai][0][m][1], u0 = acc[ai][1][m][0], u1 = acc[ai][1][m][1];
                    f32x4 a0, a1;
#pragma unroll
                    for (int j = 0; j < 4; ++j) { a0[j] = g0[j] * __builtin_amdgcn_rcpf(1.f + __builtin_amdgcn_exp2f(-1.4426950408889634f * g0[j])) * u0[j]; a1[j] = g1[j] * __builtin_amdgcn_rcpf(1.f + __builtin_amdgcn_exp2f(-1.4426950408889634f * g1[j])) * u1[j]; }
                    u32x4 w; w.x = cvt_pk_bf16(a0[0], a0[1]); w.y = cvt_pk_bf16(a0[2], a0[3]); w.z = cvt_pk_bf16(a1[0], a1[1]); w.w = cvt_pk_bf16(a1[2], a1[3]);
                    *(u32x4*)(abuf + (row0 + r) * 512 + u.pn * 128 + wc * 32 + 8 * fq) = w; } }
    }
};
struct EpiMoe2 {
    static constexpr bool PERM = true, AFTER_DRAIN = false;
    bf16_t* ybuf; const int* asg; const float* rw; const PG8_LAS int* cntL; int cap, ldy;
    __device__ __forceinline__ void operator()(const f32x4 (&acc)[2][2][4][2], const Unit& u, int wr, int wc, int fr, int fq) const {
        const int ne = cntL[u.e];
#pragma unroll
        for (int ai = 0; ai < 2; ++ai)
#pragma unroll
            for (int m = 0; m < 4; ++m) { const int p = u.pm * 256 + ai * HALF + wr * 64 + m * 16 + fr;
                if (p < ne) { const int av = asg[(size_t)u.e * cap + p]; const float wv = rw[(size_t)u.e * cap + p];
                    bf16_t* rowp = ybuf + (size_t)av * ldy + u.pn * BM + wc * 32 + 8 * fq;
#pragma unroll
                    for (int bj = 0; bj < 2; ++bj) { const f32x4 v0 = acc[ai][bj][m][0] * wv, v1 = acc[ai][bj][m][1] * wv;
                        u32x4 w; w.x = cvt_pk_bf16(v0[0], v0[1]); w.y = cvt_pk_bf16(v0[2], v0[3]); w.z = cvt_pk_bf16(v1[0], v1[1]); w.w = cvt_pk_bf16(v1[2], v1[3]);
                        *(u32x4*)(rowp + bj * HALF) = w; } } }
    }
};


template <class Epi, class Sched, bool ALIGN_EPI = false>
__device__ __forceinline__ void gemm_phase2(PG8_LAS unsigned char* lds, const Gemm g, const Sched& S, const Epi& E) {
    const int tid = threadIdx.x, wid = __builtin_amdgcn_readfirstlane(tid >> 6), lane = tid & 63, wr = wid >> 2, wc = wid & 3, fr = lane & 15, fq = lane >> 4;
    const int K = g.K, nt = K / BK;
    unsigned vC[2][2], vN[2][2], voffB[2];
#pragma unroll
    for (int i = 0; i < 2; ++i) { int R, C; stage_rc(tid * 16 + i * 8192, R, C); const int Rb = Epi::PERM ? ((R & ~31) + perm32(R & 31)) : R; voffB[i] = (unsigned)(Rb * K + C) * 2u; }
    const size_t kstep = (size_t)(BK * 2);
    const size_t hstep = (size_t)HALF * K * 2;
    const unsigned ldsw = (unsigned)wid * 1024u;
    const int aoff = lds_byte(wr * 64 + fr, fq * 8), boff = lds_byte(wc * 32 + fr, fq * 8);
#define PG8_SA(b, h) (((b) * 2 + (h)) * HTB)
#define PG8_SB(b, h) ((4 + (b) * 2 + (h)) * HTB)
#define PG8_STAGE(bufoff, gbase, voff) do { _Pragma("unroll") for (int _i = 0; _i < 2; ++_i) \
        __builtin_amdgcn_global_load_lds((const unsigned*)((const char*)(gbase) + (voff)[_i]), (PG8_LAS unsigned*)(lds + (bufoff) + ldsw + _i * 8192), 16, 0, 0); } while (0)
#define PG8_LDA(dst, b, h) do { _Pragma("unroll") for (int m = 0; m < 4; ++m) _Pragma("unroll") for (int k = 0; k < 2; ++k) dst[m][k] = *(const PG8_LAS bf16x8*)(lds + PG8_SA(b, h) + aoff + m * 2048 + k * 1024); } while (0)
#define PG8_LDB(dst, b, h) do { _Pragma("unroll") for (int n = 0; n < 2; ++n) _Pragma("unroll") for (int k = 0; k < 2; ++k) dst[n][k] = *(const PG8_LAS bf16x8*)(lds + PG8_SB(b, h) + boff + n * 2048 + k * 1024); } while (0)
#define PG8_MMA(ai, bj, At, Bt) do { __builtin_amdgcn_s_setprio(1); _Pragma("unroll") for (int m = 0; m < 4; ++m) _Pragma("unroll") for (int n = 0; n < 2; ++n) _Pragma("unroll") for (int k = 0; k < 2; ++k) \
        acc[ai][bj][m][n] = __builtin_amdgcn_mfma_f32_16x16x32_bf16(Bt[n][k], At[m][k], acc[ai][bj][m][n], 0, 0, 0); __builtin_amdgcn_s_setprio(0); } while (0)
#define PG8_WAIT_V(n) asm volatile("s_waitcnt vmcnt(" #n ")" ::: "memory")
#define PG8_WAIT_L(n) asm volatile("s_waitcnt lgkmcnt(" #n ")" ::: "memory")
#define PG8_BAR __builtin_amdgcn_s_barrier()
#define PG8_SCHED __builtin_amdgcn_sched_barrier(0)
    Unit cur, nxt; int ui = 0;
    if (!S.next(0, cur)) return;
    f32x4 acc[2][2][4][2];
#pragma unroll
    for (int a = 0; a < 2; ++a)
#pragma unroll
        for (int b = 0; b < 2; ++b)
#pragma unroll
            for (int m = 0; m < 4; ++m)
#pragma unroll
                for (int n = 0; n < 2; ++n) acc[a][b][m][n] = (f32x4){0.f, 0.f, 0.f, 0.f};
    bf16x8 At[4][2], B0[2][2], B1[2][2];
    const char* Ab = (const char*)g.A; const char* cB = S.b_base(cur);
    S.a_offs(cur, tid, vC);
    PG8_STAGE(PG8_SB(0, 0), cB, voffB); PG8_STAGE(PG8_SB(0, 1), cB + hstep, voffB); PG8_STAGE(PG8_SA(0, 0), Ab, vC[0]); PG8_STAGE(PG8_SA(0, 1), Ab, vC[1]);
    if (wr == 1) PG8_BAR;
    PG8_WAIT_V(2); PG8_BAR;
    PG8_STAGE(PG8_SB(1, 0), cB + kstep, voffB); PG8_STAGE(PG8_SA(1, 0), Ab + kstep, vC[0]); PG8_STAGE(PG8_SB(1, 1), cB + hstep + kstep, voffB);
    PG8_WAIT_V(6); PG8_BAR;
    for (;;) {
        const bool has_next = S.next(ui + 1, nxt);
        const char* nB = cB;
        if (has_next) { S.a_offs(nxt, tid, vN); nB = S.b_base(nxt); }
        else {
#pragma unroll
            for (int hh = 0; hh < 2; ++hh)
#pragma unroll
                for (int i = 0; i < 2; ++i) vN[hh][i] = vC[hh][i]; }
        for (int t = 0; t < nt; t += 2) {
            const bool last = (t == nt - 2);
            const char* a1 = Ab + (size_t)(t + 1) * kstep;
            const char* a2 = last ? Ab : Ab + (size_t)(t + 2) * kstep; const char* b2 = last ? nB : cB + (size_t)(t + 2) * kstep;
            const char* a3 = a2 + kstep; const char* b3 = b2 + kstep;
            unsigned v2[2][2];
#pragma unroll
            for (int hh = 0; hh < 2; ++hh)
#pragma unroll
                for (int i = 0; i < 2; ++i) v2[hh][i] = last ? vN[hh][i] : vC[hh][i];
            PG8_LDB(B0, 0, 0); PG8_LDB(B1, 0, 1); PG8_SCHED; PG8_LDA(At, 0, 0); PG8_STAGE(PG8_SA(1, 1), a1, vC[1]);
            PG8_WAIT_V(8); PG8_WAIT_L(0); PG8_BAR; PG8_MMA(0, 0, At, B0); PG8_MMA(0, 1, At, B1); PG8_BAR; PG8_SCHED;
            PG8_LDA(At, 0, 1); PG8_STAGE(PG8_SB(0, 0), b2, voffB); PG8_STAGE(PG8_SB(0, 1), b2 + hstep, voffB); PG8_STAGE(PG8_SA(0, 0), a2, v2[0]);
            PG8_WAIT_V(8); PG8_WAIT_L(0); PG8_BAR; PG8_MMA(1, 0, At, B0); PG8_MMA(1, 1, At, B1); PG8_BAR; PG8_SCHED;
            PG8_LDB(B0, 1, 0); PG8_LDB(B1, 1, 1); PG8_SCHED; PG8_LDA(At, 1, 0); PG8_STAGE(PG8_SA(0, 1), a2, v2[1]);
            PG8_WAIT_V(8); PG8_WAIT_L(0); PG8_BAR; PG8_MMA(0, 0, At, B0); PG8_MMA(0, 1, At, B1); PG8_BAR; PG8_SCHED;
            PG8_LDA(At, 1, 1); PG8_STAGE(PG8_SB(1, 0), b3, voffB); PG8_STAGE(PG8_SB(1, 1), b3 + hstep, voffB); PG8_STAGE(PG8_SA(1, 0), a3, v2[0]);
            PG8_WAIT_V(8); PG8_WAIT_L(0); PG8_BAR; PG8_MMA(1, 0, At, B0); PG8_MMA(1, 1, At, B1); PG8_BAR; PG8_SCHED;
        }
        if constexpr (ALIGN_EPI) { if (wr == 0) PG8_BAR; }
        E(acc, cur, wr, wc, fr, fq);
        if (!has_next) break;
#pragma unroll
        for (int a = 0; a < 2; ++a)
#pragma unroll
            for (int b = 0; b < 2; ++b)
#pragma unroll
                for (int m = 0; m < 4; ++m)
#pragma unroll
                    for (int n = 0; n < 2; ++n) acc[a][b][m][n] = (f32x4){0.f, 0.f, 0.f, 0.f};
        cur = nxt; cB = nB; ++ui;
#pragma unroll
        for (int hh = 0; hh < 2; ++hh)
#pragma unroll
            for (int i = 0; i < 2; ++i) vC[hh][i] = vN[hh][i];
        if constexpr (ALIGN_EPI) { if (wr == 1) PG8_BAR; }
    }
    PG8_WAIT_V(0);
    if constexpr (!ALIGN_EPI) { if (wr == 0) PG8_BAR; }
    PG8_BAR;
#undef PG8_SA
#undef PG8_SB
#undef PG8_STAGE
#undef PG8_LDA
#undef PG8_LDB
#undef PG8_MMA
#undef PG8_WAIT_V
#undef PG8_WAIT_L
#undef PG8_BAR
#undef PG8_SCHED
}
}

constexpr int NB = 8, T = 2048, D = 2048, M = NB * T;
constexpr int NP = 6912, PROJ = 6680;
constexpr int C_RQ = 0, C_RK = 1024, C_RV = 2048, C_RG = 3072, C_NQ = 4096, C_KC = 5120, C_VC = 5376, C_KS = 5632, C_VS = 5888, C_KW = 6144, C_VW = 6400, C_NG = 6656;
constexpr int NEXP = 64, DE = 512, CAP = 32768;
constexpr float EPS = 1e-6f;
constexpr int NWAVES = 8;

constexpr size_t MiB = 1u << 20;
constexpr size_t WS_CTL = 0, CTL_ZERO_BYTES = 1 * MiB;
constexpr size_t WS_SMALL = 1 * MiB;
constexpr size_t WS_BIAS1K = WS_SMALL, WS_BIAS1V = WS_SMALL + 1024, WS_W2KT = WS_SMALL + 4096, WS_W2VT = WS_W2KT + 65536, WS_WRT = WS_W2VT + 65536;
constexpr size_t WS_MODP = 2 * MiB;
constexpr size_t WS_MOD = WS_MODP + 4 * 8 * 12288 * 4;
constexpr size_t WS_COS = 4 * MiB, WS_SIN = 5 * MiB;
constexpr size_t WS_W1K = 6 * MiB, WS_W1V = 8 * MiB;
constexpr size_t WS_YK = 10 * MiB, WS_YV = 14 * MiB;
constexpr size_t WS_KC = 18 * MiB, WS_VCT = 19 * MiB;
constexpr size_t WS_BIAS1P = 20 * MiB;
constexpr size_t WS_ASG = 26 * MiB, WS_RW = 34 * MiB;
constexpr size_t WS_WIN = 42 * MiB;
constexpr size_t WS_WOUT = 70 * MiB;
constexpr size_t WS_WGU = 78 * MiB;
constexpr size_t WS_WD = 334 * MiB;
constexpr size_t WS_H = 462 * MiB;
constexpr size_t WS_PROJ = 526 * MiB;
constexpr size_t WS_Y = 526 * MiB;
constexpr size_t WS_A = 654 * MiB;
constexpr size_t WS_QR = 742 * MiB, WS_KR = 774 * MiB, WS_KZT = 806 * MiB, WS_VT = 838 * MiB;
constexpr size_t WS_SP = 870 * MiB;
constexpr size_t WS_KCMP = 934 * MiB, WS_VCMP = 942 * MiB, WS_VST = 950 * MiB, WS_VWT = 958 * MiB;
constexpr size_t WS_CAT = 966 * MiB;
constexpr size_t WS_END = 1030 * MiB;
constexpr int CW_BAR = 4096;
constexpr int CW_Q = 8448;
constexpr int CW_CNT = 8192;

constexpr int LDS_BYTES = 147456;
constexpr int MISC_OFF = LDS_BYTES - 256;

#define GAS __attribute__((address_space(1)))
#define LAS __attribute__((address_space(3)))
typedef unsigned short bf16;
typedef short bf16x8 __attribute__((ext_vector_type(8)));
typedef short bf16x4 __attribute__((ext_vector_type(4)));
typedef float f32x4 __attribute__((ext_vector_type(4)));
typedef float f32x16 __attribute__((ext_vector_type(16)));
typedef unsigned u32x4 __attribute__((ext_vector_type(4)));
typedef unsigned u32x2 __attribute__((ext_vector_type(2)));
#define LDS_WAIT() asm volatile("s_waitcnt lgkmcnt(0)" ::: "memory")
#define VM_WAIT() asm volatile("s_waitcnt vmcnt(0)" ::: "memory")
#define MFMA16(a, b, c) __builtin_amdgcn_mfma_f32_16x16x32_bf16((a), (b), (c), 0, 0, 0)
#define MFMA32(a, b, c) __builtin_amdgcn_mfma_f32_32x32x16_bf16((a), (b), (c), 0, 0, 0)
using pg8::cvt_pk_bf16;
__device__ __forceinline__ float bf2f(unsigned short b) { return __uint_as_float(((unsigned)b) << 16); }
__device__ __forceinline__ float bflo(unsigned w) { return __uint_as_float(w << 16); }
__device__ __forceinline__ float bfhi(unsigned w) { return __uint_as_float(w & 0xffff0000u); }
__device__ __forceinline__ float wave_sum(float v) {
#pragma unroll
    for (int o = 1; o < 64; o <<= 1) v += __shfl_xor(v, o);
    return v;
}
__device__ __forceinline__ float silu_f(float x) { return x / (1.f + __expf(-x)); }
__device__ __forceinline__ float sigmoid_f(float x) { return 1.f / (1.f + __expf(-x)); }
__device__ __forceinline__ bf16x8 cat4(bf16x4 lo, bf16x4 hi) { return __builtin_shufflevector(lo, hi, 0, 1, 2, 3, 4, 5, 6, 7); }
__device__ __forceinline__ bf16x8 pack8(const f32x4 a, const f32x4 b) { u32x4 p; p.x = cvt_pk_bf16(a[0], a[1]); p.y = cvt_pk_bf16(a[2], a[3]); p.z = cvt_pk_bf16(b[0], b[1]); p.w = cvt_pk_bf16(b[2], b[3]); return __builtin_bit_cast(bf16x8, p); }

#define XB_TMO      128
#define XB_XCNT(j)  (256  + 64 * (j))
#define XB_XSUB(j)  (1280 + 64 * (j))
#define XB_XGEN(j)  (2304 + 64 * (j))
#define XB_TOP      3328
#define XB_TOPGEN   3392
#define XCD_BAR_WORDS 3456
#define XB_SPIN_CAP (1u << 18)

__device__ __forceinline__ unsigned xb_ld(unsigned* p)              { return __hip_atomic_load(p, __ATOMIC_RELAXED, __HIP_MEMORY_SCOPE_AGENT); }
__device__ __forceinline__ unsigned xb_add(unsigned* p, unsigned v) { return __hip_atomic_fetch_add(p, v, __ATOMIC_RELAXED, __HIP_MEMORY_SCOPE_AGENT); }
__device__ __forceinline__ unsigned xb_xcc_id() { return (unsigned)__builtin_amdgcn_s_getreg((3 << 11) | 20) & 0xFu; }
#define XB_SPIN(cond, bar) do { unsigned _sp = 0; while (cond) { __builtin_amdgcn_s_sleep(1); \
    if ((++_sp & 255u) == 0u) { if (xb_ld(&(bar)[XB_TMO])) break; if (_sp > XB_SPIN_CAP) { atomicAdd(&(bar)[XB_TMO], 1u); break; } } } } while (0)

struct XcdBarrier {
    unsigned* bar; unsigned x;
    volatile LAS unsigned* st;
};

__device__ __forceinline__ XcdBarrier xcd_barrier_post(unsigned* bar, volatile LAS unsigned* st) {
    XcdBarrier b; b.bar = bar; b.x = xb_xcc_id(); b.st = st;
    if (threadIdx.x == 0) (void)xb_add(&bar[XB_XCNT(b.x)], 1u);
    return b;
}
__device__ __forceinline__ void xcd_barrier_complete(unsigned* bar, unsigned x, unsigned& nloc, unsigned& nx) {
    const unsigned G = gridDim.x * gridDim.y * gridDim.z;
    unsigned sum, cnt, mine, sp = 0u;
    for (;;) {
        sum = 0u; cnt = 0u; mine = 0u;
#pragma unroll
        for (unsigned j = 0; j < 16; ++j) { const unsigned c = xb_ld(&bar[XB_XCNT(j)]); sum += c; cnt += (c > 0u) ? 1u : 0u; mine = (j == x) ? c : mine; }
        if (sum == G) break;
        __builtin_amdgcn_s_sleep(1);
        if ((++sp & 255u) == 0u) { if (xb_ld(&bar[XB_TMO])) break; if (sp > XB_SPIN_CAP) { atomicAdd(&bar[XB_TMO], 1u); break; } }
    }
    nloc = mine > 0u ? mine : 1u; nx = cnt > 0u ? cnt : 1u;
}

__device__ __forceinline__ void xcd_barrier(const XcdBarrier& b) {
    asm volatile("s_waitcnt vmcnt(0)" ::: "memory");
    __syncthreads();
    if (threadIdx.x == 0) {
        unsigned* bar = b.bar;
        __builtin_amdgcn_s_waitcnt(0);
        unsigned nloc = b.st[0], nx = b.st[1];
        if (nloc == 0u) { xcd_barrier_complete(bar, b.x, nloc, nx); b.st[0] = nloc; b.st[1] = nx; }
        const unsigned old = xb_add(&bar[XB_XSUB(b.x)], 1u);
        const unsigned gen = old / nloc;
        if (old + 1u == (gen + 1u) * nloc) {
            __builtin_amdgcn_fence(__ATOMIC_RELEASE, "agent");
            asm volatile("s_waitcnt vmcnt(0)" ::: "memory");
            const unsigned og = xb_add(&bar[XB_TOP], 1u);
            const unsigned tg = og / nx;
            if (og + 1u == (tg + 1u) * nx) xb_add(&bar[XB_TOPGEN], 1u);
            else XB_SPIN(xb_ld(&bar[XB_TOPGEN]) == tg, bar);
            __builtin_amdgcn_fence(__ATOMIC_ACQUIRE, "agent");
            xb_add(&bar[XB_XGEN(b.x)], 1u);
            asm volatile("s_waitcnt vmcnt(0)" ::: "memory");
        } else {
            XB_SPIN(xb_ld(&bar[XB_XGEN(b.x)]) == gen, bar);
            __builtin_amdgcn_fence(__ATOMIC_ACQUIRE, "agent");
            asm volatile("s_waitcnt vmcnt(0)" ::: "memory");
        }
    }
    __syncthreads();
}

struct Args { const float* in[23]; float* out; unsigned char* ws; int ph_lo, ph_hi; };
enum { I_X = 0, I_C, I_WADA, I_BADA, I_N1G, I_N2G, I_FG, I_WIN, I_GNG, I_PK, I_W1K, I_W2K, I_PV, I_W1V, I_W2V, I_WOUT, I_WGRP, I_BGRP, I_WEXP, I_BEXP, I_WGATE, I_WUP, I_WDOWN };

__device__ __forceinline__ float ret_lg(int h) { return h == 0 ? -0.0317486983145803f : (h == 1 ? -0.015748356968139168f : (h == 2 ? -0.007843177461025893f : -0.003913899321136329f)); }

__device__ __forceinline__ void transpose_tile(const float* __restrict__ W, int ldw, int k0, int n0, int nmax, bf16* __restrict__ WT, int ldt, int drow0, int dcol0, LAS float* scr, int lane) {
    const int kr = lane >> 4, n4 = (lane & 15) * 4;
    f32x4 v[16];
    const bool ok = (n0 + n4) < nmax;
    const float* src = W + (size_t)(k0 + kr) * ldw + n0 + n4;
#pragma unroll
    for (int i = 0; i < 16; ++i) v[i] = ok ? *(const f32x4*)(src + (size_t)(4 * i) * ldw) : (f32x4){0.f, 0.f, 0.f, 0.f};
#pragma unroll
    for (int i = 0; i < 16; ++i) { LAS float* d = scr + (4 * i + kr) * 65 + n4; d[0] = v[i][0]; d[1] = v[i][1]; d[2] = v[i][2]; d[3] = v[i][3]; }
    LDS_WAIT();
    const int c = lane & 7;
#pragma unroll
    for (int j = 0; j < 8; ++j) { const int nn = 8 * j + (lane >> 3); const LAS float* s = scr + (8 * c) * 65 + nn;
        u32x4 o; o.x = cvt_pk_bf16(s[0 * 65], s[1 * 65]); o.y = cvt_pk_bf16(s[2 * 65], s[3 * 65]); o.z = cvt_pk_bf16(s[4 * 65], s[5 * 65]); o.w = cvt_pk_bf16(s[6 * 65], s[7 * 65]);
        *(u32x4*)(WT + (size_t)(drow0 + nn) * ldt + dcol0 + 8 * c) = o; }
    LDS_WAIT();
}

__device__ __forceinline__ void phase0(const Args& a, LAS unsigned char* lds) {
    const int tid = threadIdx.x, lane = tid & 63, wave = __builtin_amdgcn_readfirstlane(tid >> 6);
    unsigned char* ws = a.ws;
    {
        LAS float* cact = (LAS float*)lds;
        LAS float* red = (LAS float*)(lds + 16384);
        const float* c = a.in[I_C]; const float* wada = a.in[I_WADA];
        float* modp = (float*)(ws + WS_MODP);
        for (int it = blockIdx.x; it < 768; it += gridDim.x) {
            const int kq = it / 192, cc = it % 192;
            __syncthreads();
            for (int i = tid; i < 8 * 512; i += 512) { const int b = i >> 9, k = i & 511; cact[i] = silu_f(c[b * 2048 + kq * 512 + k]); }
            __syncthreads();
            float acc[8];
#pragma unroll
            for (int b = 0; b < 8; ++b) acc[b] = 0.f;
            const float* wp = wada + (size_t)(kq * 512 + wave * 64) * 12288 + cc * 64 + lane;
#pragma unroll 8
            for (int kk = 0; kk < 64; ++kk) { const float wv = wp[(size_t)kk * 12288];
#pragma unroll
                for (int b = 0; b < 8; ++b) acc[b] += cact[b * 512 + wave * 64 + kk] * wv; }
#pragma unroll
            for (int b = 0; b < 8; ++b) red[(wave * 8 + b) * 64 + lane] = acc[b];
            __syncthreads();
            { const int b = tid >> 6, l = tid & 63; float s = 0.f;
#pragma unroll
              for (int w = 0; w < 8; ++w) s += red[(w * 8 + b) * 64 + l];
              modp[((size_t)kq * 8 + b) * 12288 + cc * 64 + l] = s; }
        }
    }
    __syncthreads();
    {
        const int gw = blockIdx.x * NWAVES + wave, NGW = gridDim.x * NWAVES;
        float* bp = (float*)(ws + WS_BIAS1P);
        for (int it = NGW - 1 - gw; it < 128; it += NGW) { const int ten = it >> 6, kc = it & 63;
            const float* pe = a.in[ten ? I_PV : I_PK] + kc * 64; const float* w1 = a.in[ten ? I_W1V : I_W1K] + (size_t)kc * 64 * 256 + 4 * lane;
            f32x4 acc = (f32x4){0.f, 0.f, 0.f, 0.f};
#pragma unroll 16
            for (int k = 0; k < 64; ++k) acc = acc + *(const f32x4*)(w1 + (size_t)k * 256) * pe[k];
            *(f32x4*)(bp + (size_t)it * 256 + 4 * lane) = acc; }
    }
    {
        LAS float* scr = (LAS float*)(lds + wave * 16640);
        const int gw = blockIdx.x * NWAVES + wave, NGW = gridDim.x * NWAVES;
        constexpr int I_IN = 108 * 32, I_OUT = 32 * 32, I_W1 = 256, I_W2 = 8;
        constexpr int NITEMS = I_IN + I_OUT + 2 * I_W1 + 2 * I_W2;
        for (int it = gw; it < NITEMS; it += NGW) {
            int r = it;
            if (r < I_IN) { const int kb = r / 108, nb = r % 108; transpose_tile(a.in[I_WIN], PROJ, 64 * kb, 64 * nb, PROJ, (bf16*)(ws + WS_WIN), 2048, 64 * nb, 64 * kb, scr, lane); continue; } r -= I_IN;
            if (r < I_OUT) { const int kb = r >> 5, nb = r & 31; transpose_tile(a.in[I_WOUT], 2048, 64 * kb, 64 * nb, 2048, (bf16*)(ws + WS_WOUT), 2048, 64 * nb, 64 * kb, scr, lane); continue; } r -= I_OUT;
            if (r < 2 * I_W1) { const int ten = r >= I_W1 ? 1 : 0; r -= ten * I_W1; const int kb = r >> 2, nb = r & 3, k0 = 64 * kb;
                transpose_tile(a.in[ten ? I_W1V : I_W1K], 256, k0, 64 * nb, 256, (bf16*)(ws + (ten ? WS_W1V : WS_W1K)), 2048, (k0 >= 2048 ? 256 : 0) + 64 * nb, k0 & 2047, scr, lane); continue; } r -= 2 * I_W1;
            { const int ten = r >= I_W2 ? 1 : 0; r -= ten * I_W2; const int kb = r >> 1, nb = r & 1;
                transpose_tile(a.in[ten ? I_W2V : I_W2K], 128, 64 * kb, 64 * nb, 128, (bf16*)(ws + (ten ? WS_W2VT : WS_W2KT)), 256, 64 * nb, 64 * kb, scr, lane); }
        }
    }
    {
        const int gt = blockIdx.x * 512 + tid, NT = gridDim.x * 512;
        bf16* wrt = (bf16*)(ws + WS_WRT); const float* wg = a.in[I_WGRP]; const float* we = a.in[I_WEXP];
        for (int idx = gt; idx < 80 * 2048; idx += NT) { const int n = idx >> 11, k = idx & 2047;
            const float v = n < 8 ? wg[k * 8 + n] : (n < 72 ? we[k * 64 + (n - 8)] : 0.f); wrt[idx] = (bf16)(cvt_pk_bf16(v, 0.f) & 0xffffu); }
        float* cosT = (float*)(ws + WS_COS); float* sinT = (float*)(ws + WS_SIN);
        for (int idx = gt; idx < 2048 * 128; idx += NT) { const int pos = idx >> 7, j = idx & 127;
            const float inv = exp2f(-(float)j * 0.10381025296523007f);
            const double rev = (double)pos * (double)inv * 0.15915494309189535;
            const float fr = (float)(rev - __builtin_floor(rev));
            cosT[idx] = __builtin_amdgcn_cosf(fr); sinT[idx] = __builtin_amdgcn_sinf(fr); }
    }
}

struct TTItem { const float* src; bf16* dst; int ldw, ldt; };
__device__ __forceinline__ void moe_item(const Args& a, int it, int lane, TTItem& t) {
    constexpr int I_G = 64 * 256; unsigned char* ws = a.ws; const int kr = lane >> 4, n4 = (lane & 15) * 4;
    int r = it;
    if (r < 2 * I_G) { const int up = r >= I_G ? 1 : 0; r -= up * I_G; const int e = r >> 8, rr = r & 255, kb = rr >> 3, nb = rr & 7, n0 = 64 * nb;
        t.src = a.in[up ? I_WUP : I_WGATE] + (size_t)e * 2048 * 512 + (size_t)(64 * kb + kr) * 512 + n0 + n4; t.ldw = 512;
        t.dst = (bf16*)(ws + WS_WGU) + (size_t)(e * 1024 + (n0 >> 7) * 256 + up * 128 + (n0 & 127)) * 2048 + 64 * kb; t.ldt = 2048; }
    else { r -= 2 * I_G; const int e = r >> 8, rr = r & 255, kb = rr >> 5, nb = rr & 31;
        t.src = a.in[I_WDOWN] + (size_t)e * 512 * 2048 + (size_t)(64 * kb + kr) * 2048 + 64 * nb + n4; t.ldw = 2048;
        t.dst = (bf16*)(ws + WS_WD) + (size_t)(e * 2048 + 64 * nb) * 512 + 64 * kb; t.ldt = 512; }
}
__device__ __forceinline__ void tt_lds_in(const f32x4 (&v)[16], LAS float* scr, int kr, int n4) {
#pragma unroll
    for (int i = 0; i < 16; ++i) { LAS float* d = scr + (4 * i + kr) * 65 + n4; d[0] = v[i][0]; d[1] = v[i][1]; d[2] = v[i][2]; d[3] = v[i][3]; }
    LDS_WAIT();
}
__device__ __forceinline__ void tt_lds_out(const TTItem& t, const LAS float* scr, int lane) {
    const int c = lane & 7;
#pragma unroll
    for (int j = 0; j < 8; ++j) { const int nn = 8 * j + (lane >> 3); const LAS float* s = scr + (8 * c) * 65 + nn;
        u32x4 o; o.x = cvt_pk_bf16(s[0 * 65], s[1 * 65]); o.y = cvt_pk_bf16(s[2 * 65], s[3 * 65]); o.z = cvt_pk_bf16(s[4 * 65], s[5 * 65]); o.w = cvt_pk_bf16(s[6 * 65], s[7 * 65]);
        *(u32x4*)(t.dst + (size_t)nn * t.ldt + 8 * c) = o; }
    LDS_WAIT();
}
__device__ __forceinline__ void tt_load(f32x4 (&v)[16], const TTItem& t) {
#pragma unroll
    for (int i = 0; i < 16; ++i) v[i] = *(const f32x4*)(t.src + (size_t)(4 * i) * t.ldw);
}
__device__ __forceinline__ void moe_convert(const Args& a, LAS unsigned char* lds) {
    const int tid = threadIdx.x, lane = tid & 63, wave = __builtin_amdgcn_readfirstlane(tid >> 6);
    LAS float* scr = (LAS float*)(lds + wave * 16640);
    unsigned* q = (unsigned*)(a.ws + WS_CTL) + CW_Q;
    constexpr int NIT = 3 * 64 * 256, CH = 8;
    const int kr = lane >> 4, n4 = (lane & 15) * 4;
    f32x4 v[16]; TTItem cur, nxt;
    for (;;) {
        unsigned base = 0u;
        if (lane == 0) base = __hip_atomic_fetch_add(q, (unsigned)CH, __ATOMIC_RELAXED, __HIP_MEMORY_SCOPE_AGENT);
        const int i0 = (int)__builtin_amdgcn_readfirstlane(base);
        if (i0 >= NIT) break;
        moe_item(a, i0, lane, cur); tt_load(v, cur);
#pragma unroll 1
        for (int k = 0; k < CH; ++k) {
            tt_lds_in(v, scr, kr, n4);
            if (k + 1 < CH) { moe_item(a, i0 + k + 1, lane, nxt); tt_load(v, nxt); }
            tt_lds_out(cur, scr, lane);
            cur = nxt;
        }
    }
}

template <bool FROM_PART>
__device__ __forceinline__ void norm_mod_phase(const Args& a, LAS unsigned char* lds, const float* xin, const float* gvec, int sh_chunk, int sc_chunk, bf16* outp) {
    const int tid = threadIdx.x, lane = tid & 63, wave = __builtin_amdgcn_readfirstlane(tid >> 6);
    LAS float* Av = (LAS float*)lds; LAS float* Bv = Av + 2048;
    const float* modp = (const float*)(a.ws + WS_MODP); const float* mod = (const float*)(a.ws + WS_MOD); const float* bada = a.in[I_BADA];
    int prev_b = -1;
    for (int rb = blockIdx.x; rb < M / 64; rb += gridDim.x) {
        const int b = rb >> 5;
        if (b != prev_b) {
            __syncthreads();
            for (int j = tid; j < 2048; j += 512) { float sh, sc;
                if (FROM_PART) { sh = bada[sh_chunk * 2048 + j]; sc = bada[sc_chunk * 2048 + j];
#pragma unroll
                    for (int kq = 0; kq < 4; ++kq) { sh += modp[((size_t)kq * 8 + b) * 12288 + sh_chunk * 2048 + j]; sc += modp[((size_t)kq * 8 + b) * 12288 + sc_chunk * 2048 + j]; } }
                else { sh = mod[b * 12288 + sh_chunk * 2048 + j]; sc = mod[b * 12288 + sc_chunk * 2048 + j]; }
                Av[j] = gvec[j] * (1.f + sc); Bv[j] = sh; }
            __syncthreads(); prev_b = b;
        }
        for (int rr = wave; rr < 64; rr += 2 * NWAVES) {
            const int row0 = rb * 64 + rr, row1 = row0 + NWAVES;
            const f32x4* xr0 = (const f32x4*)(xin + (size_t)row0 * D) + lane; const f32x4* xr1 = (const f32x4*)(xin + (size_t)row1 * D) + lane;
            f32x4 v0[8], v1[8]; float s0 = 0.f, s1 = 0.f;
#pragma unroll
            for (int j = 0; j < 8; ++j) { v0[j] = xr0[64 * j]; v1[j] = xr1[64 * j]; }
#pragma unroll
            for (int j = 0; j < 8; ++j) { s0 += (v0[j][0] * v0[j][0] + v0[j][1] * v0[j][1]) + (v0[j][2] * v0[j][2] + v0[j][3] * v0[j][3]); s1 += (v1[j][0] * v1[j][0] + v1[j][1] * v1[j][1]) + (v1[j][2] * v1[j][2] + v1[j][3] * v1[j][3]); }
#pragma unroll
            for (int o = 1; o < 64; o <<= 1) { s0 += __shfl_xor(s0, o); s1 += __shfl_xor(s1, o); }
            const float r0 = rsqrtf(s0 * (1.f / 2048.f) + EPS), r1 = rsqrtf(s1 * (1.f / 2048.f) + EPS);
            u32x2* o0 = (u32x2*)(outp + (size_t)row0 * D) + lane; u32x2* o1 = (u32x2*)(outp + (size_t)row1 * D) + lane;
#pragma unroll
            for (int j = 0; j < 8; ++j) { const int col = 4 * lane + 256 * j; const f32x4 A4 = *(const LAS f32x4*)(Av + col), B4 = *(const LAS f32x4*)(Bv + col);
                const f32x4 y0 = v0[j] * r0 * A4 + B4, y1 = v1[j] * r1 * A4 + B4; u32x2 w0, w1; w0.x = cvt_pk_bf16(y0[0], y0[1]); w0.y = cvt_pk_bf16(y0[2], y0[3]); w1.x = cvt_pk_bf16(y1[0], y1[1]); w1.y = cvt_pk_bf16(y1[2], y1[3]);
                o0[64 * j] = w0; o1[64 * j] = w1; }
        }
    }
    if (FROM_PART) {
        { const float* bp = (const float*)(a.ws + WS_BIAS1P);
          for (int o = blockIdx.x * NWAVES + wave; o < 512; o += gridDim.x * NWAVES) { const int ten = o >> 8, n = o & 255;
              const float sb = wave_sum(bp[(size_t)(ten * 64 + lane) * 256 + n]);
              if (lane == 0) ((float*)(a.ws + (ten ? WS_BIAS1V : WS_BIAS1K)))[n] = sb; } }
        float* modw = (float*)(a.ws + WS_MOD);
        for (int idx = blockIdx.x * 512 + tid; idx < 8 * 12288; idx += gridDim.x * 512) { const int b = idx / 12288, j = idx % 12288; float s = bada[j];
#pragma unroll
            for (int kq = 0; kq < 4; ++kq) s += modp[((size_t)kq * 8 + b) * 12288 + j];
            modw[idx] = s; }
    }
}

__device__ __forceinline__ void transpose_out(const LAS unsigned short* tl, int pitch, int C, bf16* dst, size_t ldT, int tid) {
    for (int idx = tid; idx < C * 8; idx += 512) { const int cc = idx >> 3, tc = (idx & 7) * 8;
        unsigned e[8];
#pragma unroll
        for (int i = 0; i < 8; ++i) e[i] = tl[(tc + i) * pitch + cc];
        u32x4 o; o.x = e[0] | (e[1] << 16); o.y = e[2] | (e[3] << 16); o.z = e[4] | (e[5] << 16); o.w = e[6] | (e[7] << 16);
        *(u32x4*)(dst + (size_t)cc * ldT + tc) = o; }
}
__device__ __forceinline__ void rot8(const u32x4 x1, const u32x4 x2, const float* cosT, const float* sinT, int t, int jc, float (&o1)[8], float (&o2)[8]) {
    const f32x4 c0 = *(const f32x4*)(cosT + t * 128 + jc), c1 = *(const f32x4*)(cosT + t * 128 + jc + 4), s0 = *(const f32x4*)(sinT + t * 128 + jc), s1 = *(const f32x4*)(sinT + t * 128 + jc + 4);
    const float a1[8] = {bflo(x1.x), bfhi(x1.x), bflo(x1.y), bfhi(x1.y), bflo(x1.z), bfhi(x1.z), bflo(x1.w), bfhi(x1.w)};
    const float a2[8] = {bflo(x2.x), bfhi(x2.x), bflo(x2.y), bfhi(x2.y), bflo(x2.z), bfhi(x2.z), bflo(x2.w), bfhi(x2.w)};
    const float cs[8] = {c0[0], c0[1], c0[2], c0[3], c1[0], c1[1], c1[2], c1[3]}, sn[8] = {s0[0], s0[1], s0[2], s0[3], s1[0], s1[1], s1[2], s1[3]};
#pragma unroll
    for (int i = 0; i < 8; ++i) { o1[i] = a1[i] * cs[i] - a2[i] * sn[i]; o2[i] = a1[i] * sn[i] + a2[i] * cs[i]; }
}
__device__ __forceinline__ u32x4 pack8f(const float (&o)[8], float sc) { u32x4 w; w.x = cvt_pk_bf16(o[0] * sc, o[1] * sc); w.y = cvt_pk_bf16(o[2] * sc, o[3] * sc); w.z = cvt_pk_bf16(o[4] * sc, o[5] * sc); w.w = cvt_pk_bf16(o[6] * sc, o[7] * sc); return w; }

template <class DR>
__device__ __forceinline__ void transpose_out_w(const LAS unsigned short* tl, bf16* dst, size_t ldT, int lane, DR drow) {
#pragma unroll
    for (int i = 0; i < 8; ++i) { const int idx = lane + 64 * i, cc = idx >> 3, tc = (idx & 7) * 8;
        unsigned e[8];
#pragma unroll
        for (int k = 0; k < 8; ++k) e[k] = tl[(tc + k) * 66 + cc];
        u32x4 o; o.x = e[0] | (e[1] << 16); o.y = e[2] | (e[3] << 16); o.z = e[4] | (e[5] << 16); o.w = e[6] | (e[7] << 16);
        *(u32x4*)(dst + (size_t)drow(cc) * ldT + tc) = o; }
}
__device__ __forceinline__ void lds_put8(LAS unsigned short* p, const u32x4 v) { LAS unsigned* d = (LAS unsigned*)p; d[0] = v.x; d[1] = v.y; d[2] = v.z; d[3] = v.w; }

__device__ __forceinline__ void phase3(const Args& a, LAS unsigned char* lds) {
    const int tid = threadIdx.x, lane = tid & 63, wave = __builtin_amdgcn_readfirstlane(tid >> 6);
    unsigned char* ws = a.ws;
    const bf16* proj = (const bf16*)(ws + WS_PROJ);
    const float* cosT = (const float*)(ws + WS_COS); const float* sinT = (const float*)(ws + WS_SIN);
    LAS unsigned short* tl = (LAS unsigned short*)(lds + wave * 16640);
    const int gw = blockIdx.x * NWAVES + wave, NGW = gridDim.x * NWAVES;
    for (int wi = gw; wi < NB * 32 * 64; wi += NGW) {
        const int tile = wi >> 6, sub = wi & 63, b = tile >> 5, t0 = (tile & 31) * 64;
        const bf16* pr = proj + (size_t)(b * T + t0) * NP;
        if (sub < 32) {
            const bool isk = sub < 16; const int h = (sub >> 2) & 3, jg = sub & 3;
            const float zl = ret_lg(h);
            bf16* dstrow = (bf16*)(ws + (isk ? WS_KR : WS_QR)) + ((size_t)(b * 4 + h) * T + t0) * 256;
#pragma unroll
            for (int i = 0; i < 4; ++i) { const int idx = lane + 64 * i, tk = idx >> 2, jc = jg * 32 + (idx & 3) * 8, t = t0 + tk;
                const bf16* p = pr + (size_t)tk * NP + (isk ? C_RK : C_RQ) + h * 256 + jc;
                float o1[8], o2[8];
                rot8(*(const u32x4*)p, *(const u32x4*)(p + 128), cosT, sinT, t, jc, o1, o2);
                const float sc = isk ? 0.0625f : 1.f;
                bf16* d = dstrow + (size_t)tk * 256 + jc;
                *(u32x4*)d = pack8f(o1, sc); *(u32x4*)(d + 128) = pack8f(o2, sc);
                if (isk) { const float zs = 0.0625f * __expf(zl * (float)(127 - (t & 127)));
                    lds_put8(tl + tk * 66 + (idx & 3) * 8, pack8f(o1, zs)); lds_put8(tl + tk * 66 + 32 + (idx & 3) * 8, pack8f(o2, zs)); } }
            if (isk) { LDS_WAIT();
                transpose_out_w(tl, (bf16*)(ws + WS_KZT) + ((size_t)(b * 4 + h) * 256) * T + t0, T, lane, [=](int cc) { return cc < 32 ? jg * 32 + cc : 128 + jg * 32 + (cc - 32); });
                LDS_WAIT(); }
        } else if (sub < 48 || sub >= 56) {
            int scol; bf16* dst;
            if (sub < 48) { const int h = (sub >> 2) & 3, cg = sub & 3; scol = C_RV + h * 256 + cg * 64; dst = (bf16*)(ws + WS_VT) + ((size_t)(b * 4 + h) * 256 + cg * 64) * T + t0; }
            else { const int g = (sub >> 2) & 1, sel = (sub >> 1) & 1, cg = sub & 1; scol = (sel ? C_VW : C_VS) + g * 128 + cg * 64; dst = (bf16*)(ws + (sel ? WS_VWT : WS_VST)) + ((size_t)(b * 2 + g) * 128 + cg * 64) * T + t0; }
#pragma unroll
            for (int i = 0; i < 8; ++i) { const int idx = lane + 64 * i, tk = idx >> 3, dc = (idx & 7) * 8;
                lds_put8(tl + tk * 66 + dc, *(const u32x4*)(pr + (size_t)tk * NP + scol + dc)); }
            LDS_WAIT();
            transpose_out_w(tl, dst, T, lane, [](int cc) { return cc; });
            LDS_WAIT();
        } else {
            const int g = (sub >> 2) & 1, ten = (sub >> 1) & 1, cg = sub & 1;
            bf16* dst = (bf16*)(ws + (ten ? WS_VCMP : WS_KCMP)) + ((size_t)(b * 2 + g) * T + t0) * 128 + cg * 64;
#pragma unroll
            for (int i = 0; i < 8; ++i) { const int idx = lane + 64 * i, tk = idx >> 3, dc = (idx & 7) * 8;
                *(u32x4*)(dst + (size_t)tk * 128 + dc) = *(const u32x4*)(pr + (size_t)tk * NP + (ten ? C_VC : C_KC) + g * 128 + cg * 64 + dc); }
        }
    }
}

__device__ __forceinline__ void phase4(const Args& a, LAS unsigned char* lds) {
    const int tid = threadIdx.x, lane = tid & 63, wave = __builtin_amdgcn_readfirstlane(tid >> 6), q = lane >> 4, r = lane & 15;
    unsigned char* ws = a.ws;
    {
        const bf16* VT = (const bf16*)(ws + WS_VT); const bf16* KzT = (const bf16*)(ws + WS_KZT); bf16* SP = (bf16*)(ws + WS_SP);
        for (int it = blockIdx.x; it < 256; it += gridDim.x) {
            const int b = it >> 5, h = (it >> 3) & 3, es = it & 7;
            const float cd = __expf(ret_lg(h) * 128.f);
            const bf16* VTb = VT + ((size_t)(b * 4 + h) * 256 + es * 32) * T;
            const bf16* KzTb = KzT + ((size_t)(b * 4 + h) * 256 + wave * 32) * T;
            bf16* Sp = SP + (size_t)(b * 4 + h) * 16 * 65536;
            f32x4 S[2][2];
#pragma unroll
            for (int mt = 0; mt < 2; ++mt)
#pragma unroll
                for (int nt = 0; nt < 2; ++nt) S[mt][nt] = (f32x4){0.f, 0.f, 0.f, 0.f};
            for (int n = 0; n < 16; ++n) {
#pragma unroll
                for (int mt = 0; mt < 2; ++mt)
#pragma unroll
                    for (int nt = 0; nt < 2; ++nt) { const int e = es * 32 + 16 * mt + r, d = wave * 32 + 16 * nt + 4 * q;
                        u32x2 w; w.x = cvt_pk_bf16(S[mt][nt][0], S[mt][nt][1]); w.y = cvt_pk_bf16(S[mt][nt][2], S[mt][nt][3]);
                        *(u32x2*)(Sp + ((size_t)n * 256 + e) * 256 + d) = w; }
                if (n == 15) break;
#pragma unroll
                for (int mt = 0; mt < 2; ++mt)
#pragma unroll
                    for (int nt = 0; nt < 2; ++nt) S[mt][nt] = S[mt][nt] * cd;
#pragma unroll
                for (int k0 = 0; k0 < 128; k0 += 32) {
                    bf16x8 af[2], bfr[2];
#pragma unroll
                    for (int mt = 0; mt < 2; ++mt) af[mt] = *(const bf16x8*)(VTb + (size_t)(16 * mt + r) * T + n * 128 + k0 + 8 * q);
#pragma unroll
                    for (int nt = 0; nt < 2; ++nt) bfr[nt] = *(const bf16x8*)(KzTb + (size_t)(16 * nt + r) * T + n * 128 + k0 + 8 * q);
#pragma unroll
                    for (int mt = 0; mt < 2; ++mt)
#pragma unroll
                        for (int nt = 0; nt < 2; ++nt) S[mt][nt] = MFMA16(bfr[nt], af[mt], S[mt][nt]);
                }
            }
        }
    }
    {
        const int gw = blockIdx.x * NWAVES + wave, NGW = gridDim.x * NWAVES;
        for (int wi = gw; wi < 2048; wi += NGW) { const int ten = wi >> 10, rt = (wi >> 4) & 63, ct = wi & 15;
            const bf16* A = (const bf16*)(ws + (ten ? WS_VCMP : WS_KCMP)) + (size_t)(rt * 32) * 2048;
            const bf16* Bt = (const bf16*)(ws + (ten ? WS_W1V : WS_W1K)) + (size_t)(ct * 32) * 2048;
            f32x4 acc[2][2];
#pragma unroll
            for (int mt = 0; mt < 2; ++mt)
#pragma unroll
                for (int nt = 0; nt < 2; ++nt) acc[mt][nt] = (f32x4){0.f, 0.f, 0.f, 0.f};
#pragma unroll 2
            for (int k0 = 0; k0 < 2048; k0 += 32) {
                bf16x8 af[2], bfr[2];
#pragma unroll
                for (int mt = 0; mt < 2; ++mt) af[mt] = *(const bf16x8*)(A + (size_t)(16 * mt + r) * 2048 + k0 + 8 * q);
#pragma unroll
                for (int nt = 0; nt < 2; ++nt) bfr[nt] = *(const bf16x8*)(Bt + (size_t)(16 * nt + r) * 2048 + k0 + 8 * q);
#pragma unroll
                for (int mt = 0; mt < 2; ++mt)
#pragma unroll
                    for (int nt = 0; nt < 2; ++nt) acc[mt][nt] = MFMA16(bfr[nt], af[mt], acc[mt][nt]);
            }
            float* Y = (float*)(ws + (ten ? WS_YV : WS_YK));
#pragma unroll
            for (int mt = 0; mt < 2; ++mt)
#pragma unroll
                for (int nt = 0; nt < 2; ++nt) *(f32x4*)(Y + (size_t)(rt * 32 + 16 * mt + r) * 512 + ct * 32 + 16 * nt + 4 * q) = acc[mt][nt];
        }
    }
}

__device__ __forceinline__ void phase5(const Args& a, LAS unsigned char* lds) {
    const int tid = threadIdx.x, lane = tid & 63, wave = __builtin_amdgcn_readfirstlane(tid >> 6), q = lane >> 4, r = lane & 15;
    unsigned char* ws = a.ws;
    const int gw = blockIdx.x * NWAVES + wave, NGW = gridDim.x * NWAVES;
    for (int wi = gw; wi < 256; wi += NGW) { const int ten = wi >> 7, rt = wi & 127, row = rt * 16 + r, c = row & 127;
        const float* Y = (const float*)(ws + (ten ? WS_YV : WS_YK)); const float* bias = (const float*)(ws + (ten ? WS_BIAS1V : WS_BIAS1K));
        const bf16* W2T = (const bf16*)(ws + (ten ? WS_W2VT : WS_W2KT));
        f32x4 acc[8];
#pragma unroll
        for (int nt = 0; nt < 8; ++nt) acc[nt] = (f32x4){0.f, 0.f, 0.f, 0.f};
#pragma unroll
        for (int k0 = 0; k0 < 256; k0 += 32) { const int kk = k0 + 8 * q;
            bf16x8 af = (bf16x8){0, 0, 0, 0, 0, 0, 0, 0};
            if (c < 127) {
                const f32x4 y0 = *(const f32x4*)(Y + (size_t)row * 512 + kk), y1 = *(const f32x4*)(Y + (size_t)row * 512 + kk + 4);
                const f32x4 z0 = *(const f32x4*)(Y + (size_t)(row + 1) * 512 + 256 + kk), z1 = *(const f32x4*)(Y + (size_t)(row + 1) * 512 + 256 + kk + 4);
                const f32x4 b0 = *(const f32x4*)(bias + kk), b1 = *(const f32x4*)(bias + kk + 4);
                f32x4 h0 = y0 + z0 + b0, h1 = y1 + z1 + b1;
#pragma unroll
                for (int i = 0; i < 4; ++i) { h0[i] = silu_f(h0[i]); h1[i] = silu_f(h1[i]); }
                af = pack8(h0, h1);
            }
#pragma unroll
            for (int nt = 0; nt < 8; ++nt) { const bf16x8 bfr = *(const bf16x8*)(W2T + (size_t)(16 * nt + r) * 256 + kk); acc[nt] = MFMA16(bfr, af, acc[nt]); }
        }
        if (!ten) { bf16* kc = (bf16*)(ws + WS_KC);
#pragma unroll
            for (int nt = 0; nt < 8; ++nt) { u32x2 w; w.x = cvt_pk_bf16(acc[nt][0], acc[nt][1]); w.y = cvt_pk_bf16(acc[nt][2], acc[nt][3]); *(u32x2*)(kc + (size_t)row * 128 + 16 * nt + 4 * q) = w; }
        } else { bf16* vct = (bf16*)(ws + WS_VCT);
#pragma unroll
            for (int nt = 0; nt < 8; ++nt)
#pragma unroll
                for (int j = 0; j < 4; ++j) vct[((size_t)(row >> 7) * 128 + 16 * nt + 4 * q + j) * 128 + c] = (bf16)(cvt_pk_bf16(acc[nt][j], 0.f) & 0xffffu);
        }
    }
}

constexpr int R2_KP = 528, R2_VP = 272, R2_VOFF = 128 * R2_KP;
__device__ __forceinline__ void r2_item(const Args& a, LAS unsigned char* lds, int it) {
    int tid = threadIdx.x; asm volatile("" : "+v"(tid));
    const int lane = tid & 63, wave = __builtin_amdgcn_readfirstlane(tid >> 6), q = lane >> 4, r = lane & 15;
    unsigned char* ws = a.ws;
    const int b = it >> 6, h = (it >> 4) & 3, n = it & 15;
    const float lg = ret_lg(h);
    const int ti = 16 * wave + r;
    const bf16* Qrow = (const bf16*)(ws + WS_QR) + ((size_t)(b * 4 + h) * T + n * 128 + ti) * 256;
    const bf16* Kb = (const bf16*)(ws + WS_KR) + ((size_t)(b * 4 + h) * T + n * 128) * 256;
    const bf16* VTb = (const bf16*)(ws + WS_VT) + ((size_t)(b * 4 + h) * 256) * T + n * 128;
    const bf16* Sp = (const bf16*)(ws + WS_SP) + ((size_t)(b * 4 + h) * 16 + n) * 65536;
    LAS unsigned char* KS = lds; LAS unsigned char* VS = lds + R2_VOFF;
    bf16x8 qf[8];
#pragma unroll
    for (int ks = 0; ks < 8; ++ks) qf[ks] = *(const bf16x8*)(Qrow + 32 * ks + 8 * q);
    __syncthreads();
#pragma unroll
    for (int i = 0; i < 8; ++i) { const int c = tid + 512 * i, row = c >> 5, c16 = c & 31; *(LAS u32x4*)(KS + row * R2_KP + c16 * 16) = *(const u32x4*)(Kb + (size_t)row * 256 + c16 * 8); }
    __syncthreads();
    f32x4 s[8];
#pragma unroll
    for (int nt = 0; nt < 8; ++nt) s[nt] = (f32x4){0.f, 0.f, 0.f, 0.f};
#pragma unroll
    for (int ks = 0; ks < 8; ++ks)
#pragma unroll
        for (int nt = 0; nt < 8; ++nt) { const bf16x8 bfr = *(const LAS bf16x8*)(KS + (16 * nt + r) * R2_KP + (32 * ks + 8 * q) * 2); s[nt] = MFMA16(bfr, qf[ks], s[nt]); }
    bf16x8 pf[4];
#pragma unroll
    for (int nt = 0; nt < 8; ++nt)
#pragma unroll
        for (int j = 0; j < 4; ++j) { const int dd = ti - (16 * nt + 4 * q + j); s[nt][j] = dd >= 0 ? s[nt][j] * __expf(lg * (float)dd) : 0.f; }
#pragma unroll
    for (int ks = 0; ks < 4; ++ks) pf[ks] = pack8(s[2 * ks], s[2 * ks + 1]);
    const float qd = __expf(lg * (float)(ti + 1));
    f32x4 o[16];
#pragma unroll
    for (int hf = 0; hf < 2; ++hf) {
        __syncthreads();
#pragma unroll
        for (int i = 0; i < 8; ++i) { const int c = tid + 512 * i, row = c >> 5, c16 = c & 31; *(LAS u32x4*)(KS + row * R2_KP + c16 * 16) = *(const u32x4*)(Sp + (size_t)(128 * hf + row) * 256 + c16 * 8); }
#pragma unroll
        for (int i = 0; i < 4; ++i) { const int c = tid + 512 * i, row = c >> 4, c16 = c & 15; *(LAS u32x4*)(VS + row * R2_VP + c16 * 16) = *(const u32x4*)(VTb + (size_t)(128 * hf + row) * T + c16 * 8); }
        __syncthreads();
#pragma unroll
        for (int nt = 0; nt < 8; ++nt) o[8 * hf + nt] = (f32x4){0.f, 0.f, 0.f, 0.f};
#pragma unroll
        for (int ks = 0; ks < 8; ++ks)
#pragma unroll
            for (int nt = 0; nt < 8; ++nt) { const bf16x8 bfr = *(const LAS bf16x8*)(KS + (16 * nt + r) * R2_KP + (32 * ks + 8 * q) * 2); o[8 * hf + nt] = MFMA16(bfr, qf[ks], o[8 * hf + nt]); }
#pragma unroll
        for (int nt = 0; nt < 8; ++nt) o[8 * hf + nt] = o[8 * hf + nt] * qd;
#pragma unroll
        for (int ks = 0; ks < 4; ++ks)
#pragma unroll
            for (int nt = 0; nt < 8; ++nt) { const LAS unsigned char* vp = VS + (16 * nt + r) * R2_VP + (32 * ks + 4 * q) * 2;
                const bf16x8 vf = cat4(*(const LAS bf16x4*)vp, *(const LAS bf16x4*)(vp + 32)); o[8 * hf + nt] = MFMA16(vf, pf[ks], o[8 * hf + nt]); }
    }
    float sm = 0.f;
#pragma unroll
    for (int nt = 0; nt < 16; ++nt) sm += (o[nt][0] + o[nt][1]) + (o[nt][2] + o[nt][3]);
    sm += __shfl_xor(sm, 16); sm += __shfl_xor(sm, 32);
    const float mu = sm * (1.f / 256.f); float vs = 0.f;
#pragma unroll
    for (int nt = 0; nt < 16; ++nt) { const f32x4 d = o[nt] - mu; vs += (d[0] * d[0] + d[1] * d[1]) + (d[2] * d[2] + d[3] * d[3]); }
    vs += __shfl_xor(vs, 16); vs += __shfl_xor(vs, 32);
    const float rstd = rsqrtf(vs * (1.f / 256.f) + EPS);
    const size_t rowg = (size_t)b * T + n * 128 + ti;
    const bf16* gp = (const bf16*)(ws + WS_PROJ) + rowg * NP + C_RG + h * 256;
    const float* gn = a.in[I_GNG] + h * 256;
    bf16* op = (bf16*)(ws + WS_CAT) + rowg * 2048 + h * 256;
#pragma unroll
    for (int nt = 0; nt < 16; ++nt) { const int e = 16 * nt + 4 * q;
        const u32x2 gw2 = *(const u32x2*)(gp + e); const f32x4 g4 = *(const f32x4*)(gn + e);
        const float g0 = bflo(gw2.x), g1 = bfhi(gw2.x), g2 = bflo(gw2.y), g3 = bfhi(gw2.y);
        const float y0 = (o[nt][0] - mu) * rstd * g4[0] * silu_f(g0), y1 = (o[nt][1] - mu) * rstd * g4[1] * silu_f(g1);
        const float y2 = (o[nt][2] - mu) * rstd * g4[2] * silu_f(g2), y3 = (o[nt][3] - mu) * rstd * g4[3] * silu_f(g3);
        u32x2 w; w.x = cvt_pk_bf16(y0, y1); w.y = cvt_pk_bf16(y2, y3); *(u32x2*)(op + e) = w; }
}

constexpr float NSA_SCL = 0.08838834764831845f * 1.4426950408889634f;
constexpr int QP = 272, KP = 272, VP = 136, VCP = 264;
#ifndef NSA_NBR
#define NSA_NBR 2
#endif
constexpr int NSA_QS = 0, NSA_KS = 69632, NSA_VS = NSA_KS + 34816;

template <int S> __device__ __forceinline__ bf16x8 pack_step(const f32x16& x) {
    u32x4 p; p.x = cvt_pk_bf16(x[8 * S], x[8 * S + 1]); p.y = cvt_pk_bf16(x[8 * S + 2], x[8 * S + 3]); p.z = cvt_pk_bf16(x[8 * S + 4], x[8 * S + 5]); p.w = cvt_pk_bf16(x[8 * S + 6], x[8 * S + 7]);
    return __builtin_bit_cast(bf16x8, p);
}
__device__ __forceinline__ f32x16 zero16() { f32x16 z;
#pragma unroll
    for (int i = 0; i < 16; ++i) z[i] = 0.f;
    return z; }

__device__ __forceinline__ void attn_tile(const LAS unsigned char* qrow, const LAS unsigned char* Ks, const LAS unsigned char* Vs, int r, int h, float& m, float& l, f32x16 (&O)[4], int lo, int hi) {
    f32x16 st[2]; st[0] = zero16(); st[1] = zero16();
#pragma unroll
    for (int ks = 0; ks < 8; ++ks) { const bf16x8 qf = *(const LAS bf16x8*)(qrow + (16 * ks + 8 * h) * 2);
#pragma unroll
        for (int kb = 0; kb < 2; ++kb) { const bf16x8 kf = *(const LAS bf16x8*)(Ks + (32 * kb + r) * KP + (16 * ks + 8 * h) * 2); st[kb] = MFMA32(kf, qf, st[kb]); }
        if (ks & 1) asm volatile("" ::: "memory"); }
    float tmax = -1e30f;
#pragma unroll
    for (int kb = 0; kb < 2; ++kb)
#pragma unroll
        for (int reg = 0; reg < 16; ++reg) { constexpr int dummy = 0; (void)dummy; const int KC = 32 * kb + (reg & 3) + 8 * (reg >> 2); const float v = (KC > lo && KC <= hi) ? st[kb][reg] * NSA_SCL : -1e30f; st[kb][reg] = v; tmax = fmaxf(tmax, v); }
    tmax = fmaxf(tmax, __shfl_xor(tmax, 32));
    const float mn = fmaxf(m, tmax), alpha = __builtin_amdgcn_exp2f(m - mn);
    float rs = 0.f;
#pragma unroll
    for (int kb = 0; kb < 2; ++kb)
#pragma unroll
        for (int reg = 0; reg < 16; ++reg) { const float v = st[kb][reg]; const float p = v > -1e29f ? __builtin_amdgcn_exp2f(v - mn) : 0.f; st[kb][reg] = p; rs += p; }
    rs += __shfl_xor(rs, 32);
    l = l * alpha + rs; m = mn;
#pragma unroll
    for (int eb = 0; eb < 4; ++eb) O[eb] = O[eb] * alpha;
#pragma unroll
    for (int kb = 0; kb < 2; ++kb) {
        { const bf16x8 pf = pack_step<0>(st[kb]);
#pragma unroll
          for (int eb = 0; eb < 4; ++eb) { const LAS unsigned char* vp = Vs + (32 * eb + r) * VP + (32 * kb + 4 * h) * 2; const bf16x8 vf = cat4(*(const LAS bf16x4*)vp, *(const LAS bf16x4*)(vp + 16)); O[eb] = MFMA32(vf, pf, O[eb]); } }
        asm volatile("" ::: "memory");
        { const bf16x8 pf = pack_step<1>(st[kb]);
#pragma unroll
          for (int eb = 0; eb < 4; ++eb) { const LAS unsigned char* vp = Vs + (32 * eb + r) * VP + (32 * kb + 16 + 4 * h) * 2; const bf16x8 vf = cat4(*(const LAS bf16x4*)vp, *(const LAS bf16x4*)(vp + 16)); O[eb] = MFMA32(vf, pf, O[eb]); } }
        asm volatile("" ::: "memory");
    }
}

__device__ __forceinline__ void nsa_item(const Args& a, LAS unsigned char* lds, int item) {
    int tid = threadIdx.x; asm volatile("" : "+v"(tid));
    const int lane = tid & 63, w = __builtin_amdgcn_readfirstlane(tid >> 6), h = lane >> 5, r = lane & 31;
    unsigned char* ws = a.ws;
    const int bg = item & 15, qk = item >> 4, qt = qk < 16 ? 31 - qk : qk - 16, b = bg >> 1, g = bg & 1, t0 = qt * 64, cur = qt;
    const bf16* proj = (const bf16*)(ws + WS_PROJ);
    LAS unsigned char* Qs = lds + NSA_QS; LAS unsigned char* Ks = lds + NSA_KS; LAS unsigned char* Vs = lds + NSA_VS;
    LAS unsigned* bmask = (LAS unsigned*)(lds + MISC_OFF + 64);
    const int tok = t0 + 8 * w + (r >> 2), head = r & 3;
    const LAS unsigned char* qrow = Qs + (32 * w + r) * QP;
    __syncthreads();
    if (tid == 0) *bmask = 0u;
    for (int ch = tid; ch < 4096; ch += 512) { const int row = ch >> 4, dc = (ch & 15) * 8;
        *(LAS u32x4*)(Qs + row * QP + dc * 2) = *(const u32x4*)(proj + (size_t)(b * T + t0 + (row >> 2)) * NP + C_NQ + (g * 4 + (row & 3)) * 128 + dc); }
    { const bf16* kc = (const bf16*)(ws + WS_KC) + (size_t)bg * 16384; const bf16* vct = (const bf16*)(ws + WS_VCT) + (size_t)bg * 16384;
      for (int ch = tid; ch < 2048; ch += 512) { const int row = ch >> 4, dc = (ch & 15) * 8;
          *(LAS u32x4*)(Ks + row * KP + dc * 2) = *(const u32x4*)(kc + row * 128 + dc);
          const u32x4 v = *(const u32x4*)(vct + row * 128 + dc); LAS u32x2* d = (LAS u32x2*)(Vs + row * VCP + dc * 2); d[0] = (u32x2){v.x, v.y}; d[1] = (u32x2){v.z, v.w}; } }
    __syncthreads();
    float gt0, gt1, gt2;
    { const bf16* gp = proj + (size_t)(b * T + tok) * NP + C_NG + (g * 4 + head) * 3; gt0 = sigmoid_f(bf2f(gp[0])); gt1 = sigmoid_f(bf2f(gp[1])); gt2 = sigmoid_f(bf2f(gp[2])); }
    unsigned selmask;
    bf16* op = (bf16*)(ws + WS_CAT) + (size_t)(b * T + tok) * 2048 + 1024 + (g * 4 + head) * 128;
    {
        f32x16 st[4]; f32x16 Ot[4];
#pragma unroll
        for (int kb = 0; kb < 4; ++kb) st[kb] = zero16();
#pragma unroll
        for (int ks = 0; ks < 8; ++ks) { const bf16x8 qf = *(const LAS bf16x8*)(qrow + (16 * ks + 8 * h) * 2);
#pragma unroll
            for (int kb = 0; kb < 4; ++kb) { const bf16x8 kf = *(const LAS bf16x8*)(Ks + (32 * kb + r) * KP + (16 * ks + 8 * h) * 2); st[kb] = MFMA32(kf, qf, st[kb]); }
            asm volatile("" ::: "memory"); }
        float mx = -1e30f;
        const int clim = (tok - 31) >> 4;
        const int climh = (clim < 126 ? clim : 126) - 4 * h;
#pragma unroll
        for (int kb = 0; kb < 4; ++kb)
#pragma unroll
            for (int reg = 0; reg < 16; ++reg) { const int KC = 32 * kb + (reg & 3) + 8 * (reg >> 2);
                const float v = (KC <= climh) ? st[kb][reg] * NSA_SCL : -1e30f; st[kb][reg] = v; mx = fmaxf(mx, v); }
        mx = fmaxf(mx, __shfl_xor(mx, 32));
        float sm = 0.f;
#pragma unroll
        for (int kb = 0; kb < 4; ++kb)
#pragma unroll
            for (int reg = 0; reg < 16; ++reg) { const float v = st[kb][reg]; const float p = v > -1e29f ? __builtin_amdgcn_exp2f(v - mx) : 0.f; st[kb][reg] = p; sm += p; }
        sm += __shfl_xor(sm, 32);
        const float inv = sm > 0.f ? 1.f / sm : 0.f;
#pragma unroll
        for (int kb = 0; kb < 4; ++kb) st[kb] = st[kb] * inv;
        float imp[16], lastv[16];
#pragma unroll
        for (int i = 0; i < 16; ++i) { const int kb = i >> 2, rq = i & 3; imp[i] = (st[kb][4 * rq] + st[kb][4 * rq + 1]) + (st[kb][4 * rq + 2] + st[kb][4 * rq + 3]); lastv[i] = __shfl_xor(st[kb][4 * rq + 3], 32); }
#pragma unroll
        for (int i = 0; i < 16; ++i) { const float prev = h ? lastv[i] : (i > 0 ? lastv[i > 0 ? i - 1 : 0] : 0.f); imp[i] += prev; }
#pragma unroll
        for (int i = 0; i < 16; ++i) { imp[i] += __shfl_xor(imp[i], 1); imp[i] += __shfl_xor(imp[i], 2); }
        float sc[16], so[16];
#pragma unroll
        for (int i = 0; i < 16; ++i) { const int s = 2 * i + h; const bool forced = (s == 0) || (s == cur) || (s == cur - 1); sc[i] = s <= cur ? imp[i] + (forced ? 1e4f : 0.f) : -1.f; }
#pragma unroll
        for (int i = 0; i < 16; ++i) so[i] = __shfl_xor(sc[i], 32);
        unsigned mine = 0u;
#pragma unroll
        for (int i = 0; i < 16; ++i) { int rank = 0;
#pragma unroll
            for (int i2 = 0; i2 < 16; ++i2) {
                rank += (sc[i2] > sc[i] || (sc[i2] == sc[i] && i2 < i)) ? 1 : 0;
                const bool lower = h ? (i2 <= i) : (i2 < i);
                rank += (so[i2] > sc[i] || (so[i2] == sc[i] && lower)) ? 1 : 0; }
            if (rank < 16 && (2 * i + h) <= cur) mine |= 1u << (2 * i + h); }
        selmask = mine | __shfl_xor(mine, 32);
        if ((lane & 35) == 0) __hip_atomic_fetch_or(bmask, selmask, __ATOMIC_RELAXED, __HIP_MEMORY_SCOPE_WORKGROUP);
#pragma unroll
        for (int eb = 0; eb < 4; ++eb) Ot[eb] = zero16();
#pragma unroll
        for (int kb = 0; kb < 4; ++kb) {
            { const bf16x8 pf = pack_step<0>(st[kb]);
#pragma unroll
              for (int eb = 0; eb < 4; ++eb) { const LAS unsigned char* vp = Vs + (32 * eb + r) * VCP + (32 * kb + 4 * h) * 2; const bf16x8 vf = cat4(*(const LAS bf16x4*)vp, *(const LAS bf16x4*)(vp + 16)); Ot[eb] = MFMA32(vf, pf, Ot[eb]); } }
            asm volatile("" ::: "memory");
            { const bf16x8 pf = pack_step<1>(st[kb]);
#pragma unroll
              for (int eb = 0; eb < 4; ++eb) { const LAS unsigned char* vp = Vs + (32 * eb + r) * VCP + (32 * kb + 16 + 4 * h) * 2; const bf16x8 vf = cat4(*(const LAS bf16x4*)vp, *(const LAS bf16x4*)(vp + 16)); Ot[eb] = MFMA32(vf, pf, Ot[eb]); } }
            asm volatile("" ::: "memory");
        }
#pragma unroll
        for (int eb = 0; eb < 4; ++eb)
#pragma unroll
            for (int rq = 0; rq < 4; ++rq) { u32x2 wv; wv.x = cvt_pk_bf16(Ot[eb][4 * rq] * gt0, Ot[eb][4 * rq + 1] * gt0); wv.y = cvt_pk_bf16(Ot[eb][4 * rq + 2] * gt0, Ot[eb][4 * rq + 3] * gt0);
                *(u32x2*)(op + 32 * eb + 8 * rq + 4 * h) = wv; }
    }
    __syncthreads();
    const unsigned blockmask = *bmask;
#pragma unroll 1
    for (int br = 0; br < NSA_NBR; ++br) {
        f32x16 O[4];
#pragma unroll
        for (int eb = 0; eb < 4; ++eb) O[eb] = zero16();
        float m = -1e30f, l = 0.f;
        const int kcol = (br ? C_KW : C_KS) + g * 128;
        const bf16* vT = (const bf16*)(ws + (br ? WS_VWT : WS_VST)) + (size_t)bg * 128 * T;
        const int jlo = br ? (cur > 8 ? cur - 8 : 0) : 0;
        unsigned todo = br ? ((cur >= 31 ? 0xffffffffu : ((2u << cur) - 1u)) & ~((1u << jlo) - 1u)) : blockmask;
        const bf16* kg = proj + (size_t)(b * T + (tid >> 4)) * NP + kcol + (tid & 15) * 8;
        const bf16* vg = vT + (size_t)(tid >> 3) * T + (tid & 7) * 8;
        LAS unsigned char* kd = Ks + (tid >> 4) * KP + (tid & 15) * 16; LAS unsigned char* vd = Vs + (tid >> 3) * VP + (tid & 7) * 16;
        u32x4 pk0, pk1, pv0, pv1;
#define NSA_LOAD(jj) do { const bf16* kp_ = kg + (size_t)(64 * (jj)) * NP; pk0 = *(const u32x4*)kp_; pk1 = *(const u32x4*)(kp_ + (size_t)32 * NP); \
                          const bf16* vp_ = vg + 64 * (jj); pv0 = *(const u32x4*)vp_; pv1 = *(const u32x4*)(vp_ + (size_t)64 * T); } while (0)
        if (todo) NSA_LOAD(__builtin_ctz(todo));
#pragma unroll 1
        while (todo) {
            const int j = __builtin_ctz(todo); todo &= todo - 1u;
            __syncthreads();
            *(LAS u32x4*)kd = pk0; *(LAS u32x4*)(kd + 32 * KP) = pk1;
            { LAS u32x2* d = (LAS u32x2*)vd; d[0] = (u32x2){pv0.x, pv0.y}; d[1] = (u32x2){pv0.z, pv0.w}; d = (LAS u32x2*)(vd + 64 * VP); d[0] = (u32x2){pv1.x, pv1.y}; d[1] = (u32x2){pv1.z, pv1.w}; }
            __syncthreads();
            if (todo) NSA_LOAD(__builtin_ctz(todo));
            const int kbase = 64 * j;
            if (!br) {
                const bool mysel = (selmask >> j) & 1u;
                if (__ballot(mysel) != 0ull) attn_tile(qrow, Ks, Vs, r, h, m, l, O, -1000000, mysel ? (tok - kbase - 4 * h) : -1000000);
            } else {
                attn_tile(qrow, Ks, Vs, r, h, m, l, O, tok - kbase - 4 * h - 512, tok - kbase - 4 * h);
            }
        }
#undef NSA_LOAD
        const float sc = (l > 0.f ? 1.f / l : 0.f) * (br ? gt2 : gt1);
        VM_WAIT();
#pragma unroll
        for (int eb = 0; eb < 4; ++eb)
#pragma unroll
            for (int rq = 0; rq < 4; ++rq) { u32x2* p = (u32x2*)(op + 32 * eb + 8 * rq + 4 * h); const u32x2 old = *p;
                u32x2 wv; wv.x = cvt_pk_bf16(bflo(old.x) + O[eb][4 * rq] * sc, bfhi(old.x) + O[eb][4 * rq + 1] * sc); wv.y = cvt_pk_bf16(bflo(old.y) + O[eb][4 * rq + 2] * sc, bfhi(old.y) + O[eb][4 * rq + 3] * sc);
                *p = wv; }
    }
}

#ifndef P6_REP_NSA
#define P6_REP_NSA 1
#endif
#ifndef P6_REP_R2
#define P6_REP_R2 1
#endif
__device__ __forceinline__ void phase6(const Args& a, LAS unsigned char* lds) {
    for (int it = blockIdx.x; it < 1024; it += gridDim.x) {
        if (it < 512) { for (int rep = 0; rep < P6_REP_NSA; ++rep) nsa_item(a, lds, it); }
        else { for (int rep = 0; rep < P6_REP_R2; ++rep) r2_item(a, lds, it - 512); }
    }
}

__device__ __forceinline__ void phase9(const Args& a, LAS unsigned char* lds) {
    const int tid = threadIdx.x, lane = tid & 63, wave = __builtin_amdgcn_readfirstlane(tid >> 6), q = lane >> 4, r = lane & 15;
    unsigned char* ws = a.ws;
    const bf16* h2 = (const bf16*)(ws + WS_H); const bf16* wrt = (const bf16*)(ws + WS_WRT);
    const float* bgrp = a.in[I_BGRP]; const float* bexp = a.in[I_BEXP];
    unsigned* cnt = (unsigned*)(ws + WS_CTL) + CW_CNT; int* asg = (int*)(ws + WS_ASG); float* rw = (float*)(ws + WS_RW);
    LAS float* lg = (LAS float*)(lds + wave * 8192);
    const int gw = blockIdx.x * NWAVES + wave, NGW = gridDim.x * NWAVES;
    for (int wi = gw; wi < M / 16; wi += NGW) {
        const bf16* A = h2 + (size_t)(wi * 16 + r) * D;
        f32x4 acc[5];
#pragma unroll
        for (int nt = 0; nt < 5; ++nt) acc[nt] = (f32x4){0.f, 0.f, 0.f, 0.f};
#pragma unroll 2
        for (int k0 = 0; k0 < D; k0 += 32) { const bf16x8 af = *(const bf16x8*)(A + k0 + 8 * q);
#pragma unroll
            for (int nt = 0; nt < 5; ++nt) { const bf16x8 bfr = *(const bf16x8*)(wrt + (size_t)(16 * nt + r) * D + k0 + 8 * q); acc[nt] = MFMA16(bfr, af, acc[nt]); } }
#pragma unroll
        for (int nt = 0; nt < 5; ++nt) *(LAS f32x4*)(lg + r * 84 + 16 * nt + 4 * q) = acc[nt];
        LDS_WAIT();
        if (lane < 16) {
            const int tok = wi * 16 + lane; const LAS float* L = lg + lane * 84;
            float gl[8]; float gmax = -3.0e38f; int gi = 0;
#pragma unroll
            for (int i = 0; i < 8; ++i) { gl[i] = L[i] + bgrp[i]; if (gl[i] > gmax) { gmax = gl[i]; gi = i; } }
            float gs = 0.f;
#pragma unroll
            for (int i = 0; i < 8; ++i) gs += __expf(gl[i] - gmax);
            const float pg = 1.f / gs;
            float el[8]; float m1 = -3.0e38f; int i1 = 0;
#pragma unroll
            for (int i = 0; i < 8; ++i) { el[i] = L[8 + gi * 8 + i] + bexp[gi * 8 + i]; if (el[i] > m1) { m1 = el[i]; i1 = i; } }
            float m2 = -3.0e38f; int i2 = 0;
#pragma unroll
            for (int i = 0; i < 8; ++i) { if (i != i1 && el[i] > m2) { m2 = el[i]; i2 = i; } }
            const float e2 = __expf(m2 - m1); const float w1 = pg / (1.f + e2), w2 = pg * e2 / (1.f + e2);
            const int ea = gi * 8 + i1, eb = gi * 8 + i2;
            const unsigned pa = atomicAdd(cnt + ea, 1u); asg[(size_t)ea * CAP + pa] = tok * 2;     rw[(size_t)ea * CAP + pa] = w1;
            const unsigned pb = atomicAdd(cnt + eb, 1u); asg[(size_t)eb * CAP + pb] = tok * 2 + 1; rw[(size_t)eb * CAP + pb] = w2;
        }
        LDS_WAIT();
    }
}

constexpr int MOE_TAB_OFF = 131072;
__device__ __forceinline__ void moe_tables(const Args& a, LAS unsigned char* lds) {
    const int tid = threadIdx.x;
    LAS int* cntL = (LAS int*)(lds + MOE_TAB_OFF); LAS int* tst = cntL + 64;
    const unsigned* cnt = (const unsigned*)(a.ws + WS_CTL) + CW_CNT;
    __syncthreads();
    if (tid < 64) cntL[tid] = (int)__hip_atomic_load(cnt + tid, __ATOMIC_RELAXED, __HIP_MEMORY_SCOPE_AGENT);
    __syncthreads();
    if (tid == 0) { int ts = 0; for (int e = 0; e < 64; ++e) { tst[e] = ts; ts += (cntL[e] + 255) >> 8; } tst[64] = ts; }
    __syncthreads();
}
__device__ __forceinline__ void phase10(const Args& a, LAS unsigned char* lds) {
    const int tid = threadIdx.x;
    unsigned char* ws = a.ws;
    moe_tables(a, lds);
    const LAS int* cntL = (const LAS int*)(lds + MOE_TAB_OFF); const LAS int* tst = cntL + 64; LAS int* tab = (LAS int*)(lds + MOE_TAB_OFF + 1024);
    pg8::MoeOrder1 S; S.cntL = cntL; S.tst = tst; S.npn = 4; S.G = (int)gridDim.x; S.c = (int)blockIdx.x; S.tab = tab; S.Bt = (const bf16*)(ws + WS_WGU); S.K = D;
    { const int* asg = (const int*)(ws + WS_ASG); pg8::Unit u;
      for (int i = 0; i < 12 && S.next(i, u); ++i) if (tid < 256) { const int p = u.pm * 256 + tid; tab[i * 256 + tid] = p < cntL[u.e] ? (asg[(size_t)u.e * CAP + p] >> 1) : 0; } }
    __syncthreads();
    pg8::Gemm g{(const bf16*)(ws + WS_H), (const bf16*)(ws + WS_WGU), 0, 0, D};
    pg8::EpiMoe1 E{(bf16*)(ws + WS_A), cntL, tst};
    pg8::gemm_phase2<pg8::EpiMoe1, pg8::MoeOrder1, true>(lds, g, S, E);
}
__device__ __forceinline__ void phase11(const Args& a, LAS unsigned char* lds) {
    unsigned char* ws = a.ws;
    moe_tables(a, lds);
    const LAS int* cntL = (const LAS int*)(lds + MOE_TAB_OFF); const LAS int* tst = cntL + 64;
    pg8::MoeOrder2 S; S.cntL = cntL; S.tst = tst; S.npn = 8; S.G = (int)gridDim.x; S.c = (int)blockIdx.x; S.Bt = (const bf16*)(ws + WS_WD); S.K = DE;
    pg8::Gemm g{(const bf16*)(ws + WS_A), (const bf16*)(ws + WS_WD), 0, 0, DE};
    pg8::EpiMoe2 E{(bf16*)(ws + WS_Y), (const int*)(ws + WS_ASG), (const float*)(ws + WS_RW), cntL, CAP, D};
    pg8::gemm_phase2<pg8::EpiMoe2, pg8::MoeOrder2, true>(lds, g, S, E);
}

template <bool WITH_MOE>
__device__ __forceinline__ void phase12(const Args& a) {
    const int tid = threadIdx.x, lane = tid & 63, wave = __builtin_amdgcn_readfirstlane(tid >> 6);
    const float* mod = (const float*)(a.ws + WS_MOD); const bf16* ybuf = (const bf16*)(a.ws + WS_Y); const float* fg = a.in[I_FG];
    const int gw = blockIdx.x * NWAVES + wave, NGW = gridDim.x * NWAVES;
    for (int row = gw; row < M; row += NGW) {
        const int b = row >> 11;
        f32x4* xr = (f32x4*)(a.out + (size_t)row * D) + lane;
        const u32x2* y0 = (const u32x2*)(ybuf + (size_t)(2 * row) * D) + lane; const u32x2* y1 = (const u32x2*)(ybuf + (size_t)(2 * row + 1) * D) + lane;
        const f32x4* g2 = (const f32x4*)(mod + (size_t)b * 12288 + 5 * 2048) + lane;
        f32x4 v[8]; float ss = 0.f;
#pragma unroll
        for (int j = 0; j < 8; ++j) { v[j] = xr[64 * j];
            if (WITH_MOE) { const u32x2 p0 = y0[64 * j], p1 = y1[64 * j]; const f32x4 gg = g2[64 * j];
                v[j][0] += gg[0] * (bflo(p0.x) + bflo(p1.x)); v[j][1] += gg[1] * (bfhi(p0.x) + bfhi(p1.x)); v[j][2] += gg[2] * (bflo(p0.y) + bflo(p1.y)); v[j][3] += gg[3] * (bfhi(p0.y) + bfhi(p1.y)); }
            ss += (v[j][0] * v[j][0] + v[j][1] * v[j][1]) + (v[j][2] * v[j][2] + v[j][3] * v[j][3]); }
        const float rstd = rsqrtf(wave_sum(ss) * (1.f / 2048.f) + EPS);
#pragma unroll
        for (int j = 0; j < 8; ++j) { const f32x4 f4 = *((const f32x4*)fg + lane + 64 * j); xr[64 * j] = v[j] * rstd * f4; }
    }
}

constexpr int NPHASES = 13;
#ifndef MK_N_LAUNCHES
#define MK_N_LAUNCHES 1
#endif
__global__ void __launch_bounds__(NWAVES * 64, 2) fwd(Args a) {
    extern __shared__ __attribute__((aligned(16))) unsigned char lds_raw[];
    LAS unsigned char* lds = (LAS unsigned char*)lds_raw;
    const int tid = threadIdx.x;
    if (tid < 64) ((LAS unsigned*)(lds + MISC_OFF))[tid] = 0u;
    __syncthreads();
    XcdBarrier bar; bar.bar = (unsigned*)(a.ws + WS_CTL) + CW_BAR; bar.x = 0; bar.st = nullptr;
    if (a.ph_hi - a.ph_lo > 1) bar = xcd_barrier_post((unsigned*)(a.ws + WS_CTL) + CW_BAR, (volatile LAS unsigned*)(lds + MISC_OFF) + 8);
    unsigned char* ws = a.ws;
#ifndef ONLY_PHASE
#define ONLY_PHASE -1
#endif
#define IN(k) ((ONLY_PHASE < 0 || ONLY_PHASE == (k)) && a.ph_lo <= (k) && (k) < a.ph_hi)
#define SEAM(k) do { if (IN(k) && IN((k) + 1)) xcd_barrier(bar); } while (0)
#ifndef REP0
#define REP0 1
#endif
#ifndef REP3
#define REP3 1
#endif
#ifndef REP1
#define REP1 1
#endif
#ifndef REP2
#define REP2 1
#endif
#ifndef XBAR
#define XBAR 0
#endif
#ifndef REP4
#define REP4 1
#endif
#ifndef REP6
#define REP6 1
#endif
#ifndef REP10
#define REP10 1
#endif
    if (IN(0)) for (int rep = 0; rep < REP0; ++rep) { phase0(a, lds); if (rep + 1 < REP0) xcd_barrier(bar); }
    SEAM(0);
    if (IN(1)) for (int rep = 0; rep < REP1; ++rep) { norm_mod_phase<true>(a, lds, a.in[I_X], a.in[I_N1G], 0, 1, (bf16*)(ws + WS_H)); if (rep + 1 < REP1) xcd_barrier(bar); }
    SEAM(1);
    if (IN(2)) {
        constexpr int GEMM_WG = 192;
        const int ngemm = (int)gridDim.x > GEMM_WG ? GEMM_WG : (int)gridDim.x;
        if ((int)blockIdx.x < ngemm) { pg8::Gemm g{(const bf16*)(ws + WS_H), (const bf16*)(ws + WS_WIN), M, NP, D}; pg8::PlainOrder S; S.init(M, NP, ngemm, (int)blockIdx.x); S.Bt = g.Bt; S.K = D;
            pg8::EpiProj E{(bf16*)(ws + WS_PROJ), NP, T, (bf16*)(ws + WS_QR), (bf16*)(ws + WS_KR), (bf16*)(ws + WS_KZT), (bf16*)(ws + WS_VT), (bf16*)(ws + WS_KCMP), (bf16*)(ws + WS_VCMP),
                           (bf16*)(ws + WS_VST), (bf16*)(ws + WS_VWT), (const float*)(ws + WS_COS), (const float*)(ws + WS_SIN)};
            pg8::gemm_phase2<pg8::EpiProj, pg8::PlainOrder, true>(lds, g, S, E); }
        moe_convert(a, lds);
    }
    SEAM(2);
    for (int xb = 0; xb < XBAR; ++xb) xcd_barrier(bar);
    for (int rep = 0; rep < REP4; ++rep) {
    if (IN(4)) phase4(a, lds);
    SEAM(4);
    if (IN(5)) phase5(a, lds);
    if (rep + 1 < REP4) xcd_barrier(bar); }
    SEAM(5);
    if (IN(6)) for (int rep = 0; rep < REP6; ++rep) { phase6(a, lds); if (rep + 1 < REP6) xcd_barrier(bar); }
    SEAM(6);
    if (IN(7)) { pg8::Gemm g{(const bf16*)(ws + WS_CAT), (const bf16*)(ws + WS_WOUT), M, D, D}; pg8::PlainOrder S; S.init(M, D, (int)gridDim.x, (int)blockIdx.x); S.Bt = g.Bt; S.K = D;
        pg8::EpiResGate E{a.in[I_X], a.out, D, (const float*)(ws + WS_MOD) + 2 * 2048, 12288, T};
        pg8::gemm_phase2<pg8::EpiResGate, pg8::PlainOrder, true>(lds, g, S, E); }
    SEAM(7);
    if (IN(8)) norm_mod_phase<false>(a, lds, a.out, a.in[I_N2G], 3, 4, (bf16*)(ws + WS_H));
    SEAM(8);
    if (IN(9)) phase9(a, lds);
    SEAM(9);
    for (int rep = 0; rep < REP10; ++rep) {
    if (IN(10)) phase10(a, lds);
    SEAM(10);
    if (IN(11)) phase11(a, lds);
    if (rep + 1 < REP10) xcd_barrier(bar); }
    SEAM(11);
    if (IN(12)) phase12<true>(a);
#undef IN
#undef SEAM
}

extern "C" void kernel_launch(void* const* d_in, const int* in_sizes, int n_in, void* d_out, int out_size, void* d_ws, size_t ws_size, hipStream_t stream) {
    static int grid = 0;
    if (grid == 0) {
        if (n_in != 23 || out_size != M * D || ws_size < WS_END) { fprintf(stderr, "kernel_launch: unexpected shapes (n_in %d, out %d, ws %zu < %zu); nothing launched\n", n_in, out_size, ws_size, (size_t)WS_END); grid = -1; return; }
        int dev = 0, cus = 0, per_cu = 0;
        if (hipGetDevice(&dev) != hipSuccess || hipDeviceGetAttribute(&cus, hipDeviceAttributeMultiprocessorCount, dev) != hipSuccess) { grid = -1; return; }
        if (hipFuncSetAttribute((const void*)fwd, hipFuncAttributeMaxDynamicSharedMemorySize, LDS_BYTES) != hipSuccess) { fprintf(stderr, "kernel_launch: hipFuncSetAttribute failed\n"); grid = -1; return; }
        if (hipOccupancyMaxActiveBlocksPerMultiprocessor(&per_cu, (const void*)fwd, NWAVES * 64, LDS_BYTES) != hipSuccess || per_cu < 1) fprintf(stderr, "kernel_launch: occupancy query reports %d\n", per_cu);
        (void)hipGetLastError();
        grid = cus;
    }
    if (grid < 0) return;
    if (hipMemsetAsync((char*)d_ws + WS_CTL, 0, CTL_ZERO_BYTES, stream) != hipSuccess) return;
    Args a{};
    for (int i = 0; i < 23; ++i) a.in[i] = (const float*)d_in[i];
    a.out = (float*)d_out; a.ws = (unsigned char*)d_ws;
    constexpr int NL = MK_N_LAUNCHES;
    for (int li = 0; li < NL; ++li) {
        a.ph_lo = (NL == 1) ? 0 : li; a.ph_hi = (NL == 1) ? NPHASES : li + 1;
        hipLaunchKernelGGL(fwd, dim3(grid), dim3(NWAVES * 64), LDS_BYTES, stream, a);
        const hipError_t le = hipPeekAtLastError();
        if (le != hipSuccess) { fprintf(stderr, "kernel_launch: launch %d failed: %s\n", li, hipGetErrorName(le)); break; }
    }
}
```
